# Optimizing an MI355X kernel written in HIP

```python
import math, functools
import jax, jax.numpy as jnp
from jax import lax
import numpy as np

D_MODEL = 1024
BATCH = 4
SEQ = 4096
DEPTH = 2

CTX_LEN = 256
GRID_W = 64
HEAD_DIM = 64
N_DIFF_HEADS = 8
DIFF_V_DIM = 2 * HEAD_DIM
N_GQA_HEADS = 16
N_GQA_KV = 4
GQA_REP = N_GQA_HEADS // N_GQA_KV
D_FF = 2816
N_EXPERTS = 8
TOP_K = 2
D_FF_EXPERT = 3584
Q_BLOCK = 128
ROPE_THETA = 10000.0
EPS = 1e-6

DIFF_Q_W = N_DIFF_HEADS * 2 * HEAD_DIM
GQA_Q_W = N_GQA_HEADS * HEAD_DIM
DIFF_K_W = N_DIFF_HEADS * 2 * HEAD_DIM
DIFF_V_W = N_DIFF_HEADS * DIFF_V_DIM
GQA_K_W = N_GQA_KV * HEAD_DIM
GQA_V_W = N_GQA_KV * HEAD_DIM
GATE_W = 2 * D_MODEL
Q_END = DIFF_Q_W + GQA_Q_W
KV_END = Q_END + DIFF_K_W + DIFF_V_W + GQA_K_W + GQA_V_W
IN_W = KV_END + GATE_W

kernel_name = "hybrid_diff_gqa_prefix_dit"


def rms_norm(x, g):
    xf = x.astype(jnp.float32)
    y = xf * lax.rsqrt(jnp.mean(xf * xf, axis=-1, keepdims=True) + EPS)
    return (y * g.astype(jnp.float32)).astype(x.dtype)


def modulate(x, g, shift, scale):
    return rms_norm(x, g) * (1.0 + scale) + shift


def axial_rope_tables(n_tok):
    rows = n_tok // GRID_W
    row = jnp.repeat(jnp.arange(rows, dtype=jnp.float32), GRID_W)
    col = jnp.tile(jnp.arange(GRID_W, dtype=jnp.float32), rows)
    half = HEAD_DIM // 2
    inv_freq = ROPE_THETA ** (-jnp.arange(0, half, 2, dtype=jnp.float32) / half)
    ang = jnp.concatenate([row[:, None] * inv_freq, col[:, None] * inv_freq], axis=-1)
    return jnp.cos(ang), jnp.sin(ang)


def apply_rope(x, cos, sin):
    xf = x.astype(jnp.float32).reshape(*x.shape[:-1], x.shape[-1] // 2, 2)
    x0, x1 = xf[..., 0], xf[..., 1]
    out = jnp.stack([x0 * cos - x1 * sin, x0 * sin + x1 * cos], axis=-1)
    return out.reshape(x.shape).astype(x.dtype)


def split_queries(p_q, q_norm, rope):
    B, T = p_q.shape[:2]
    dq = p_q[..., :DIFF_Q_W].reshape(B, T, N_DIFF_HEADS, 2, HEAD_DIM)
    gq = rms_norm(p_q[..., DIFF_Q_W:Q_END].reshape(B, T, N_GQA_HEADS, HEAD_DIM), q_norm)
    if rope is not None:
        cos, sin = rope
        dq = apply_rope(dq, cos[:, None, None, :], sin[:, None, None, :])
        gq = apply_rope(gq, cos[:, None, :], sin[:, None, :])
    return dq, gq.reshape(B, T, N_GQA_KV, GQA_REP, HEAD_DIM)


def split_keys_values(p_kv, k_norm, rope):
    B, T = p_kv.shape[:2]
    o1 = DIFF_K_W
    o2 = o1 + DIFF_V_W
    o3 = o2 + GQA_K_W
    dk = p_kv[..., :o1].reshape(B, T, N_DIFF_HEADS, 2, HEAD_DIM)
    dv = p_kv[..., o1:o2].reshape(B, T, N_DIFF_HEADS, DIFF_V_DIM)
    gk = rms_norm(p_kv[..., o2:o3].reshape(B, T, N_GQA_KV, HEAD_DIM), k_norm)
    gv = p_kv[..., o3:].reshape(B, T, N_GQA_KV, HEAD_DIM)
    if rope is not None:
        cos, sin = rope
        dk = apply_rope(dk, cos[:, None, None, :], sin[:, None, None, :])
        gk = apply_rope(gk, cos[:, None, :], sin[:, None, :])
    return dk, dv, gk, gv


def diff_attention(q, k, v, lam):
    s = jnp.einsum('bqhcd,bkhcd->bhcqk', q, k, preferred_element_type=jnp.float32) * (HEAD_DIM ** -0.5)
    p = jax.nn.softmax(s, axis=-1)
    w = p[:, :, 0] - lam * p[:, :, 1]
    return jnp.einsum('bhqk,bkhe->bqhe', w, v.astype(jnp.float32)).astype(v.dtype)


def gqa_attention(q, k, v):
    s = jnp.einsum('bqgrd,bkgd->bgrqk', q, k, preferred_element_type=jnp.float32) * (HEAD_DIM ** -0.5)
    p = jax.nn.softmax(s, axis=-1)
    return jnp.einsum('bgrqk,bkgd->bqgrd', p, v.astype(jnp.float32)).astype(v.dtype)


def sweep_query_blocks(attn, q, *kv):
    B, S = q.shape[:2]
    nb = S // Q_BLOCK
    qb = jnp.moveaxis(q.reshape(B, nb, Q_BLOCK, *q.shape[2:]), 1, 0)
    ob = lax.map(lambda qi: attn(qi, *kv), qb)
    return jnp.moveaxis(ob, 0, 1).reshape(B, S, *ob.shape[3:])


def mixer_output(y_diff, y_gqa, gates, lam_init, subln_g, w_pd, w_pg, w_o):
    B, T = y_diff.shape[:2]
    yd = (rms_norm(y_diff, subln_g) * (1.0 - lam_init)).reshape(B, T, DIFF_V_W)
    yg = y_gqa.reshape(B, T, GQA_Q_W)
    m = jax.nn.sigmoid(gates[..., :D_MODEL]) * (yd @ w_pd) + jax.nn.sigmoid(gates[..., D_MODEL:]) * (yg @ w_pg)
    return m @ w_o


def swiglu(t, w1, w3, w2):
    return (jax.nn.silu(t @ w1) * (t @ w3)) @ w2


def moe_swiglu(h, router, w1, w3, w2):
    B, S, D = h.shape
    t = h.reshape(-1, D)
    logits = jnp.dot(t, router, preferred_element_type=jnp.float32)
    top_v, top_i = lax.top_k(logits, TOP_K)
    top_w = jax.nn.softmax(top_v, axis=-1)
    gate = jnp.sum(jax.nn.one_hot(top_i, N_EXPERTS, dtype=jnp.float32) * top_w[..., None], axis=1)
    out = jnp.zeros(t.shape, jnp.float32)
    for e in range(N_EXPERTS):
        out = out + gate[:, e:e + 1] * swiglu(t, w1[e], w3[e], w2[e]).astype(jnp.float32)
    return out.astype(h.dtype).reshape(B, S, D)


def setup_inputs(seed: int = 0) -> dict:
    key = jax.random.key(seed)
    ks = jax.random.split(key, 32)
    n_dense = (DEPTH + 1) // 2
    n_moe = DEPTH // 2
    f32 = jnp.float32

    def nrm(k, shape, scale):
        return jax.random.normal(k, shape, f32) * scale

    return {
        'x': nrm(ks[0], (BATCH, SEQ, D_MODEL), 1.0),
        'c': nrm(ks[1], (BATCH, D_MODEL), 1.0),
        'ctx': nrm(ks[2], (BATCH, CTX_LEN, D_MODEL), 1.0),
        'c_ctx': nrm(ks[3], (D_MODEL,), 1.0),
        'ada_w': nrm(ks[4], (DEPTH, D_MODEL, 6 * D_MODEL), D_MODEL ** -0.5),
        'ada_b': nrm(ks[5], (DEPTH, 6 * D_MODEL), 0.02),
        'norm_attn_g': 1.0 + nrm(ks[6], (DEPTH, D_MODEL), 0.1),
        'norm_ffn_g': 1.0 + nrm(ks[7], (DEPTH, D_MODEL), 0.1),
        'w_in': nrm(ks[8], (DEPTH, D_MODEL, IN_W), D_MODEL ** -0.5),
        'q_norm_g': 1.0 + nrm(ks[9], (DEPTH, HEAD_DIM), 0.1),
        'k_norm_g': 1.0 + nrm(ks[10], (DEPTH, HEAD_DIM), 0.1),
        'diff_lambda': nrm(ks[11], (DEPTH, 4, HEAD_DIM), 0.1),
        'diff_subln_g': 1.0 + nrm(ks[12], (DEPTH, DIFF_V_DIM), 0.1),
        'w_proj_diff': nrm(ks[13], (DEPTH, DIFF_V_W, D_MODEL), DIFF_V_W ** -0.5),
        'w_proj_gqa': nrm(ks[14], (DEPTH, GQA_Q_W, D_MODEL), GQA_Q_W ** -0.5),
        'w_out': nrm(ks[15], (DEPTH, D_MODEL, D_MODEL), D_MODEL ** -0.5),
        'ffn_w1': nrm(ks[16], (n_dense, D_MODEL, D_FF), D_MODEL ** -0.5),
        'ffn_w3': nrm(ks[17], (n_dense, D_MODEL, D_FF), D_MODEL ** -0.5),
        'ffn_w2': nrm(ks[18], (n_dense, D_FF, D_MODEL), D_FF ** -0.5),
        'moe_router': nrm(ks[19], (n_moe, D_MODEL, N_EXPERTS), D_MODEL ** -0.5),
        'moe_w1': nrm(ks[20], (n_moe, N_EXPERTS, D_MODEL, D_FF_EXPERT), D_MODEL ** -0.5),
        'moe_w3': nrm(ks[21], (n_moe, N_EXPERTS, D_MODEL, D_FF_EXPERT), D_MODEL ** -0.5),
        'moe_w2': nrm(ks[22], (n_moe, N_EXPERTS, D_FF_EXPERT, D_MODEL), D_FF_EXPERT ** -0.5),
        'final_norm_g': 1.0 + nrm(ks[23], (D_MODEL,), 0.1),
    }


def reference(x, c, ctx, c_ctx, ada_w, ada_b, norm_attn_g, norm_ffn_g, w_in, q_norm_g, k_norm_g,
              diff_lambda, diff_subln_g, w_proj_diff, w_proj_gqa, w_out, ffn_w1, ffn_w3, ffn_w2,
              moe_router, moe_w1, moe_w3, moe_w2, final_norm_g):
    B, S, _ = x.shape
    rope = axial_rope_tables(S)
    silu_c = jax.nn.silu(c)
    silu_cc = jax.nn.silu(c_ctx)
    xc = ctx

    for l in range(DEPTH):
        last = l == DEPTH - 1
        sh1, sc1, gt1, sh2, sc2, gt2 = jnp.split((silu_c @ ada_w[l] + ada_b[l])[:, None, :], 6, axis=-1)
        csh1, csc1, cgt1, csh2, csc2, cgt2 = jnp.split(silu_cc @ ada_w[l] + ada_b[l], 6, axis=-1)

        lam_init = 0.8 - 0.6 * math.exp(-0.3 * l)
        lq1, lk1, lq2, lk2 = diff_lambda[l]
        lam = (jnp.exp(jnp.sum(lq1 * lk1).astype(jnp.float32))
               - jnp.exp(jnp.sum(lq2 * lk2).astype(jnp.float32)) + lam_init)

        h = modulate(x, norm_attn_g[l], sh1, sc1)
        hc = modulate(xc, norm_attn_g[l], csh1, csc1)
        p = h @ w_in[l]
        if last:
            pc_kv = hc @ w_in[l, :, Q_END:KV_END]
        else:
            pc = hc @ w_in[l]
            pc_kv = pc[..., Q_END:KV_END]

        dq, gq = split_queries(p[..., :Q_END], q_norm_g[l], rope)
        dk, dv, gk, gv = split_keys_values(p[..., Q_END:KV_END], k_norm_g[l], rope)
        cdk, cdv, cgk, cgv = split_keys_values(pc_kv, k_norm_g[l], None)

        dk_all = jnp.concatenate([dk, cdk], axis=1)
        dv_all = jnp.concatenate([dv, cdv], axis=1)
        gk_all = jnp.concatenate([gk, cgk], axis=1)
        gv_all = jnp.concatenate([gv, cgv], axis=1)
        y_diff = sweep_query_blocks(functools.partial(diff_attention, lam=lam), dq, dk_all, dv_all)
        y_gqa = sweep_query_blocks(gqa_attention, gq, gk_all, gv_all)
        x = x + gt1 * mixer_output(y_diff, y_gqa, p[..., KV_END:], lam_init, diff_subln_g[l],
                                   w_proj_diff[l], w_proj_gqa[l], w_out[l])

        if not last:
            cdq, cgq = split_queries(pc[..., :Q_END], q_norm_g[l], None)
            yc_diff = diff_attention(cdq, cdk, cdv, lam)
            yc_gqa = gqa_attention(cgq, cgk, cgv)
            xc = xc + cgt1 * mixer_output(yc_diff, yc_gqa, pc[..., KV_END:], lam_init, diff_subln_g[l],
                                          w_proj_diff[l], w_proj_gqa[l], w_out[l])

        h2 = modulate(x, norm_ffn_g[l], sh2, sc2)
        if l % 2 == 0:
            i = l // 2
            x = x + gt2 * swiglu(h2, ffn_w1[i], ffn_w3[i], ffn_w2[i])
            if not last:
                hc2 = modulate(xc, norm_ffn_g[l], csh2, csc2)
                xc = xc + cgt2 * swiglu(hc2, ffn_w1[i], ffn_w3[i], ffn_w2[i])
        else:
            i = l // 2
            x = x + gt2 * moe_swiglu(h2, moe_router[i], moe_w1[i], moe_w3[i], moe_w2[i])
            if not last:
                hc2 = modulate(xc, norm_ffn_g[l], csh2, csc2)
                xc = xc + cgt2 * moe_swiglu(hc2, moe_router[i], moe_w1[i], moe_w3[i], moe_w2[i])

    return rms_norm(x, final_norm_g)
```

```cpp
#include <hip/hip_runtime.h>
#include <hip/hip_bf16.h>
#include <cstdio>
#include <cstdint>
#include <cmath>

constexpr int DM = 1024, NB = 4, SEQ = 4096, CTXL = 256, EXT = SEQ + CTXL, MEXT = NB * EXT, MLAT = NB * SEQ, MCTX = NB * CTXL;
constexpr int PANB = EXT / 256  , NPAN = NB * PANB  ;
constexpr int INW = 6656;
constexpr int PC_QD = 0, PC_QG = 1024, PC_KD = 2048, PC_VD = 3072, PC_KG = 4096, PC_VG = 4352, PC_G1 = 4608, PC_G2 = 5632;
constexpr int OAW = 3072;
constexpr int DFF = 2816, NEXP = 8, DFE = 3584;
constexpr int MOE_ROWS = 2 * MLAT + NEXP * 256;
constexpr float EPS = 1e-6f;
constexpr int NHU = 48;
namespace pg8 {
#define PG8_LAS __attribute__((address_space(3)))
typedef unsigned short bf16_t;
typedef short bf16x8 __attribute__((ext_vector_type(8)));
typedef float f32x4 __attribute__((ext_vector_type(4)));
typedef unsigned u32x4 __attribute__((ext_vector_type(4)));
constexpr int BM = 256, BK = 64, HALF = 128, HTB = HALF * BK * 2  , STAGE_BYTES = 8 * HTB, NXCD = 8, WGM = 8;

__host__ __device__ __forceinline__ int lds_byte(int r, int c) { const int st = (r >> 4) * 2 + (c >> 5), rr = r & 15, cc = c & 31, ob = rr * 64 + cc * 2; return st * 1024 + (ob ^ (((ob >> 9) & 1) << 5)); }
__host__ __device__ __forceinline__ void stage_rc(int b, int& R, int& C) { const int st = b / 1024, sb = b % 1024, swz = sb ^ (((sb >> 9) & 1) << 5); R = (st >> 1) * 16 + swz / 64; C = (st & 1) * 32 + (swz % 64) / 2; }
__host__ __device__ __forceinline__ int perm32(int rho) { const int n = rho >> 4, i = rho & 15; return 8 * (i >> 2) + 4 * n + (i & 3); }

struct Unit { int pm, pn, e; };
struct Gemm { const bf16_t* A; const bf16_t* Bt; int K, lda; size_t bstride; };
__device__ __forceinline__ void rect_map(int wgid, int nM, int nN, int& pm, int& pn) {
    const int nwg = nM * nN; { const int q = nwg / NXCD, r = nwg % NXCD, xcd = wgid % NXCD, off = wgid / NXCD; wgid = (xcd < r ? xcd * (q + 1) : r * (q + 1) + (xcd - r) * q) + off; }
    const int nig = WGM * nN, gid = wgid / nig, fm = gid * WGM, gsz = (nM - fm) < WGM ? (nM - fm) : WGM;
    pm = fm + ((wgid % nig) % gsz); pn = (wgid % nig) / gsz;
}
struct RectOrder {
    int nMq, nN, nrect, G, c, latmode, exlo, exn, nextra;
    __device__ __forceinline__ void init(int nMq_, int nN_, int G_, int c_, int latmode_, int exlo_, int exn_) { nMq = nMq_; nN = nN_; nrect = nMq_ * nN_; G = G_; c = c_; latmode = latmode_; exlo = exlo_; exn = exn_; nextra = 4 * exn_; }
    __device__ __forceinline__ bool next(int i, Unit& u) const {
        int L = i * G + c; u.e = 0;
        if (L < nrect) { int q, pn; rect_map(L, nMq, nN, q, pn); u.pm = latmode ? (q >> 4) * 17 + (q & 15) : q; u.pn = pn; return true; }
        L -= nrect; if (L >= nextra) return false;
        const int b = L / exn; u.pm = b * 17 + 16; u.pn = exlo + (L - b * exn); return true;
    }
    __device__ __forceinline__ void a_ready(const Unit&) const {}
    __device__ __forceinline__ void done(const Unit&) const {}
};
struct MoeOrder {
    int P, nN, nwg, G, c, p1, p2, p3, p4, p5, p6, p7;
    __device__ __forceinline__ bool next(int i, Unit& u) const {
        const int L = i * G + c; if (L >= nwg) return false;
        int pm, pn; rect_map(L, P, nN, pm, pn); u.pm = pm; u.pn = pn;
        u.e = (pm >= p1) + (pm >= p2) + (pm >= p3) + (pm >= p4) + (pm >= p5) + (pm >= p6) + (pm >= p7); return true;
    }
    __device__ __forceinline__ void a_ready(const Unit&) const {}
    __device__ __forceinline__ void done(const Unit&) const {}
};

__device__ __forceinline__ unsigned cvt_pk_bf16(float lo, float hi) { unsigned r; asm volatile("v_cvt_pk_bf16_f32 %0, %1, %2" : "=v"(r) : "v"(lo), "v"(hi)); return r; }
__device__ __forceinline__ u32x4 pack8(const f32x4& a, const f32x4& b) { u32x4 w; w.x = cvt_pk_bf16(a[0], a[1]); w.y = cvt_pk_bf16(a[2], a[3]); w.z = cvt_pk_bf16(b[0], b[1]); w.w = cvt_pk_bf16(b[2], b[3]); return w; }
__device__ __forceinline__ void unpack8(const u32x4& w, f32x4& a, f32x4& b) {
    a[0] = __builtin_bit_cast(float, w.x << 16); a[1] = __builtin_bit_cast(float, w.x & 0xffff0000u); a[2] = __builtin_bit_cast(float, w.y << 16); a[3] = __builtin_bit_cast(float, w.y & 0xffff0000u);
    b[0] = __builtin_bit_cast(float, w.z << 16); b[1] = __builtin_bit_cast(float, w.z & 0xffff0000u); b[2] = __builtin_bit_cast(float, w.w << 16); b[3] = __builtin_bit_cast(float, w.w & 0xffff0000u); }
__device__ __forceinline__ float sigmoidf_(float v) { return __builtin_amdgcn_rcpf(1.f + __expf(-v)); }

struct EpiInProj {
    static constexpr bool PERM = true, AFTER_DRAIN = false;
    bf16_t* P; const float* qg; const float* kg; const float* tab; float c2;
    __device__ __forceinline__ void operator()(const f32x4 (&acc)[2][2][4][2], const Unit& u, int wr, int wc, int fr, int fq) const {
        asm volatile("" : "+v"(fr), "+v"(fq));
        const int pn = u.pn, seg = u.pm % 17; const bool lat = seg < 16;
        bf16_t* base = P + (size_t)(u.pm * 256 + wr * 64 + fr) * INW + 256 * pn + 64 * wc + 8 * fq;
        if (pn >= 18) {
#pragma unroll
            for (int ai = 0; ai < 2; ++ai)
#pragma unroll
                for (int m = 0; m < 4; ++m)
#pragma unroll
                    for (int bj = 0; bj < 2; ++bj) { f32x4 v0 = acc[ai][bj][m][0], v1 = acc[ai][bj][m][1];
#pragma unroll
                        for (int e = 0; e < 4; ++e) { v0[e] = sigmoidf_(v0[e]); v1[e] = sigmoidf_(v1[e]); }
                        *(u32x4*)(base + (size_t)(ai * 128 + m * 16) * INW + 32 * bj) = pack8(v0, v1); }
            return;
        }
        const bool donorm = (pn >= 4 && pn < 8) || pn == 16, dorope = lat && (pn < 12 || pn == 16);
        const float osc = pn < 8 ? c2 : 1.f;
        f32x4 gv[2][2];
#pragma unroll
        for (int bj = 0; bj < 2; ++bj)
#pragma unroll
            for (int n = 0; n < 2; ++n) gv[bj][n] = donorm ? *(const f32x4*)((pn == 16 ? kg : qg) + 32 * bj + 8 * fq + 4 * n) : (f32x4){1.f, 1.f, 1.f, 1.f};
        f32x4 tr[2][2], tc[4][2];
#pragma unroll
        for (int n = 0; n < 2; ++n) {
#pragma unroll
            for (int ai = 0; ai < 2; ++ai) tr[ai][n] = dorope ? *(const f32x4*)(tab + ((4 * seg + 2 * ai + wr) * 16 + 4 * fq + 2 * n) * 2) : (f32x4){1.f, 0.f, 1.f, 0.f};
#pragma unroll
            for (int m = 0; m < 4; ++m) tc[m][n] = dorope ? *(const f32x4*)(tab + ((16 * m + fr) * 16 + 4 * fq + 2 * n) * 2) : (f32x4){1.f, 0.f, 1.f, 0.f};
        }
#pragma unroll
        for (int ai = 0; ai < 2; ++ai)
#pragma unroll
            for (int m = 0; m < 4; ++m) {
                f32x4 v[2][2];
#pragma unroll
                for (int bj = 0; bj < 2; ++bj)
#pragma unroll
                    for (int n = 0; n < 2; ++n) v[bj][n] = acc[ai][bj][m][n];
                if (donorm) {
                    float ss = 0.f;
#pragma unroll
                    for (int bj = 0; bj < 2; ++bj)
#pragma unroll
                        for (int n = 0; n < 2; ++n) ss += (v[bj][n][0] * v[bj][n][0] + v[bj][n][1] * v[bj][n][1]) + (v[bj][n][2] * v[bj][n][2] + v[bj][n][3] * v[bj][n][3]);
                    ss += __shfl_xor(ss, 16); ss += __shfl_xor(ss, 32);
                    const float rs = 1.f / sqrtf(ss * (1.f / 64.f) + EPS);
#pragma unroll
                    for (int bj = 0; bj < 2; ++bj)
#pragma unroll
                        for (int n = 0; n < 2; ++n) v[bj][n] = v[bj][n] * rs * gv[bj][n];
                }
#pragma unroll
                for (int bj = 0; bj < 2; ++bj) {
#pragma unroll
                    for (int n = 0; n < 2; ++n) { const f32x4 t = bj == 0 ? tr[ai][n] : tc[m][n]; const f32x4 x = v[bj][n];
                        v[bj][n] = (f32x4){(x[0] * t[0] - x[1] * t[1]) * osc, (x[0] * t[1] + x[1] * t[0]) * osc, (x[2] * t[2] - x[3] * t[3]) * osc, (x[2] * t[3] + x[3] * t[2]) * osc}; }
                    *(u32x4*)(base + (size_t)(ai * 128 + m * 16) * INW + 32 * bj) = pack8(v[bj][0], v[bj][1]);
                }
            }
    }
};
struct EpiGate {
    static constexpr bool PERM = true, AFTER_DRAIN = false;
    bf16_t* Mx; const bf16_t* G; int accum;
    __device__ __forceinline__ void operator()(const f32x4 (&acc)[2][2][4][2], const Unit& u, int wr, int wc, int fr, int fq) const {
        asm volatile("" : "+v"(fr), "+v"(fq));
        const int row0 = u.pm * 256 + wr * 64 + fr, col0 = u.pn * 256 + wc * 32 + 8 * fq;
#pragma unroll
        for (int ai = 0; ai < 2; ++ai)
#pragma unroll
            for (int m = 0; m < 4; ++m) { const size_t row = (size_t)(row0 + ai * 128 + m * 16);
#pragma unroll
                for (int bj = 0; bj < 2; ++bj) { const int col = col0 + 128 * bj;
                    f32x4 g0, g1; unpack8(*(const u32x4*)(G + row * INW + col), g0, g1);
                    f32x4 v0 = acc[ai][bj][m][0] * g0, v1 = acc[ai][bj][m][1] * g1;
                    if (accum) { f32x4 o0, o1; unpack8(*(const u32x4*)(Mx + row * DM + col), o0, o1); v0 = v0 + o0; v1 = v1 + o1; }
                    *(u32x4*)(Mx + row * DM + col) = pack8(v0, v1); } }
    }
};
struct EpiResid {
    static constexpr bool PERM = true, AFTER_DRAIN = false;
    const float* XoL; const float* XoC; float* XnL; float* XnC; const float* mod;
    __device__ __forceinline__ void operator()(const f32x4 (&acc)[2][2][4][2], const Unit& u, int wr, int wc, int fr, int fq) const {
        asm volatile("" : "+v"(fr), "+v"(fq));
        const int b = u.pm / 17, seg = u.pm - b * 17; const bool lat = seg < 16;
        const size_t rb = (lat ? (size_t)(b * SEQ + seg * 256) : (size_t)(b * CTXL)) + wr * 64 + fr;
        const float* xo = lat ? XoL : XoC; float* xn = lat ? XnL : XnC;
        const int col0 = u.pn * 256 + wc * 32 + 8 * fq; const float* gp = mod + (lat ? b : 4) * 6144 + col0;
        f32x4 gt[2][2];
#pragma unroll
        for (int bj = 0; bj < 2; ++bj)
#pragma unroll
            for (int n = 0; n < 2; ++n) gt[bj][n] = *(const f32x4*)(gp + 128 * bj + 4 * n);
#pragma unroll
        for (int ai = 0; ai < 2; ++ai)
#pragma unroll
            for (int m = 0; m < 4; ++m) { const size_t ro = (rb + ai * 128 + m * 16) * DM + col0;
#pragma unroll
                for (int bj = 0; bj < 2; ++bj)
#pragma unroll
                    for (int n = 0; n < 2; ++n) { const f32x4 o = *(const f32x4*)(xo + ro + 128 * bj + 4 * n); *(f32x4*)(xn + ro + 128 * bj + 4 * n) = o + gt[bj][n] * acc[ai][bj][m][n]; } }
    }
};
struct EpiSwiGLU {
    static constexpr bool PERM = true, AFTER_DRAIN = false;
    bf16_t* U; int ldu;
    __device__ __forceinline__ void operator()(const f32x4 (&acc)[2][2][4][2], const Unit& u, int wr, int wc, int fr, int fq) const {
        asm volatile("" : "+v"(fr), "+v"(fq));
        bf16_t* base = U + (size_t)(u.pm * 256 + wr * 64 + fr) * ldu + u.pn * 128 + wc * 32 + 8 * fq;
#pragma unroll
        for (int ai = 0; ai < 2; ++ai)
#pragma unroll
            for (int m = 0; m < 4; ++m) { f32x4 r[2];
#pragma unroll
                for (int n = 0; n < 2; ++n) { const f32x4 a = acc[ai][0][m][n], b = acc[ai][1][m][n];
#pragma unroll
                    for (int e = 0; e < 4; ++e) r[n][e] = a[e] * sigmoidf_(a[e]) * b[e]; }
                *(u32x4*)(base + (size_t)(ai * 128 + m * 16) * ldu) = pack8(r[0], r[1]); }
    }
};
struct EpiPlain {
    static constexpr bool PERM = true, AFTER_DRAIN = false;
    bf16_t* Y; int ldy;
    __device__ __forceinline__ void operator()(const f32x4 (&acc)[2][2][4][2], const Unit& u, int wr, int wc, int fr, int fq) const {
        asm volatile("" : "+v"(fr), "+v"(fq));
        bf16_t* base = Y + (size_t)(u.pm * 256 + wr * 64 + fr) * ldy + u.pn * 256 + wc * 32 + 8 * fq;
#pragma unroll
        for (int ai = 0; ai < 2; ++ai)
#pragma unroll
            for (int m = 0; m < 4; ++m)
#pragma unroll
                for (int bj = 0; bj < 2; ++bj) *(u32x4*)(base + (size_t)(ai * 128 + m * 16) * ldy + 128 * bj) = pack8(acc[ai][bj][m][0], acc[ai][bj][m][1]);
    }
};

template <class Epi, class Sched, bool ALIGN_EPI = false, bool SP2 = false>
__device__ __forceinline__ void gemm_phase(PG8_LAS unsigned char* lds, const Gemm g, const Sched& S, const Epi& E) {
    int tid_ = threadIdx.x; asm volatile("" : "+v"(tid_));
    const int tid = tid_, wid = __builtin_amdgcn_readfirstlane(tid >> 6), lane = tid & 63, wr = wid >> 2, wc = wid & 3, fr = lane & 15, fq = lane >> 4;
    const int K = g.K, nt = K / BK, lda = g.lda;
    unsigned voffA[2], voffB[2];
#pragma unroll
    for (int i = 0; i < 2; ++i) { int R, C; stage_rc(tid * 16 + i * 8192, R, C); const int Rb = Epi::PERM ? ((R & ~31) + perm32(R & 31)) : R;
        voffA[i] = (unsigned)(R * lda + C) * 2u; voffB[i] = (unsigned)(Rb * K + C) * 2u; }
    const size_t kstep = (size_t)(BK * 2);
    const size_t hstepA = (size_t)HALF * lda * 2, hstepB = (size_t)HALF * K * 2;
    const size_t tstepA = 2 * hstepA, tstepB = 2 * hstepB;
    const unsigned ldsw = (unsigned)wid * 1024u;
    const int aoff = lds_byte(wr * 64 + fr, fq * 8), boff = lds_byte(wc * 32 + fr, fq * 8);
#define PG8_SA(b, h) (((b) * 2 + (h)) * HTB)
#define PG8_SB(b, h) ((4 + (b) * 2 + (h)) * HTB)
#define PG8_STAGE(bufoff, gbase, voff) do { _Pragma("unroll") for (int _i = 0; _i < 2; ++_i) \
        __builtin_amdgcn_global_load_lds((const unsigned*)((const char*)(gbase) + (voff)[_i]), (PG8_LAS unsigned*)(lds + (bufoff) + ldsw + _i * 8192), 16, 0, 0); } while (0)
#define PG8_LDA(dst, b, h) do { _Pragma("unroll") for (int m = 0; m < 4; ++m) _Pragma("unroll") for (int k = 0; k < 2; ++k) dst[m][k] = *(const PG8_LAS bf16x8*)(lds + PG8_SA(b, h) + aoff + m * 2048 + k * 1024); } while (0)
#define PG8_LDB(dst, b, h) do { _Pragma("unroll") for (int n = 0; n < 2; ++n) _Pragma("unroll") for (int k = 0; k < 2; ++k) dst[n][k] = *(const PG8_LAS bf16x8*)(lds + PG8_SB(b, h) + boff + n * 2048 + k * 1024); } while (0)
#define PG8_MMA(ai, bj, At, Bt) do { __builtin_amdgcn_s_setprio(1); _Pragma("unroll") for (int m = 0; m < 4; ++m) _Pragma("unroll") for (int n = 0; n < 2; ++n) _Pragma("unroll") for (int k = 0; k < 2; ++k) \
        acc[ai][bj][m][n] = __builtin_amdgcn_mfma_f32_16x16x32_bf16(Bt[n][k], At[m][k], acc[ai][bj][m][n], 0, 0, 0); __builtin_amdgcn_s_setprio(0); } while (0)
#define PG8_WAIT_V(n) asm volatile("s_waitcnt vmcnt(" #n ")" ::: "memory")
#define PG8_WAIT_L(n) asm volatile("s_waitcnt lgkmcnt(" #n ")" ::: "memory")
#define PG8_BAR __builtin_amdgcn_s_barrier()
#define PG8_SCHED __builtin_amdgcn_sched_barrier(0)
    Unit cur, nxt; int ui = 0;
    if (!S.next(0, cur)) return;
    f32x4 acc[2][2][4][2];
#pragma unroll
    for (int a = 0; a < 2; ++a)
#pragma unroll
        for (int b = 0; b < 2; ++b)
#pragma unroll
            for (int m = 0; m < 4; ++m)
#pragma unroll
                for (int n = 0; n < 2; ++n) acc[a][b][m][n] = (f32x4){0.f, 0.f, 0.f, 0.f};
    bf16x8 At[4][2], B0[2][2], B1[2][2];
    const char* cA = (const char*)g.A + (size_t)cur.pm * tstepA; const char* cB = (const char*)g.Bt + (size_t)cur.e * g.bstride + (size_t)cur.pn * tstepB;
    S.a_ready(cur);
    if constexpr (SP2) {
        PG8_STAGE(PG8_SB(0, 0), cB, voffB); PG8_STAGE(PG8_SB(0, 1), cB + hstepB, voffB); PG8_STAGE(PG8_SA(0, 0), cA, voffA); PG8_STAGE(PG8_SA(0, 1), cA + hstepA, voffA);
        if (wr == 1) PG8_BAR;
        PG8_WAIT_V(2); PG8_BAR;
        PG8_STAGE(PG8_SB(1, 0), cB + kstep, voffB); PG8_STAGE(PG8_SA(1, 0), cA + kstep, voffA); PG8_STAGE(PG8_SB(1, 1), cB + hstepB + kstep, voffB);
        PG8_WAIT_V(6); PG8_BAR;
    } else {
        PG8_STAGE(PG8_SB(0, 0), cB, voffB); PG8_STAGE(PG8_SA(0, 0), cA, voffA); PG8_STAGE(PG8_SB(0, 1), cB + hstepB, voffB); PG8_STAGE(PG8_SA(0, 1), cA + hstepA, voffA);
        if (wr == 1) PG8_BAR;
        PG8_WAIT_V(4); PG8_BAR;
        PG8_STAGE(PG8_SB(1, 0), cB + kstep, voffB); PG8_STAGE(PG8_SA(1, 0), cA + kstep, voffA); PG8_STAGE(PG8_SB(1, 1), cB + hstepB + kstep, voffB);
        PG8_WAIT_V(6); PG8_BAR;
    }
    for (;;) {
        const bool has_next = S.next(ui + 1, nxt);
        const char* nA = has_next ? (const char*)g.A + (size_t)nxt.pm * tstepA : cA; const char* nB = has_next ? (const char*)g.Bt + (size_t)nxt.e * g.bstride + (size_t)nxt.pn * tstepB : cB;
        for (int t = 0; t < nt; t += 2) {
            const bool last = (t == nt - 2);
            const char* a1 = cA + (size_t)(t + 1) * kstep;
            const char* a2 = last ? nA : cA + (size_t)(t + 2) * kstep; const char* b2 = last ? nB : cB + (size_t)(t + 2) * kstep;
            const char* a3 = a2 + kstep; const char* b3 = b2 + kstep;
            if (last && has_next) S.a_ready(nxt);
            if constexpr (SP2) {
            PG8_LDB(B0, 0, 0); PG8_LDB(B1, 0, 1); PG8_SCHED; PG8_LDA(At, 0, 0); PG8_STAGE(PG8_SA(1, 1), a1 + hstepA, voffA);
            PG8_WAIT_V(8); PG8_WAIT_L(0); PG8_BAR; PG8_MMA(0, 0, At, B0); PG8_MMA(0, 1, At, B1); PG8_BAR; PG8_SCHED;
            PG8_LDA(At, 0, 1); PG8_STAGE(PG8_SB(0, 0), b2, voffB); PG8_STAGE(PG8_SB(0, 1), b2 + hstepB, voffB); PG8_STAGE(PG8_SA(0, 0), a2, voffA);
            PG8_WAIT_V(8); PG8_WAIT_L(0); PG8_BAR; PG8_MMA(1, 0, At, B0); PG8_MMA(1, 1, At, B1); PG8_BAR; PG8_SCHED;
            PG8_LDB(B0, 1, 0); PG8_LDB(B1, 1, 1); PG8_SCHED; PG8_LDA(At, 1, 0); PG8_STAGE(PG8_SA(0, 1), a2 + hstepA, voffA);
            PG8_WAIT_V(8); PG8_WAIT_L(0); PG8_BAR; PG8_MMA(0, 0, At, B0); PG8_MMA(0, 1, At, B1); PG8_BAR; PG8_SCHED;
            PG8_LDA(At, 1, 1); PG8_STAGE(PG8_SB(1, 0), b3, voffB); PG8_STAGE(PG8_SB(1, 1), b3 + hstepB, voffB); PG8_STAGE(PG8_SA(1, 0), a3, voffA);
            PG8_WAIT_V(8); PG8_WAIT_L(0); PG8_BAR; PG8_MMA(1, 0, At, B0); PG8_MMA(1, 1, At, B1); PG8_BAR; PG8_SCHED;
            } else {
            PG8_LDB(B0, 0, 0); PG8_SCHED; PG8_LDA(At, 0, 0); PG8_STAGE(PG8_SA(1, 1), a1 + hstepA, voffA);
            PG8_WAIT_L(8); PG8_BAR; PG8_WAIT_L(0); PG8_MMA(0, 0, At, B0); PG8_BAR; PG8_SCHED;
            PG8_LDB(B1, 0, 1); PG8_STAGE(PG8_SB(0, 0), b2, voffB);
            PG8_BAR; PG8_WAIT_L(0); PG8_MMA(0, 1, At, B1); PG8_BAR;
            PG8_LDA(At, 0, 1); PG8_STAGE(PG8_SA(0, 0), a2, voffA);
            PG8_BAR; PG8_WAIT_L(0); PG8_MMA(1, 0, At, B0); PG8_BAR; PG8_SCHED;
            PG8_STAGE(PG8_SB(0, 1), b2 + hstepB, voffB);
            PG8_WAIT_V(6); PG8_BAR; PG8_MMA(1, 1, At, B1); PG8_BAR;
            PG8_LDB(B0, 1, 0); PG8_SCHED; PG8_LDA(At, 1, 0); PG8_STAGE(PG8_SA(0, 1), a2 + hstepA, voffA);
            PG8_WAIT_L(8); PG8_BAR; PG8_WAIT_L(0); PG8_MMA(0, 0, At, B0); PG8_BAR; PG8_SCHED;
            PG8_LDB(B1, 1, 1); PG8_STAGE(PG8_SB(1, 0), b3, voffB);
            PG8_BAR; PG8_WAIT_L(0); PG8_MMA(0, 1, At, B1); PG8_BAR;
            PG8_LDA(At, 1, 1); PG8_STAGE(PG8_SA(1, 0), a3, voffA);
            PG8_BAR; PG8_WAIT_L(0); PG8_MMA(1, 0, At, B0); PG8_BAR; PG8_SCHED;
            PG8_STAGE(PG8_SB(1, 1), b3 + hstepB, voffB);
            PG8_WAIT_V(6); PG8_BAR; PG8_MMA(1, 1, At, B1); PG8_BAR;
            }
        }
        if constexpr (ALIGN_EPI) { if (wr == 0) PG8_BAR; }
        if constexpr (!Epi::AFTER_DRAIN) { E(acc, cur, wr, wc, fr, fq); S.done(cur); }
        if (!has_next) break;
#pragma unroll
        for (int a = 0; a < 2; ++a)
#pragma unroll
            for (int b = 0; b < 2; ++b)
#pragma unroll
                for (int m = 0; m < 4; ++m)
#pragma unroll
                    for (int n = 0; n < 2; ++n) acc[a][b][m][n] = (f32x4){0.f, 0.f, 0.f, 0.f};
        cur = nxt; cA = nA; cB = nB; ++ui;
        if constexpr (ALIGN_EPI) { if (wr == 1) PG8_BAR; }
    }
    PG8_WAIT_V(0);
    if constexpr (!ALIGN_EPI) { if (wr == 0) PG8_BAR; }
    PG8_BAR;
    if constexpr (Epi::AFTER_DRAIN) { E.fused(acc, cur, wr, wc, fr, fq, lds, wid, lane); S.done(cur); }
#undef PG8_SA
#undef PG8_SB
#undef PG8_STAGE
#undef PG8_LDA
#undef PG8_LDB
#undef PG8_MMA
#undef PG8_WAIT_V
#undef PG8_WAIT_L
#undef PG8_BAR
#undef PG8_SCHED
}
}

#include <hip/hip_bf16.h>
#include <cmath>
namespace attn_body {
using bf16=__hip_bfloat16;
using bf16x8=__attribute__((ext_vector_type(8)))short;
using s16x4=__attribute__((ext_vector_type(4)))short;
using f32x16=__attribute__((ext_vector_type(16)))float;
using u32x4=__attribute__((ext_vector_type(4)))unsigned;
constexpr int D=64;
constexpr int NW=8,QBLK=32,QB=QBLK*NW,KVBLK=64;
__device__ __forceinline__ int crow(int r,int hi){return (r&3)+8*(r>>2)+4*hi;}
#define SBAR() __builtin_amdgcn_sched_barrier(0)
constexpr int NSLOT=3, SLOTB=8192;
constexpr int LDS_K=0, LDS_V=NSLOT*SLOTB, LDS_WS=2*NSLOT*SLOTB, LDS_OST=LDS_WS+NW*64*4, LDS_BYTES=LDS_OST+NW*4096;
constexpr float C2=0.125f*1.4426950408889634f;
__device__ __forceinline__ void glds16(const void*gsrc,unsigned lds_dst){unsigned keep;
  asm volatile("s_mov_b32 %0, m0\n\ts_mov_b32 m0, %2\n\ts_nop 0\n\tglobal_load_lds_dwordx4 %1, off\n\ts_mov_b32 m0, %0":"=&s"(keep):"v"(gsrc),"s"(lds_dst):"memory");}
__device__ __forceinline__ float max3f(float a,float b,float c){float r;asm("v_max3_f32 %0, %1, %2, %3":"=v"(r):"v"(a),"v"(b),"v"(c));return r;}
__device__ __forceinline__ float max2f(float a,float b){float r;asm("v_max_f32_e32 %0, %1, %2":"=v"(r):"v"(a),"v"(b));return r;}
__device__ __forceinline__ float fadd_s(float a,float b){float r;asm("v_add_f32_e32 %0, %1, %2":"=v"(r):"v"(a),"v"(b));return r;}
__device__ __forceinline__ float fsub_s(float a,float b){float r;asm("v_sub_f32_e32 %0, %1, %2":"=v"(r):"v"(a),"v"(b));return r;}
typedef float f32x2_t __attribute__((ext_vector_type(2))); typedef __bf16 bf16x2_t __attribute__((ext_vector_type(2)));
__device__ __forceinline__ unsigned cvtpk_s(float lo,float hi){f32x2_t v={lo,hi};bf16x2_t b=__builtin_convertvector(v,bf16x2_t);return __builtin_bit_cast(unsigned,b);}
#define WAIT_BAR(N) asm volatile("s_waitcnt vmcnt(" #N ") lgkmcnt(0)\n\ts_barrier":::"memory")

__device__ __forceinline__ void qkt(f32x16&p0,f32x16&p1,const char*Kslot,const bf16x8*qr,const f32x16&negm,int r32,int hi){
  const char*kb=Kslot+hi*1024+r32*16;
  #pragma unroll
  for(int d0=0;d0<4;++d0){
    const bf16x8 b0=*reinterpret_cast<const bf16x8*>(kb+d0*2048);
    const bf16x8 b1=*reinterpret_cast<const bf16x8*>(kb+d0*2048+512);
    if(d0==0){p0=__builtin_amdgcn_mfma_f32_32x32x16_bf16(b0,qr[0],negm,0,0,0);p1=__builtin_amdgcn_mfma_f32_32x32x16_bf16(b1,qr[0],negm,0,0,0);}
    else{p0=__builtin_amdgcn_mfma_f32_32x32x16_bf16(b0,qr[d0],p0,0,0,0);p1=__builtin_amdgcn_mfma_f32_32x32x16_bf16(b1,qr[d0],p1,0,0,0);}}
}
typedef __attribute__((address_space(3))) const char* lds_cptr;
typedef short v4i16_t __attribute__((ext_vector_type(4)));
__device__ __forceinline__ void kload8(bf16x8*kf,lds_cptr kp){
  kf[0]=*(const __attribute__((address_space(3))) bf16x8*)(kp);      kf[1]=*(const __attribute__((address_space(3))) bf16x8*)(kp+512);
  kf[2]=*(const __attribute__((address_space(3))) bf16x8*)(kp+2048); kf[3]=*(const __attribute__((address_space(3))) bf16x8*)(kp+2560);
  kf[4]=*(const __attribute__((address_space(3))) bf16x8*)(kp+4096); kf[5]=*(const __attribute__((address_space(3))) bf16x8*)(kp+4608);
  kf[6]=*(const __attribute__((address_space(3))) bf16x8*)(kp+6144); kf[7]=*(const __attribute__((address_space(3))) bf16x8*)(kp+6656);
}
__device__ __forceinline__ void kload2(bf16x8*kf,lds_cptr kp,int j){ kf[2*j]=*(const __attribute__((address_space(3))) bf16x8*)(kp+j*2048); kf[2*j+1]=*(const __attribute__((address_space(3))) bf16x8*)(kp+j*2048+512); }
__device__ __forceinline__ s16x4 vtr(lds_cptr p){ return __builtin_bit_cast(s16x4,__builtin_amdgcn_ds_read_tr16_b64_v4i16((__attribute__((address_space(3))) v4i16_t*)p)); }
__device__ __forceinline__ float rowmax(const f32x16&p0,const f32x16&p1){
  float a=max3f(p0[0],p0[1],p1[0]),b=max3f(p0[2],p0[3],p1[1]);a=max3f(a,p1[2],p1[3]);
  #pragma unroll
  for(int r=4;r<16;r+=4){a=max3f(a,p0[r],p0[r+1]);b=max3f(b,p0[r+2],p0[r+3]);a=max3f(a,p1[r],p1[r+1]);b=max3f(b,p1[r+2],p1[r+3]);}
  const float m=max2f(a,b);
  auto rr=__builtin_amdgcn_permlane32_swap(__float_as_uint(m),__float_as_uint(m),false,false);
  return max2f(__uint_as_float(rr[0]),__uint_as_float(rr[1]));
}
__device__ __forceinline__ void pv(f32x16*o,int vb,bf16x8 pa0,bf16x8 pa1,bf16x8 pa2,bf16x8 pa3){
  #pragma unroll
  for(int d0=0;d0<2;++d0){s16x4 lo[4],hi[4];
    #pragma unroll
    for(int ks=0;ks<4;++ks){
      asm volatile("ds_read_b64_tr_b16 %0,%1 offset:%c2":"=&v"(lo[ks]):"v"(vb),"i"(d0*4096+ks*1024):"memory");
      asm volatile("ds_read_b64_tr_b16 %0,%1 offset:%c2":"=&v"(hi[ks]):"v"(vb),"i"(d0*4096+ks*1024+512):"memory");}
    asm volatile("s_waitcnt lgkmcnt(0)":::"memory");SBAR();
    #define PK(k) (bf16x8){lo[k][0],lo[k][1],lo[k][2],lo[k][3],hi[k][0],hi[k][1],hi[k][2],hi[k][3]}
    o[d0]=__builtin_amdgcn_mfma_f32_32x32x16_bf16(pa0,PK(0),o[d0],0,0,0);
    o[d0]=__builtin_amdgcn_mfma_f32_32x32x16_bf16(pa1,PK(1),o[d0],0,0,0);
    o[d0]=__builtin_amdgcn_mfma_f32_32x32x16_bf16(pa2,PK(2),o[d0],0,0,0);
    o[d0]=__builtin_amdgcn_mfma_f32_32x32x16_bf16(pa3,PK(3),o[d0],0,0,0);
    #undef PK
  }
}

#ifndef ATTN_STORE16
#define ATTN_STORE16(p,v) (*(u32x4*)(p)=(v))
#endif
template<int THRL> __device__ __forceinline__ void attn_unit(const bf16*Q0,int qp,const bf16*__restrict__ K0,int kp,const bf16*__restrict__ V0,int vp,bf16*O0,int op,const int NT,char*shm){
  int tid_=threadIdx.x; asm volatile("":"+v"(tid_)); const int tid=tid_,lane=tid&63,r32=lane&31,hi=lane>>5; const int wid=__builtin_amdgcn_readfirstlane(tid>>6);
  const bf16*Qw=Q0+(long)(wid*QBLK)*qp;
  const bf16*Kh=K0,*Vh=V0;
  const unsigned lds0=(unsigned)(uintptr_t)shm;
  float*wsf=(float*)(shm+LDS_WS)+wid*64;
  const bf16*ksrc=Kh+(long)lane*kp+wid*8;
  const bf16*vsrc=Vh+(long)(16*(wid&3)+(lane>>2))*vp+(wid>>2)*32+(lane&3)*8;
  const unsigned kdst=lds0+LDS_K+wid*1024, vdst=lds0+LDS_V+wid*1024;
  #define DMA_K(t,slot) glds16(ksrc+(long)(t)*KVBLK*kp,(unsigned)__builtin_amdgcn_readfirstlane(kdst+(slot)))
  #define DMA_V(t,slot) glds16(vsrc+(long)(t)*KVBLK*vp,(unsigned)__builtin_amdgcn_readfirstlane(vdst+(slot)))
  const int vb0=(int)(lds0+LDS_V)+((lane>>4)&1)*32+(lane&3)*8+(4*hi+((lane&15)>>2))*64;
  const char*Kbase=shm+LDS_K; bf16x8 kf[8];
  const lds_cptr shm3=(lds_cptr)shm; const lds_cptr kp0=shm3+LDS_K+hi*1024+r32*16; const lds_cptr vp0=shm3+LDS_V+((lane>>4)&1)*32+(lane&3)*8+(4*hi+((lane&15)>>2))*64;
  DMA_K(0,0);DMA_V(0,0);DMA_K(1,SLOTB);
  bf16x8 qr[4];
  #pragma unroll
  for(int d0=0;d0<4;++d0)qr[d0]=*reinterpret_cast<const bf16x8*>(&Qw[(long)r32*qp+d0*16+hi*8]);
  float mhat=0.f,l_reg=0.f;f32x16 o[2];o[0]=f32x16{};o[1]=f32x16{};f32x16 negm=f32x16{};asm volatile("":"+v"(negm));
  #define CMASK(P0,P1,t) do{}while(0)
  bool resc=false;
  #define START(P0,P1) do{ const float rm=rowmax(P0,P1); resc=false; \
    { const float dl=rm; mhat=fadd_s(mhat,dl); \
      _Pragma("unroll") for(int r=0;r<16;++r){P0[r]=fsub_s(P0[r],dl);P1[r]=fsub_s(P1[r],dl);} \
      _Pragma("unroll") for(int r=0;r<16;++r)negm[r]=-mhat; asm volatile("":"+v"(negm)); } \
    _Pragma("unroll") for(int r=0;r<16;++r)P0[r]=__builtin_amdgcn_exp2f(P0[r]); }while(0)
  #define RESC() do{ if(resc){ asm volatile("s_waitcnt lgkmcnt(0)":::"memory"); \
      _Pragma("unroll") for(int d_=0;d_<2;++d_) _Pragma("unroll") for(int r=0;r<16;++r)o[d_][r]*=wsf[crow(r,hi)]; } }while(0)
  f32x16 pA0,pA1,pB0,pB1;
  int sl_prev=0,sl_cur=0,sl_next=SLOTB;
  #define ROT() do{sl_prev=sl_cur;sl_cur=sl_next;sl_next=(sl_next==(NSLOT-1)*SLOTB)?0:sl_next+SLOTB;}while(0)
  DMA_K(2,2*SLOTB);
  WAIT_BAR(3);
  qkt(pA0,pA1,Kbase,qr,negm,r32,hi);asm volatile("s_nop 15\n\ts_nop 7":"+v"(pA0),"+v"(pA1));CMASK(pA0,pA1,0);
  START(pA0,pA1);
  _Pragma("unroll") for(int r=0;r<16;++r)pA1[r]=__builtin_amdgcn_exp2f(pA1[r]);
  WAIT_BAR(0);
  DMA_K(3,0);DMA_V(1,SLOTB);
  ROT();
  kload8(kf,kp0+sl_cur);
  WAIT_BAR(2);
  s16x4 vlo[8],vhi[8]; u32x4 pw0,pw1,pw2,pw3;
  #define PKW(P,B) cvtpk_s(P[B],P[B+1])
  #define PAF(k) __builtin_bit_cast(bf16x8,pw##k)
  #define VFR(i) (bf16x8){vlo[i][0],vlo[i][1],vlo[i][2],vlo[i][3],vhi[i][0],vhi[i][1],vhi[i][2],vhi[i][3]}
  #define PIN(x) asm volatile("":"+v"(x))
  #define MX3(a,b,c) __builtin_fmaxf(__builtin_fmaxf((a),(b)),(c))
  #define GAPA(MF,A0,A1,A2,A3,W0,W1,PW) do{ MF; sacc+=A0; sacc+=A1; sacc+=A2; sacc+=A3; PIN(sacc); W0; W1; PIN(PW); SBAR(); }while(0)
  #define EX(v) __builtin_amdgcn_exp2f(v)
  #define GAPB(MF,X,B) do{ MF; X[B]=EX(X[B]); X[B+1]=EX(X[B+1]); X[B+2]=EX(X[B+2]); X[B+3]=EX(X[B+3]); PIN(X); SBAR(); }while(0)
  #define VRD(i) do{ vlo[i]=vtr(vp_+(((i)>>2)*4096+((i)&3)*1024)); vhi[i]=vtr(vp_+(((i)>>2)*4096+((i)&3)*1024+512)); }while(0)
  #define KRD(G,j) do{ if(G){ kload2(kf,kp0+sl_next,j); SBAR(); } }while(0)
  #define STEP(C0,C1,P0,P1,t,GK,GV,GL) do{ SBAR(); \
    const lds_cptr vp_=vp0+sl_prev; \
    VRD(0); SBAR(); float sacc=(P0[0]+P0[1]); \
    GAPA(C0=__builtin_amdgcn_mfma_f32_32x32x16_bf16(kf[0],qr[0],negm,0,0,0), P0[2],P0[3],P0[4],P0[5],     pw0[0]=PKW(P0,0), pw0[1]=PKW(P0,2), pw0); \
    VRD(4); SBAR(); GAPA(C1=__builtin_amdgcn_mfma_f32_32x32x16_bf16(kf[1],qr[0],negm,0,0,0), P0[6],P0[7],P0[8],P0[9],     pw0[2]=PKW(P0,4), pw0[3]=PKW(P0,6), pw0); \
    VRD(1); SBAR(); GAPA(C0=__builtin_amdgcn_mfma_f32_32x32x16_bf16(kf[2],qr[1],C0,0,0,0),   P0[10],P0[11],P0[12],P0[13], pw1[0]=PKW(P0,8), pw1[1]=PKW(P0,10), pw1); \
    VRD(5); SBAR(); GAPA(C1=__builtin_amdgcn_mfma_f32_32x32x16_bf16(kf[3],qr[1],C1,0,0,0),   P0[14],P0[15],P1[0],P1[1],   pw1[2]=PKW(P0,12),pw1[3]=PKW(P0,14), pw1); \
    VRD(2); SBAR(); GAPA(C0=__builtin_amdgcn_mfma_f32_32x32x16_bf16(kf[4],qr[2],C0,0,0,0),   P1[2],P1[3],P1[4],P1[5],     pw2[0]=PKW(P1,0), pw2[1]=PKW(P1,2), pw2); \
    VRD(6); SBAR(); GAPA(C1=__builtin_amdgcn_mfma_f32_32x32x16_bf16(kf[5],qr[2],C1,0,0,0),   P1[6],P1[7],P1[8],P1[9],     pw2[2]=PKW(P1,4), pw2[3]=PKW(P1,6), pw2); \
    VRD(3); SBAR(); GAPA(C0=__builtin_amdgcn_mfma_f32_32x32x16_bf16(kf[6],qr[3],C0,0,0,0),   P1[10],P1[11],P1[12],P1[13], pw3[0]=PKW(P1,8), pw3[1]=PKW(P1,10), pw3); \
    VRD(7); SBAR(); GAPA(C1=__builtin_amdgcn_mfma_f32_32x32x16_bf16(kf[7],qr[3],C1,0,0,0),   P1[14],P1[15],0.f,0.f,       pw3[2]=PKW(P1,12),pw3[3]=PKW(P1,14), pw3); \
    l_reg+=sacc; \
    if(GK){DMA_K((t)+3,sl_cur);} if(GV){DMA_V((t)+1,sl_next);} \
    CMASK(C0,C1,t); \
    { float a=MX3(C0[0],C0[1],C1[0]),b=MX3(C0[2],C0[3],C1[1]); a=MX3(a,C1[2],C1[3]); \
      _Pragma("unroll") for(int r=4;r<16;r+=4){a=MX3(a,C0[r],C0[r+1]);b=MX3(b,C0[r+2],C0[r+3]);a=MX3(a,C1[r],C1[r+1]);b=MX3(b,C1[r+2],C1[r+3]);} \
      float rm=__builtin_fmaxf(a,b); { auto rr=__builtin_amdgcn_permlane32_swap(__float_as_uint(rm),__float_as_uint(rm),false,false); rm=__builtin_fmaxf(__uint_as_float(rr[0]),__uint_as_float(rr[1])); } \
      resc=false; \
      if(__builtin_expect(__any(rm>(float)THRL),0)){ const float dl=__builtin_fmaxf(rm,0.f); mhat+=dl; \
        _Pragma("unroll") for(int r=0;r<16;++r){C0[r]-=dl;C1[r]-=dl;} \
        _Pragma("unroll") for(int r=0;r<16;++r)negm[r]=-mhat; asm volatile("":"+v"(negm)); \
        const float f=__builtin_amdgcn_exp2f(-dl); l_reg*=f; if(hi==0)wsf[r32]=f; resc=true; } } \
    SBAR(); \
    GAPB(o[0]=__builtin_amdgcn_mfma_f32_32x32x16_bf16(PAF(0),VFR(0),o[0],0,0,0), C0,0); \
    GAPB(o[1]=__builtin_amdgcn_mfma_f32_32x32x16_bf16(PAF(0),VFR(4),o[1],0,0,0), C0,4); \
    KRD(GL,0); GAPB(o[0]=__builtin_amdgcn_mfma_f32_32x32x16_bf16(PAF(1),VFR(1),o[0],0,0,0), C0,8); \
    KRD(GL,1); GAPB(o[1]=__builtin_amdgcn_mfma_f32_32x32x16_bf16(PAF(1),VFR(5),o[1],0,0,0), C0,12); \
    KRD(GL,2); GAPB(o[0]=__builtin_amdgcn_mfma_f32_32x32x16_bf16(PAF(2),VFR(2),o[0],0,0,0), C1,0); \
    KRD(GL,3); GAPB(o[1]=__builtin_amdgcn_mfma_f32_32x32x16_bf16(PAF(2),VFR(6),o[1],0,0,0), C1,4); \
    GAPB(o[0]=__builtin_amdgcn_mfma_f32_32x32x16_bf16(PAF(3),VFR(3),o[0],0,0,0), C1,8); \
    GAPB(o[1]=__builtin_amdgcn_mfma_f32_32x32x16_bf16(PAF(3),VFR(7),o[1],0,0,0), C1,12); \
    }while(0)
  int t=1;
  #undef CMASK
  #define CMASK(P0,P1,t) do{}while(0)
  for(;t+5<NT;t+=2){
    STEP(pB0,pB1,pA0,pA1,t,true,true,true);     WAIT_BAR(2); RESC(); ROT();
    STEP(pA0,pA1,pB0,pB1,t+1,true,true,true);   WAIT_BAR(2); RESC(); ROT();
  }
  #undef CMASK
  #define CMASK(P0,P1,t) do{}while(0)
  #define ENDW(tt) do{ if((tt)+3<NT){WAIT_BAR(2);} else if((tt)+2<NT){WAIT_BAR(1);} else {WAIT_BAR(0);} }while(0)
  for(;t+1<NT;t+=2){
    STEP(pB0,pB1,pA0,pA1,t,(t+3<NT),(t+1<NT),(t+1<NT));       ENDW(t);   RESC(); ROT();
    STEP(pA0,pA1,pB0,pB1,t+1,(t+4<NT),(t+2<NT),(t+2<NT));     ENDW(t+1); RESC(); ROT();
  }
  STEP(pB0,pB1,pA0,pA1,NT-1,false,false,false); RESC();
  { float sacc=pB0[0]+pB0[1]; _Pragma("unroll") for(int r=2;r<16;++r)sacc+=pB0[r]; _Pragma("unroll") for(int r=0;r<16;++r)sacc+=pB1[r]; l_reg+=sacc;
    pw0=(u32x4){PKW(pB0,0),PKW(pB0,2),PKW(pB0,4),PKW(pB0,6)};pw1=(u32x4){PKW(pB0,8),PKW(pB0,10),PKW(pB0,12),PKW(pB0,14)};pw2=(u32x4){PKW(pB1,0),PKW(pB1,2),PKW(pB1,4),PKW(pB1,6)};pw3=(u32x4){PKW(pB1,8),PKW(pB1,10),PKW(pB1,12),PKW(pB1,14)};
    SBAR(); pv(o,vb0+sl_cur,PAF(0),PAF(1),PAF(2),PAF(3)); }
  #undef PKW
  #undef PAF
  #undef VFR
  #undef PIN
  #undef MX3
  #undef GAPA
  #undef GAPB
  #undef EX
  #undef VRD
  #undef KRD
  #undef STEP
  #undef ENDW
  {auto rr=__builtin_amdgcn_permlane32_swap(__float_as_uint(l_reg),__float_as_uint(l_reg),false,false);l_reg=__uint_as_float(rr[0])+__uint_as_float(rr[1]);}
  if(hi==0)wsf[32+r32]=l_reg;asm volatile("s_waitcnt lgkmcnt(0)":::"memory");
  float rli[16];
  #pragma unroll
  for(int r=0;r<16;++r)rli[r]=__builtin_amdgcn_rcpf(wsf[32+crow(r,hi)]);
  bf16*Ow=O0+(long)(wid*QBLK)*op;
  { bf16*stg=(bf16*)(shm+LDS_OST)+wid*2048;
    #pragma unroll
    for(int r=0;r<16;++r){const int orow=crow(r,hi);
      #pragma unroll
      for(int d0=0;d0<2;++d0)stg[orow*64+d0*32+r32]=__float2bfloat16(o[d0][r]*rli[r]);}
    asm volatile("s_waitcnt lgkmcnt(0)":::"memory");
    #pragma unroll
    for(int i=0;i<4;++i){const int row=i*8+(lane>>3),ch=lane&7; const u32x4 v=*(const u32x4*)(stg+row*64+ch*8); ATTN_STORE16(Ow+(long)row*op+ch*8,v);} }
  asm volatile("s_waitcnt lgkmcnt(0)\n\ts_barrier":::"memory");
  #undef DMA_K
  #undef DMA_V
  #undef CMASK
  #undef START
  #undef RESC
  #undef ROT
}
#undef SBAR
#undef WAIT_BAR
}

constexpr size_t MiB = 1u << 20;
constexpr size_t WS_CTL = 0, CTL_ZERO_BYTES = 1 * MiB;
constexpr size_t WS_MOD = 1 * MiB;
constexpr size_t WS_TAB = 1 * MiB + 256 * 1024;
constexpr size_t WS_LAM = 1 * MiB + 272 * 1024;
constexpr size_t WS_ME = 2 * MiB, WS_MP = 2 * MiB + 128 * 1024, WS_MW = 2 * MiB + 256 * 1024;
constexpr size_t WS_WIN = 4 * MiB;
constexpr size_t WS_WPRJ = 30 * MiB;
constexpr size_t WS_W13 = 42 * MiB;
constexpr size_t WS_W2F = 53 * MiB;
constexpr size_t WS_XC = 60 * MiB;
constexpr size_t WS_H = 64 * MiB;
constexpr size_t WS_P = 98 * MiB;
constexpr size_t WS_OA = 319 * MiB;
constexpr size_t WS_MX = 421 * MiB;
constexpr size_t WS_U = 98 * MiB;
constexpr size_t WS_MW2 = 4 * MiB;
constexpr size_t WS_HS = 98 * MiB;
constexpr size_t WS_U2 = 166 * MiB;
constexpr size_t WS_MW13 = 404 * MiB;
constexpr size_t WS_END = 516 * MiB;
static_assert(WS_P + (size_t)MEXT * INW * 2 <= WS_OA && WS_OA + (size_t)MEXT * OAW * 2 <= WS_MX && WS_MX + (size_t)MEXT * DM * 2 <= WS_END, "attention-phase map");
static_assert(WS_HS + (size_t)MOE_ROWS * DM * 2 <= WS_U2 && WS_U2 + (size_t)MOE_ROWS * DFE * 2 <= WS_MW13 && WS_MW13 + (size_t)NEXP * 2 * DFE * DM * 2 <= WS_END && WS_MW2 + (size_t)NEXP * DFE * DM * 2 <= WS_XC, "MoE-phase map");
static_assert(WS_W2F + (size_t)DM * DFF * 2 <= WS_XC && WS_U + (size_t)MEXT * DFF * 2 <= WS_OA && WS_H + (size_t)MEXT * DM * 2 <= WS_P, "dense map");
constexpr int CW_BAR = 4096;
constexpr int CW_MOE = 8192;

constexpr int NWAVES = 8;
constexpr int RING_OFF = 0, RING_BYTES = 131072;
constexpr int LDSCTL_OFF = RING_BYTES, MISC_OFF = LDSCTL_OFF + 320;
constexpr int LDS_BYTES = 147456;
static_assert(MISC_OFF + 128 <= LDS_BYTES, "LDS map");

#define GAS __attribute__((address_space(1)))
#define LAS __attribute__((address_space(3)))
typedef unsigned short bf16;
typedef unsigned v4u __attribute__((ext_vector_type(4)));
typedef float f32x4 __attribute__((ext_vector_type(4)));
typedef short bf16x8 __attribute__((ext_vector_type(8)));
typedef GAS unsigned gu32;
typedef GAS unsigned long long gu64;
#define RLX_AGENT __ATOMIC_RELAXED, __HIP_MEMORY_SCOPE_AGENT
#define LDS_WAIT() asm volatile("s_waitcnt lgkmcnt(0)" ::: "memory")
#define VM_WAIT() asm volatile("s_waitcnt vmcnt(0)" ::: "memory")
__device__ __forceinline__ unsigned long long rt() { return __builtin_amdgcn_s_memrealtime(); }
__device__ __forceinline__ unsigned f2bf(float f) { unsigned u = __builtin_bit_cast(unsigned, f); return (u + 0x7fffu + ((u >> 16) & 1u)) >> 16; }
__device__ __forceinline__ unsigned pk2(float lo, float hi) { return f2bf(lo) | (f2bf(hi) << 16); }

#define XB_TMO      128
#define XB_XCNT(j)  (256  + 64 * (j))
#define XB_XSUB(j)  (1280 + 64 * (j))
#define XB_XGEN(j)  (2304 + 64 * (j))
#define XB_TOP      3328
#define XB_TOPGEN   3392
#define XCD_BAR_WORDS 3456
#define XB_SPIN_CAP (1u << 22)

__device__ __forceinline__ unsigned xb_ld(unsigned* p)              { return __hip_atomic_load(p, __ATOMIC_RELAXED, __HIP_MEMORY_SCOPE_AGENT); }
__device__ __forceinline__ unsigned xb_add(unsigned* p, unsigned v) { return __hip_atomic_fetch_add(p, v, __ATOMIC_RELAXED, __HIP_MEMORY_SCOPE_AGENT); }
__device__ __forceinline__ unsigned xb_xcc_id() { return (unsigned)__builtin_amdgcn_s_getreg((3 << 11) | 20) & 0xFu; }
#define XB_SPIN(cond, bar) do { unsigned _sp = 0; while (cond) { __builtin_amdgcn_s_sleep(1); \
    if ((++_sp & 255u) == 0u) { if (xb_ld(&(bar)[XB_TMO])) break; if (_sp > XB_SPIN_CAP) { atomicAdd(&(bar)[XB_TMO], 1u); break; } } } } while (0)

struct XcdBarrier {
    unsigned* bar; unsigned x;
    volatile LAS unsigned* st;
};

__device__ __forceinline__ XcdBarrier xcd_barrier_post(unsigned* bar, volatile LAS unsigned* st) {
    XcdBarrier b; b.bar = bar; b.x = xb_xcc_id(); b.st = st;
    if (threadIdx.x == 0) (void)xb_add(&bar[XB_XCNT(b.x)], 1u);
    return b;
}
__device__ __forceinline__ void xcd_barrier_complete(unsigned* bar, unsigned x, unsigned& nloc, unsigned& nx) {
    const unsigned G = gridDim.x * gridDim.y * gridDim.z;
    unsigned sum, cnt, mine, sp = 0u;
    for (;;) {
        sum = 0u; cnt = 0u; mine = 0u;
#pragma unroll
        for (unsigned j = 0; j < 16; ++j) { const unsigned c = xb_ld(&bar[XB_XCNT(j)]); sum += c; cnt += (c > 0u) ? 1u : 0u; mine = (j == x) ? c : mine; }
        if (sum == G) break;
        __builtin_amdgcn_s_sleep(1);
        if ((++sp & 255u) == 0u) { if (xb_ld(&bar[XB_TMO])) break; if (sp > XB_SPIN_CAP) { atomicAdd(&bar[XB_TMO], 1u); break; } }
    }
    nloc = mine > 0u ? mine : 1u; nx = cnt > 0u ? cnt : 1u;
}

__device__ __forceinline__ void xcd_barrier(const XcdBarrier& b) {
    asm volatile("s_waitcnt vmcnt(0)" ::: "memory");
    __syncthreads();
    if (threadIdx.x == 0) {
        unsigned* bar = b.bar;
        __builtin_amdgcn_s_waitcnt(0);
        unsigned nloc = b.st[0], nx = b.st[1];
        if (nloc == 0u) { xcd_barrier_complete(bar, b.x, nloc, nx); b.st[0] = nloc; b.st[1] = nx; }
        const unsigned old = xb_add(&bar[XB_XSUB(b.x)], 1u);
        const unsigned gen = old / nloc;
        if (old + 1u == (gen + 1u) * nloc) {
            __builtin_amdgcn_fence(__ATOMIC_RELEASE, "agent");
            asm volatile("s_waitcnt vmcnt(0)" ::: "memory");
            const unsigned og = xb_add(&bar[XB_TOP], 1u);
            const unsigned tg = og / nx;
            if (og + 1u == (tg + 1u) * nx) xb_add(&bar[XB_TOPGEN], 1u);
            else XB_SPIN(xb_ld(&bar[XB_TOPGEN]) == tg, bar);
            __builtin_amdgcn_fence(__ATOMIC_ACQUIRE, "agent");
            xb_add(&bar[XB_XGEN(b.x)], 1u);
            asm volatile("s_waitcnt vmcnt(0)" ::: "memory");
        } else {
            XB_SPIN(xb_ld(&bar[XB_XGEN(b.x)]) == gen, bar);
            __builtin_amdgcn_fence(__ATOMIC_ACQUIRE, "agent");
            asm volatile("s_waitcnt vmcnt(0)" ::: "memory");
        }
    }
    __syncthreads();
}

__device__ __forceinline__ float wave_sum(float v) {
#pragma unroll
    for (int o = 1; o < 64; o <<= 1) v += __shfl_xor(v, o);
    return v;
}
__device__ __forceinline__ unsigned pkbf(float lo, float hi) { return pg8::cvt_pk_bf16(lo, hi); }
__device__ __forceinline__ int dst_row0(int mode, int n0) {
    if (mode == 0) return n0;
    if (mode == 1) { const int t = n0 >> 8, blk = (n0 & 255) >> 5, wc = blk >> 1, bj = blk & 1; return (t << 8) + 32 * (4 * bj + wc); }
    const int r = ((n0 >> 7) << 8) + (n0 & 127); return mode == 2 ? r : r + 128;
}
__device__ __forceinline__ void transpose_item(const float* W, int K, int N, bf16* WT, int mode, LAS float* scr, int item, int lane) {
    const int nblk = N / 32, kb = item / nblk, nb = item % nblk, k0 = 64 * kb, n0 = 32 * nb, d0 = dst_row0(mode, n0);
#pragma unroll 8
    for (int i = 0; i < 32; ++i) { const int kk = 2 * i + (lane >> 5); scr[kk * 33 + (lane & 31)] = W[(size_t)(k0 + kk) * N + n0 + (lane & 31)]; }
    LDS_WAIT(); asm volatile("" ::: "memory");
    const int c = lane & 7;
#pragma unroll
    for (int j = 0; j < 4; ++j) { const int n = (lane >> 3) + 8 * j; const LAS float* s = scr + (8 * c) * 33 + n;
        v4u o; o.x = pkbf(s[0 * 33], s[1 * 33]); o.y = pkbf(s[2 * 33], s[3 * 33]); o.z = pkbf(s[4 * 33], s[5 * 33]); o.w = pkbf(s[6 * 33], s[7 * 33]);
        *(GAS v4u*)(WT + (size_t)(d0 + n) * K + k0 + 8 * c) = o; }
    LDS_WAIT(); asm volatile("" ::: "memory");
}
__device__ __forceinline__ void norm_mod_row(const float* xrow, const float* g, const float* sh, const float* sc, bf16* orow, int lane, f32x4 (&h)[4]) {
    const GAS f32x4* xr = (const GAS f32x4*)xrow + lane; float ss = 0.f;
#pragma unroll
    for (int j = 0; j < 4; ++j) { h[j] = xr[64 * j]; ss += (h[j].x * h[j].x + h[j].y * h[j].y) + (h[j].z * h[j].z + h[j].w * h[j].w); }
    const float rs = 1.f / sqrtf(wave_sum(ss) * (1.f / DM) + EPS);
    GAS unsigned long long* o8 = (GAS unsigned long long*)orow + lane;
#pragma unroll
    for (int j = 0; j < 4; ++j) { const f32x4 g4 = ((const GAS f32x4*)g)[lane + 64 * j], s4 = ((const GAS f32x4*)sc)[lane + 64 * j], b4 = ((const GAS f32x4*)sh)[lane + 64 * j];
        h[j] = h[j] * rs * g4 * (s4 + 1.f) + b4;
        o8[64 * j] = (unsigned long long)pkbf(h[j].x, h[j].y) | ((unsigned long long)pkbf(h[j].z, h[j].w) << 32); }
}
struct Args { const float* in[24]; float* out; unsigned char* ws; };
enum { I_X = 0, I_C, I_CTX, I_CCTX, I_ADAW, I_ADAB, I_NAG, I_NFG, I_WIN, I_QNG, I_KNG, I_DLAM, I_SUBG, I_WPD, I_WPG, I_WO, I_FW1, I_FW3, I_FW2, I_ROUTER, I_MW1, I_MW3, I_MW2, I_FNG };

#define CAS __attribute__((address_space(4)))
#define PH_BEGIN \
    const CAS Args* ap = (const CAS Args*)__builtin_amdgcn_kernarg_segment_ptr(); asm volatile("" : "+s"(ap)); \
    unsigned char* const ws = (unsigned char*)(GAS unsigned char*)ap->ws; \
    int tid = threadIdx.x; asm volatile("" : "+v"(tid)); \
    const int lane = tid & 63, wave = __builtin_amdgcn_readfirstlane(tid >> 6); \
    const int G = gridDim.x, bx = blockIdx.x, vcu = (G % 8 == 0) ? (bx % 8) * (G / 8) + bx / 8 : bx, gw = vcu * NWAVES + wave, NGW = G * NWAVES; \
    (void)lane; (void)gw; (void)NGW; (void)bx; (void)ws;
#define INP(i) ((const float*)(const GAS float*)ap->in[i])
#define WSP(T, off) ((T*)(ws + (off)))
#define LDSP ((LAS unsigned char*)lds)

__global__ void __launch_bounds__(NWAVES * 64, 2) fwd_kernel(Args args) {
    extern __shared__ __attribute__((aligned(16))) unsigned char lds[];
    for (int u = threadIdx.x; u < (LDS_BYTES - LDSCTL_OFF) / 4; u += NWAVES * 64) ((LAS unsigned*)(LDSP + LDSCTL_OFF))[u] = 0u;
    __syncthreads();
    const XcdBarrier bar = xcd_barrier_post((unsigned*)(args.ws + WS_CTL) + CW_BAR, (volatile LAS unsigned*)(LDSP + MISC_OFF) + 8);
#define GRID_BAR() do { XcdBarrier b_ = bar; asm volatile("" : "+s"(b_.bar), "+s"(b_.x)); b_.bar = (unsigned*)(GAS unsigned*)b_.bar; xcd_barrier(b_); } while (0)

#define D_MOD WSP(float, WS_MOD)
#define D_TAB WSP(float, WS_TAB)
#define D_LAM WSP(float, WS_LAM)
#define D_H WSP(bf16, WS_H)
#define D_P WSP(bf16, WS_P)
#define D_OA WSP(bf16, WS_OA)
#define D_MX WSP(bf16, WS_MX)
#define D_XC WSP(float, WS_XC)
#define D_X ((float*)(GAS float*)ap->out)
#define D_SCR ((LAS float*)(LDSP + RING_OFF + wave * 8448))
#define D_MODL (D_MOD + (size_t)l * 5 * 6144)
#define D_CNT ((gu32*)(GAS unsigned*)(ws + WS_CTL) + CW_MOE)
#define D_ME WSP(int2, WS_ME)
#define D_MP WSP(int2, WS_MP)
#define D_MW WSP(float2, WS_MW)
#define PS_LOAD int ps[9]; ps[0] = 0; _Pragma("unroll") for (int e_ = 0; e_ < 8; ++e_) { const int n_ = (int)__builtin_amdgcn_readfirstlane(__hip_atomic_load(D_CNT + 64 * e_, RLX_AGENT)); ps[e_ + 1] = ps[e_] + ((n_ + 255) >> 8); }
    {
        PH_BEGIN
        LAS float* const st = (LAS float*)(LDSP + RING_OFF + 69632);
        for (int i = tid; i < 5 * DM; i += NWAVES * 64) { const float x = i < 4 * DM ? INP(I_C)[i] : INP(I_CCTX)[i - 4 * DM]; st[i] = x / (1.f + __expf(-x)); }
        __syncthreads();
        constexpr int N_MOD = 2 * 384, N_ROPE = 16, N_LAM = 1, N_WIN = 16 * (INW / 32), N_PRJ = 16 * 32, N_W1 = 16 * (DFF / 32), N_W2 = (DFF / 64) * 32;
        constexpr int NITEMS = N_MOD + N_ROPE + N_LAM + 2 * N_WIN + 6 * N_PRJ + 2 * N_W1 + N_W2;
        for (int it = gw; it < NITEMS; it += NGW) {
            int r = it;
            if (r < N_MOD) {
                const int l = r / 384, cb = r - l * 384, cl = lane & 15, kg = lane >> 4, col = 16 * cb + cl;
                const float* w = INP(I_ADAW) + (size_t)l * DM * 6144 + col; float a0 = 0.f, a1 = 0.f, a2 = 0.f, a3 = 0.f, a4 = 0.f;
#pragma unroll 8
                for (int k = kg; k < DM; k += 4) { const float wv = w[(size_t)k * 6144]; a0 += st[k] * wv; a1 += st[DM + k] * wv; a2 += st[2 * DM + k] * wv; a3 += st[3 * DM + k] * wv; a4 += st[4 * DM + k] * wv; }
                a0 += __shfl_xor(a0, 16); a0 += __shfl_xor(a0, 32); a1 += __shfl_xor(a1, 16); a1 += __shfl_xor(a1, 32); a2 += __shfl_xor(a2, 16); a2 += __shfl_xor(a2, 32);
                a3 += __shfl_xor(a3, 16); a3 += __shfl_xor(a3, 32); a4 += __shfl_xor(a4, 16); a4 += __shfl_xor(a4, 32);
                if (kg == 0) { const float bb = INP(I_ADAB)[l * 6144 + col]; float* m = D_MOD + (size_t)l * 5 * 6144 + col;
                    m[0] = a0 + bb; m[6144] = a1 + bb; m[2 * 6144] = a2 + bb; m[3 * 6144] = a3 + bb; m[4 * 6144] = a4 + bb; }
                continue; }
            r -= N_MOD;
            if (r < N_ROPE) { const int idx = r * 64 + lane, pos = idx >> 4, f = idx & 15; const float invf = powf(10000.f, -(float)f / 16.f), ang = (float)pos * invf;
                D_TAB[2 * idx] = cosf(ang); D_TAB[2 * idx + 1] = sinf(ang); continue; }
            r -= N_ROPE;
            if (r < N_LAM) {
                for (int l = 0; l < 2; ++l) { const float* dl = INP(I_DLAM) + l * 256; const float s1 = wave_sum(dl[lane] * dl[64 + lane]), s2 = wave_sum(dl[128 + lane] * dl[192 + lane]);
                    if (lane == 0) D_LAM[l] = expf(s1) - expf(s2) + (0.8f - 0.6f * expf(-0.3f * (float)l)); }
                continue; }
            r -= N_LAM;
            if (r < 2 * N_WIN) { const int l = r / N_WIN; transpose_item(INP(I_WIN) + (size_t)l * DM * INW, DM, INW, (bf16*)(ws + WS_WIN) + (size_t)l * INW * DM, 1, D_SCR, r - l * N_WIN, lane); continue; }
            r -= 2 * N_WIN;
            if (r < 6 * N_PRJ) { const int j = r / N_PRJ, l = j / 3, w = j - 3 * l;
                const float* src = (w == 0 ? INP(I_WPD) : w == 1 ? INP(I_WPG) : INP(I_WO)) + (size_t)l * DM * DM;
                transpose_item(src, DM, DM, (bf16*)(ws + WS_WPRJ) + (size_t)j * DM * DM, 0, D_SCR, r - j * N_PRJ, lane); continue; }
            r -= 6 * N_PRJ;
            if (r < N_W1) { transpose_item(INP(I_FW1), DM, DFF, (bf16*)(ws + WS_W13), 2, D_SCR, r, lane); continue; }
            r -= N_W1;
            if (r < N_W1) { transpose_item(INP(I_FW3), DM, DFF, (bf16*)(ws + WS_W13), 3, D_SCR, r, lane); continue; }
            r -= N_W1;
            transpose_item(INP(I_FW2), DFF, DM, (bf16*)(ws + WS_W2F), 0, D_SCR, r, lane);
        }
    }
    GRID_BAR();

    for (int l = 0; l < 2; ++l) {
        {
            PH_BEGIN
            const float* xl = l == 0 ? INP(I_X) : D_X; const float* xc = l == 0 ? INP(I_CTX) : D_XC; f32x4 hv[4];
            for (int e = gw; e < MEXT; e += NGW) { const int b = e / EXT, s = e - b * EXT; const bool lat = s < SEQ;
                const float* xrow = lat ? xl + (size_t)(b * SEQ + s) * DM : xc + (size_t)(b * CTXL + s - SEQ) * DM; const float* mv = D_MODL + (lat ? b : 4) * 6144;
                norm_mod_row(xrow, INP(I_NAG) + l * DM, mv, mv + DM, D_H + (size_t)e * DM, lane, hv); }
        }
        GRID_BAR();
        {
            PH_BEGIN
            pg8::Gemm g{(const pg8::bf16_t*)D_H, (const pg8::bf16_t*)(ws + WS_WIN) + (size_t)l * INW * DM, DM, DM, 0};
            pg8::RectOrder S; if (l == 0) S.init(NPAN, INW / 256, G, bx, 0, 0, 0); else S.init(64, INW / 256, G, bx, 1, 8, 10);
            pg8::EpiInProj E{(pg8::bf16_t*)D_P, INP(I_QNG) + l * 64, INP(I_KNG) + l * 64, D_TAB, attn_body::C2};
            pg8::gemm_phase<pg8::EpiInProj, pg8::RectOrder, true, true>(LDSP + RING_OFF, g, S, E);
        }
        GRID_BAR();
        {
            PH_BEGIN
            const int nun = l == 0 ? 3072 + 192 : 3072;
            for (int i = 0;; ++i) {
                const int Lu = i * G + vcu; if (Lu >= nun) break;
                int pair, qb; if (Lu < 3072) { pair = Lu >> 4; qb = Lu & 15; } else { pair = Lu - 3072; qb = 16; }
                const int b = pair / NHU, hu = pair - b * NHU; int qc, kc, vc, oc;
                if (hu < 32) { const int h = hu >> 2, c = (hu >> 1) & 1, vh = hu & 1; qc = PC_QD + h * 128 + c * 64; kc = PC_KD + h * 128 + c * 64; vc = PC_VD + h * 128 + vh * 64; oc = c * 1024 + h * 128 + vh * 64; }
                else { const int qh = hu - 32, gk = qh >> 2; qc = PC_QG + qh * 64; kc = PC_KG + gk * 64; vc = PC_VG + gk * 64; oc = 2048 + qh * 64; }
                const size_t qrow = (size_t)b * EXT + qb * 256, krow = (size_t)b * EXT + (qb < 16 ? 0 : SEQ); const int NT = qb < 16 ? EXT / 64 : CTXL / 64;
                attn_body::attn_unit<8>((const attn_body::bf16*)D_P + qrow * INW + qc, INW, (const attn_body::bf16*)D_P + krow * INW + kc, INW, (const attn_body::bf16*)D_P + krow * INW + vc, INW,
                                        (attn_body::bf16*)D_OA + qrow * OAW + oc, OAW, NT, (char*)lds + RING_OFF);
            }
        }
        GRID_BAR();
        {
            PH_BEGIN
            const float lam = D_LAM[l], li = 1.f - (0.8f - 0.6f * expf(-0.3f * (float)l)); const float* sg = INP(I_SUBG) + l * 128 + 16 * (lane & 7);
            f32x4 g4[4];
#pragma unroll
            for (int j = 0; j < 4; ++j) g4[j] = ((const GAS f32x4*)sg)[j];
            for (int e = gw; e < MEXT; e += NGW) { bf16* row = D_OA + (size_t)e * OAW + 16 * lane;
                const v4u ra0 = *(const GAS v4u*)row, ra1 = *(const GAS v4u*)(row + 8), rc0 = *(const GAS v4u*)(row + 1024), rc1 = *(const GAS v4u*)(row + 1032);
                f32x4 a[4], c[4]; pg8::unpack8(ra0, a[0], a[1]); pg8::unpack8(ra1, a[2], a[3]); pg8::unpack8(rc0, c[0], c[1]); pg8::unpack8(rc1, c[2], c[3]);
                float ss = 0.f;
#pragma unroll
                for (int j = 0; j < 4; ++j) { a[j] = a[j] - c[j] * lam; ss += (a[j].x * a[j].x + a[j].y * a[j].y) + (a[j].z * a[j].z + a[j].w * a[j].w); }
                ss += __shfl_xor(ss, 1); ss += __shfl_xor(ss, 2); ss += __shfl_xor(ss, 4);
                const float rs = li / sqrtf(ss * (1.f / 128.f) + EPS);
#pragma unroll
                for (int j = 0; j < 4; ++j) a[j] = a[j] * rs * g4[j];
                *(GAS v4u*)row = pg8::pack8(a[0], a[1]); *(GAS v4u*)(row + 8) = pg8::pack8(a[2], a[3]); }
        }
        GRID_BAR();
        {
            PH_BEGIN
            pg8::Gemm g{(const pg8::bf16_t*)D_OA, (const pg8::bf16_t*)(ws + WS_WPRJ) + (size_t)(l * 3 + 0) * DM * DM, DM, OAW, 0};
            pg8::RectOrder S; if (l == 0) S.init(NPAN, 4, G, bx, 0, 0, 0); else S.init(64, 4, G, bx, 1, 0, 0);
            pg8::EpiGate E{(pg8::bf16_t*)D_MX, (const pg8::bf16_t*)D_P + PC_G1, 0};
            pg8::gemm_phase<pg8::EpiGate, pg8::RectOrder, true, true>(LDSP + RING_OFF, g, S, E);
        }
        GRID_BAR();
        {
            PH_BEGIN
            pg8::Gemm g{(const pg8::bf16_t*)D_OA + 2048, (const pg8::bf16_t*)(ws + WS_WPRJ) + (size_t)(l * 3 + 1) * DM * DM, DM, OAW, 0};
            pg8::RectOrder S; if (l == 0) S.init(NPAN, 4, G, bx, 0, 0, 0); else S.init(64, 4, G, bx, 1, 0, 0);
            pg8::EpiGate E{(pg8::bf16_t*)D_MX, (const pg8::bf16_t*)D_P + PC_G2, 1};
            pg8::gemm_phase<pg8::EpiGate, pg8::RectOrder, true, true>(LDSP + RING_OFF, g, S, E);
        }
        GRID_BAR();
        {
            PH_BEGIN
            pg8::Gemm g{(const pg8::bf16_t*)D_MX, (const pg8::bf16_t*)(ws + WS_WPRJ) + (size_t)(l * 3 + 2) * DM * DM, DM, DM, 0};
            pg8::RectOrder S; if (l == 0) S.init(NPAN, 4, G, bx, 0, 0, 0); else S.init(64, 4, G, bx, 1, 0, 0);
            pg8::EpiResid E{l == 0 ? INP(I_X) : D_X, l == 0 ? INP(I_CTX) : D_XC, D_X, D_XC, D_MODL + 2 * DM};
            pg8::gemm_phase<pg8::EpiResid, pg8::RectOrder, true, true>(LDSP + RING_OFF, g, S, E);
        }
        GRID_BAR();
        if (l == 0) {
            { PH_BEGIN
              f32x4 hv[4];
              for (int e = gw; e < MEXT; e += NGW) { const int b = e / EXT, s = e - b * EXT; const bool lat = s < SEQ;
                  const float* xrow = lat ? D_X + (size_t)(b * SEQ + s) * DM : D_XC + (size_t)(b * CTXL + s - SEQ) * DM; const float* mv = D_MODL + (lat ? b : 4) * 6144;
                  norm_mod_row(xrow, INP(I_NFG) + l * DM, mv + 3 * DM, mv + 4 * DM, D_H + (size_t)e * DM, lane, hv); } }
            GRID_BAR();
            {
                PH_BEGIN
                pg8::Gemm g{(const pg8::bf16_t*)D_H, (const pg8::bf16_t*)(ws + WS_W13), DM, DM, 0};
                pg8::RectOrder S; S.init(NPAN, 2 * DFF / 256, G, bx, 0, 0, 0);
                pg8::EpiSwiGLU E{(pg8::bf16_t*)(ws + WS_U), DFF};
                pg8::gemm_phase<pg8::EpiSwiGLU, pg8::RectOrder, true, true>(LDSP + RING_OFF, g, S, E);
            }
            GRID_BAR();
            {
                PH_BEGIN
                pg8::Gemm g{(const pg8::bf16_t*)(ws + WS_U), (const pg8::bf16_t*)(ws + WS_W2F), DFF, DFF, 0};
                pg8::RectOrder S; S.init(NPAN, 4, G, bx, 0, 0, 0);
                pg8::EpiResid E{D_X, D_XC, D_X, D_XC, D_MODL + 5 * DM};
                pg8::gemm_phase<pg8::EpiResid, pg8::RectOrder, true, true>(LDSP + RING_OFF, g, S, E);
            }
            GRID_BAR();
        } else {
            { PH_BEGIN
              f32x4 hv[4]; const float* router = INP(I_ROUTER);
              for (int t = gw; t < MLAT; t += NGW) { const int b = t / SEQ; const float* mv = D_MODL + b * 6144;
                  norm_mod_row(D_X + (size_t)t * DM, INP(I_NFG) + l * DM, mv + 3 * DM, mv + 4 * DM, D_H + (size_t)t * DM, lane, hv);
                  float lg[8];
#pragma unroll
                  for (int e = 0; e < 8; ++e) lg[e] = 0.f;
#pragma unroll
                  for (int j = 0; j < 4; ++j)
#pragma unroll
                      for (int i = 0; i < 4; ++i) { const GAS f32x4* rp = (const GAS f32x4*)(router + (size_t)(4 * lane + 256 * j + i) * 8); const f32x4 r0 = rp[0], r1 = rp[1]; const float hx = hv[j][i];
                          lg[0] += hx * r0.x; lg[1] += hx * r0.y; lg[2] += hx * r0.z; lg[3] += hx * r0.w; lg[4] += hx * r1.x; lg[5] += hx * r1.y; lg[6] += hx * r1.z; lg[7] += hx * r1.w; }
#pragma unroll
                  for (int e = 0; e < 8; ++e) lg[e] = wave_sum(lg[e]);
                  int i0 = 0; float v0 = lg[0];
#pragma unroll
                  for (int e = 1; e < 8; ++e) if (lg[e] > v0) { v0 = lg[e]; i0 = e; }
                  int i1 = -1; float v1 = -INFINITY;
#pragma unroll
                  for (int e = 0; e < 8; ++e) if (e != i0 && lg[e] > v1) { v1 = lg[e]; i1 = e; }
                  if (lane == 0) { const float w0 = 1.f / (1.f + expf(v1 - v0));
                      const int p0 = (int)__hip_atomic_fetch_add(D_CNT + 64 * i0, 1u, RLX_AGENT), p1 = (int)__hip_atomic_fetch_add(D_CNT + 64 * i1, 1u, RLX_AGENT);
                      D_ME[t] = make_int2(i0, i1); D_MP[t] = make_int2(p0, p1); D_MW[t] = make_float2(w0, 1.f - w0); } } }
            {
                PH_BEGIN
                constexpr int N_E1 = 16 * (DFE / 32), N_E2 = (DFE / 64) * 32;
                for (int it = gw; it < NEXP * (2 * N_E1 + N_E2); it += NGW) { const int e = it / (2 * N_E1 + N_E2); int r = it - e * (2 * N_E1 + N_E2);
                    if (r < N_E1) { transpose_item(INP(I_MW1) + (size_t)e * DM * DFE, DM, DFE, (bf16*)(ws + WS_MW13) + (size_t)e * 2 * DFE * DM, 2, D_SCR, r, lane); continue; }
                    r -= N_E1;
                    if (r < N_E1) { transpose_item(INP(I_MW3) + (size_t)e * DM * DFE, DM, DFE, (bf16*)(ws + WS_MW13) + (size_t)e * 2 * DFE * DM, 3, D_SCR, r, lane); continue; }
                    r -= N_E1;
                    transpose_item(INP(I_MW2) + (size_t)e * DFE * DM, DFE, DM, (bf16*)(ws + WS_MW2) + (size_t)e * DM * DFE, 0, D_SCR, r, lane); }
            }
            GRID_BAR();
            {
                PH_BEGIN
                PS_LOAD
                bf16* const HS = (bf16*)(ws + WS_HS);
                for (int it = gw; it < 2 * MLAT; it += NGW) { const int t = it >> 1, k = it & 1; const int2 ee = D_ME[t], pp = D_MP[t]; const int e = k ? ee.y : ee.x, p = k ? pp.y : pp.x;
                    int pe = 0;
#pragma unroll
                    for (int q = 1; q < 8; ++q) pe = (e == q) ? ps[q] : pe;
                    const GAS v4u* src = (const GAS v4u*)(D_H + (size_t)t * DM); GAS v4u* dst = (GAS v4u*)(HS + ((size_t)pe * 256 + p) * DM);
                    dst[lane] = src[lane]; dst[lane + 64] = src[lane + 64]; }
            }
            GRID_BAR();
            {
                PH_BEGIN
                PS_LOAD
                pg8::Gemm g{(const pg8::bf16_t*)(ws + WS_HS), (const pg8::bf16_t*)(ws + WS_MW13), DM, DM, (size_t)2 * DFE * DM * 2};
                pg8::MoeOrder S{ps[8], 2 * DFE / 256, ps[8] * (2 * DFE / 256), G, bx, ps[1], ps[2], ps[3], ps[4], ps[5], ps[6], ps[7]};
                pg8::EpiSwiGLU E{(pg8::bf16_t*)(ws + WS_U2), DFE};
                pg8::gemm_phase<pg8::EpiSwiGLU, pg8::MoeOrder, true, true>(LDSP + RING_OFF, g, S, E);
            }
            GRID_BAR();
            {
                PH_BEGIN
                PS_LOAD
                pg8::Gemm g{(const pg8::bf16_t*)(ws + WS_U2), (const pg8::bf16_t*)(ws + WS_MW2), DFE, DFE, (size_t)DM * DFE * 2};
                pg8::MoeOrder S{ps[8], 4, ps[8] * 4, G, bx, ps[1], ps[2], ps[3], ps[4], ps[5], ps[6], ps[7]};
                pg8::EpiPlain E{(pg8::bf16_t*)(ws + WS_HS), DM};
                pg8::gemm_phase<pg8::EpiPlain, pg8::MoeOrder, true, true>(LDSP + RING_OFF, g, S, E);
            }
            GRID_BAR();
            {
                PH_BEGIN
                PS_LOAD
                const bf16* const Y = (const bf16*)(ws + WS_HS); const float* fg = INP(I_FNG);
                for (int t = gw; t < MLAT; t += NGW) { const int b = t / SEQ; const int2 ee = D_ME[t], pp = D_MP[t]; const float2 ww = D_MW[t];
                    int pe0 = 0, pe1 = 0;
#pragma unroll
                    for (int q = 1; q < 8; ++q) { pe0 = (ee.x == q) ? ps[q] : pe0; pe1 = (ee.y == q) ? ps[q] : pe1; }
                    const GAS unsigned long long* y0 = (const GAS unsigned long long*)(Y + ((size_t)pe0 * 256 + pp.x) * DM) + lane; const GAS unsigned long long* y1 = (const GAS unsigned long long*)(Y + ((size_t)pe1 * 256 + pp.y) * DM) + lane;
                    GAS f32x4* xr = (GAS f32x4*)(D_X + (size_t)t * DM) + lane; const GAS f32x4* gt = (const GAS f32x4*)(D_MODL + b * 6144 + 5 * DM) + lane;
                    f32x4 v[4]; float ss = 0.f;
#pragma unroll
                    for (int j = 0; j < 4; ++j) { const unsigned long long a = y0[64 * j], c = y1[64 * j]; const unsigned a0 = (unsigned)a, a1 = (unsigned)(a >> 32), c0 = (unsigned)c, c1 = (unsigned)(c >> 32);
                        const f32x4 ya = {__builtin_bit_cast(float, a0 << 16), __builtin_bit_cast(float, a0 & 0xffff0000u), __builtin_bit_cast(float, a1 << 16), __builtin_bit_cast(float, a1 & 0xffff0000u)};
                        const f32x4 yc = {__builtin_bit_cast(float, c0 << 16), __builtin_bit_cast(float, c0 & 0xffff0000u), __builtin_bit_cast(float, c1 << 16), __builtin_bit_cast(float, c1 & 0xffff0000u)};
                        v[j] = xr[64 * j] + gt[64 * j] * (ya * ww.x + yc * ww.y);
                        ss += (v[j].x * v[j].x + v[j].y * v[j].y) + (v[j].z * v[j].z + v[j].w * v[j].w); }
                    const float rs = 1.f / sqrtf(wave_sum(ss) * (1.f / DM) + EPS);
#pragma unroll
                    for (int j = 0; j < 4; ++j) xr[64 * j] = v[j] * rs * ((const GAS f32x4*)fg)[lane + 64 * j]; }
            }
        }
    }
#undef GRID_BAR
}

extern "C" void kernel_launch(void* const* d_in, const int* in_sizes, int n_in, void* d_out, int out_size, void* d_ws, size_t ws_size, hipStream_t stream) {
    static int grid = 0;
    if (grid == 0) {
        if (n_in != 24 || out_size != MLAT * DM || ws_size < WS_END) { fprintf(stderr, "kernel_launch: built for 24 inputs, %d outputs, >= %zu bytes of workspace; got n_in %d, out %d, ws %zu; nothing launched\n", MLAT * DM, (size_t)WS_END, n_in, out_size, ws_size); grid = -1; return; }
        int dev = 0, cus = 0, per_cu = 0;
        if (hipGetDevice(&dev) != hipSuccess || hipDeviceGetAttribute(&cus, hipDeviceAttributeMultiprocessorCount, dev) != hipSuccess) { fprintf(stderr, "kernel_launch: device query failed\n"); grid = -1; return; }
        if (hipFuncSetAttribute((const void*)fwd_kernel, hipFuncAttributeMaxDynamicSharedMemorySize, LDS_BYTES) != hipSuccess) { fprintf(stderr, "kernel_launch: hipFuncSetAttribute failed\n"); grid = -1; return; }
        if (hipOccupancyMaxActiveBlocksPerMultiprocessor(&per_cu, (const void*)fwd_kernel, NWAVES * 64, LDS_BYTES) != hipSuccess || per_cu < 1) { fprintf(stderr, "kernel_launch: occupancy query reports %d workgroups per CU\n", per_cu); }
        (void)hipGetLastError();
        grid = cus;
    }
    if (grid < 0) return;
    if (hipMemsetAsync((char*)d_ws + WS_CTL, 0, CTL_ZERO_BYTES, stream) != hipSuccess) { fprintf(stderr, "kernel_launch: hipMemsetAsync failed\n"); return; }
    Args a{};
    for (int i = 0; i < 24; ++i) a.in[i] = (const float*)d_in[i];
    a.out = (float*)d_out; a.ws = (unsigned char*)d_ws;
    hipLaunchKernelGGL(fwd_kernel, dim3(grid), dim3(NWAVES * 64), LDS_BYTES, stream, a);
    const hipError_t le = hipPeekAtLastError();
    if (le != hipSuccess) fprintf(stderr, "kernel_launch: launch failed: %s\n", hipGetErrorName(le));
}
```

```cpp
#include <hip/hip_runtime.h>
#include <hip/hip_bf16.h>
#include <cstdio>
#include <cstdint>
#include <cmath>

constexpr int DM = 1024, NB = 4, SEQ = 4096, CTXL = 256, EXT = SEQ + CTXL, MEXT = NB * EXT, MLAT = NB * SEQ, MCTX = NB * CTXL;
constexpr int PANB = EXT / 256  , NPAN = NB * PANB  ;
constexpr int INW = 6656;
constexpr int PC_QD = 0, PC_QG = 1024, PC_KD = 2048, PC_VD = 3072, PC_KG = 4096, PC_VG = 4352, PC_G1 = 4608, PC_G2 = 5632;
constexpr int OAW = 3072;
constexpr int DFF = 2816, NEXP = 8, DFE = 3584;
constexpr int MOE_ROWS = 2 * MLAT + NEXP * 256;
constexpr float EPS = 1e-6f;
constexpr int NHU = 48;
namespace pg8 {
#define PG8_LAS __attribute__((address_space(3)))
typedef unsigned short bf16_t;
typedef short bf16x8 __attribute__((ext_vector_type(8)));
typedef float f32x4 __attribute__((ext_vector_type(4)));
typedef unsigned u32x4 __attribute__((ext_vector_type(4)));
constexpr int BM = 256, BK = 64, HALF = 128, HTB = HALF * BK * 2  , STAGE_BYTES = 8 * HTB, NXCD = 8, WGM = 8;

__host__ __device__ __forceinline__ int lds_byte(int r, int c) { const int st = (r >> 4) * 2 + (c >> 5), rr = r & 15, cc = c & 31, ob = rr * 64 + cc * 2; return st * 1024 + (ob ^ (((ob >> 9) & 1) << 5)); }
__host__ __device__ __forceinline__ void stage_rc(int b, int& R, int& C) { const int st = b / 1024, sb = b % 1024, swz = sb ^ (((sb >> 9) & 1) << 5); R = (st >> 1) * 16 + swz / 64; C = (st & 1) * 32 + (swz % 64) / 2; }
__host__ __device__ __forceinline__ int perm32(int rho) { const int n = rho >> 4, i = rho & 15; return 8 * (i >> 2) + 4 * n + (i & 3); }

struct Unit { int pm, pn, e; };
struct Gemm { const bf16_t* A; const bf16_t* Bt; int K, lda; size_t bstride; };
__device__ __forceinline__ void rect_map(int wgid, int nM, int nN, int& pm, int& pn) {
    const int nwg = nM * nN; { const int q = nwg / NXCD, r = nwg % NXCD, xcd = wgid % NXCD, off = wgid / NXCD; wgid = (xcd < r ? xcd * (q + 1) : r * (q + 1) + (xcd - r) * q) + off; }
    const int nig = WGM * nN, gid = wgid / nig, fm = gid * WGM, gsz = (nM - fm) < WGM ? (nM - fm) : WGM;
    pm = fm + ((wgid % nig) % gsz); pn = (wgid % nig) / gsz;
}
struct RectOrder {
    int nMq, nN, nrect, G, c, latmode, exlo, exn, nextra;
    __device__ __forceinline__ void init(int nMq_, int nN_, int G_, int c_, int latmode_, int exlo_, int exn_) { nMq = nMq_; nN = nN_; nrect = nMq_ * nN_; G = G_; c = c_; latmode = latmode_; exlo = exlo_; exn = exn_; nextra = 4 * exn_; }
    __device__ __forceinline__ bool next(int i, Unit& u) const {
        int L = i * G + c; u.e = 0;
        if (L < nrect) { int q, pn; rect_map(L, nMq, nN, q, pn); u.pm = latmode ? (q >> 4) * 17 + (q & 15) : q; u.pn = pn; return true; }
        L -= nrect; if (L >= nextra) return false;
        const int b = L / exn; u.pm = b * 17 + 16; u.pn = exlo + (L - b * exn); return true;
    }
    __device__ __forceinline__ void a_ready(const Unit&) const {}
    __device__ __forceinline__ void done(const Unit&) const {}
};
struct MoeOrder {
    int P, nN, nwg, G, c, p1, p2, p3, p4, p5, p6, p7;
    __device__ __forceinline__ bool next(int i, Unit& u) const {
        const int L = i * G + c; if (L >= nwg) return false;
        int pm, pn; rect_map(L, P, nN, pm, pn); u.pm = pm; u.pn = pn;
        u.e = (pm >= p1) + (pm >= p2) + (pm >= p3) + (pm >= p4) + (pm >= p5) + (pm >= p6) + (pm >= p7); return true;
    }
    __device__ __forceinline__ void a_ready(const Unit&) const {}
    __device__ __forceinline__ void done(const Unit&) const {}
};

__device__ __forceinline__ unsigned cvt_pk_bf16(float lo, float hi) { unsigned r; asm volatile("v_cvt_pk_bf16_f32 %0, %1, %2" : "=v"(r) : "v"(lo), "v"(hi)); return r; }
__device__ __forceinline__ u32x4 pack8(const f32x4& a, const f32x4& b) { u32x4 w; w.x = cvt_pk_bf16(a[0], a[1]); w.y = cvt_pk_bf16(a[2], a[3]); w.z = cvt_pk_bf16(b[0], b[1]); w.w = cvt_pk_bf16(b[2], b[3]); return w; }
__device__ __forceinline__ void unpack8(const u32x4& w, f32x4& a, f32x4& b) {
    a[0] = __builtin_bit_cast(float, w.x << 16); a[1] = __builtin_bit_cast(float, w.x & 0xffff0000u); a[2] = __builtin_bit_cast(float, w.y << 16); a[3] = __builtin_bit_cast(float, w.y & 0xffff0000u);
    b[0] = __builtin_bit_cast(float, w.z << 16); b[1] = __builtin_bit_cast(float, w.z & 0xffff0000u); b[2] = __builtin_bit_cast(float, w.w << 16); b[3] = __builtin_bit_cast(float, w.w & 0xffff0000u); }
__device__ __forceinline__ float sigmoidf_(float v) { return __builtin_amdgcn_rcpf(1.f + __expf(-v)); }

struct EpiInProj {
    static constexpr bool PERM = true, AFTER_DRAIN = false;
    bf16_t* P; const float* qg; const float* kg; const float* tab; float c2;
    __device__ __forceinline__ void operator()(const f32x4 (&acc)[2][2][4][2], const Unit& u, int wr, int wc, int fr, int fq) const {
        asm volatile("" : "+v"(fr), "+v"(fq));
        const int pn = u.pn, seg = u.pm % 17; const bool lat = seg < 16;
        bf16_t* base = P + (size_t)(u.pm * 256 + wr * 64 + fr) * INW + 256 * pn + 64 * wc + 8 * fq;
        if (pn >= 18) {
#pragma unroll
            for (int ai = 0; ai < 2; ++ai)
#pragma unroll
                for (int m = 0; m < 4; ++m)
#pragma unroll
                    for (int bj = 0; bj < 2; ++bj) { f32x4 v0 = acc[ai][bj][m][0], v1 = acc[ai][bj][m][1];
#pragma unroll
                        for (int e = 0; e < 4; ++e) { v0[e] = sigmoidf_(v0[e]); v1[e] = sigmoidf_(v1[e]); }
                        *(u32x4*)(base + (size_t)(ai * 128 + m * 16) * INW + 32 * bj) = pack8(v0, v1); }
            return;
        }
        const bool donorm = (pn >= 4 && pn < 8) || pn == 16, dorope = lat && (pn < 12 || pn == 16);
        const float osc = pn < 8 ? c2 : 1.f;
        f32x4 gv[2][2];
#pragma unroll
        for (int bj = 0; bj < 2; ++bj)
#pragma unroll
            for (int n = 0; n < 2; ++n) gv[bj][n] = donorm ? *(const f32x4*)((pn == 16 ? kg : qg) + 32 * bj + 8 * fq + 4 * n) : (f32x4){1.f, 1.f, 1.f, 1.f};
        f32x4 tr[2][2], tc[4][2];
#pragma unroll
        for (int n = 0; n < 2; ++n) {
#pragma unroll
            for (int ai = 0; ai < 2; ++ai) tr[ai][n] = dorope ? *(const f32x4*)(tab + ((4 * seg + 2 * ai + wr) * 16 + 4 * fq + 2 * n) * 2) : (f32x4){1.f, 0.f, 1.f, 0.f};
#pragma unroll
            for (int m = 0; m < 4; ++m) tc[m][n] = dorope ? *(const f32x4*)(tab + ((16 * m + fr) * 16 + 4 * fq + 2 * n) * 2) : (f32x4){1.f, 0.f, 1.f, 0.f};
        }
#pragma unroll
        for (int ai = 0; ai < 2; ++ai)
#pragma unroll
            for (int m = 0; m < 4; ++m) {
                f32x4 v[2][2];
#pragma unroll
                for (int bj = 0; bj < 2; ++bj)
#pragma unroll
                    for (int n = 0; n < 2; ++n) v[bj][n] = acc[ai][bj][m][n];
                if (donorm) {
                    float ss = 0.f;
#pragma unroll
                    for (int bj = 0; bj < 2; ++bj)
#pragma unroll
                        for (int n = 0; n < 2; ++n) ss += (v[bj][n][0] * v[bj][n][0] + v[bj][n][1] * v[bj][n][1]) + (v[bj][n][2] * v[bj][n][2] + v[bj][n][3] * v[bj][n][3]);
                    ss += __shfl_xor(ss, 16); ss += __shfl_xor(ss, 32);
                    const float rs = 1.f / sqrtf(ss * (1.f / 64.f) + EPS);
#pragma unroll
                    for (int bj = 0; bj < 2; ++bj)
#pragma unroll
                        for (int n = 0; n < 2; ++n) v[bj][n] = v[bj][n] * rs * gv[bj][n];
                }
#pragma unroll
                for (int bj = 0; bj < 2; ++bj) {
#pragma unroll
                    for (int n = 0; n < 2; ++n) { const f32x4 t = bj == 0 ? tr[ai][n] : tc[m][n]; const f32x4 x = v[bj][n];
                        v[bj][n] = (f32x4){(x[0] * t[0] - x[1] * t[1]) * osc, (x[0] * t[1] + x[1] * t[0]) * osc, (x[2] * t[2] - x[3] * t[3]) * osc, (x[2] * t[3] + x[3] * t[2]) * osc}; }
                    *(u32x4*)(base + (size_t)(ai * 128 + m * 16) * INW + 32 * bj) = pack8(v[bj][0], v[bj][1]);
                }
            }
    }
};
struct EpiGate {
    static constexpr bool PERM = true, AFTER_DRAIN = false;
    bf16_t* Mx; const bf16_t* G; int accum;
    __device__ __forceinline__ void operator()(const f32x4 (&acc)[2][2][4][2], const Unit& u, int wr, int wc, int fr, int fq) const {
        asm volatile("" : "+v"(fr), "+v"(fq));
        const int row0 = u.pm * 256 + wr * 64 + fr, col0 = u.pn * 256 + wc * 32 + 8 * fq;
#pragma unroll
        for (int ai = 0; ai < 2; ++ai)
#pragma unroll
            for (int m = 0; m < 4; ++m) { const size_t row = (size_t)(row0 + ai * 128 + m * 16);
#pragma unroll
                for (int bj = 0; bj < 2; ++bj) { const int col = col0 + 128 * bj;
                    f32x4 g0, g1; unpack8(*(const u32x4*)(G + row * INW + col), g0, g1);
                    f32x4 v0 = acc[ai][bj][m][0] * g0, v1 = acc[ai][bj][m][1] * g1;
                    if (accum) { f32x4 o0, o1; unpack8(*(const u32x4*)(Mx + row * DM + col), o0, o1); v0 = v0 + o0; v1 = v1 + o1; }
                    *(u32x4*)(Mx + row * DM + col) = pack8(v0, v1); } }
    }
};
struct EpiResid {
    static constexpr bool PERM = true, AFTER_DRAIN = false;
    const float* XoL; const float* XoC; float* XnL; float* XnC; const float* mod;
    __device__ __forceinline__ void operator()(const f32x4 (&acc)[2][2][4][2], const Unit& u, int wr, int wc, int fr, int fq) const {
        asm volatile("" : "+v"(fr), "+v"(fq));
        const int b = u.pm / 17, seg = u.pm - b * 17; const bool lat = seg < 16;
        const size_t rb = (lat ? (size_t)(b * SEQ + seg * 256) : (size_t)(b * CTXL)) + wr * 64 + fr;
        const float* xo = lat ? XoL : XoC; float* xn = lat ? XnL : XnC;
        const int col0 = u.pn * 256 + wc * 32 + 8 * fq; const float* gp = mod + (lat ? b : 4) * 6144 + col0;
        f32x4 gt[2][2];
#pragma unroll
        for (int bj = 0; bj < 2; ++bj)
#pragma unroll
            for (int n = 0; n < 2; ++n) gt[bj][n] = *(const f32x4*)(gp + 128 * bj + 4 * n);
#pragma unroll
        for (int ai = 0; ai < 2; ++ai)
#pragma unroll
            for (int m = 0; m < 4; ++m) { const size_t ro = (rb + ai * 128 + m * 16) * DM + col0;
#pragma unroll
                for (int bj = 0; bj < 2; ++bj)
#pragma unroll
                    for (int n = 0; n < 2; ++n) { const f32x4 o = *(const f32x4*)(xo + ro + 128 * bj + 4 * n); *(f32x4*)(xn + ro + 128 * bj + 4 * n) = o + gt[bj][n] * acc[ai][bj][m][n]; } }
    }
};
struct EpiSwiGLU {
    static constexpr bool PERM = true, AFTER_DRAIN = false;
    bf16_t* U; int ldu;
    __device__ __forceinline__ void operator()(const f32x4 (&acc)[2][2][4][2], const Unit& u, int wr, int wc, int fr, int fq) const {
        asm volatile("" : "+v"(fr), "+v"(fq));
        bf16_t* base = U + (size_t)(u.pm * 256 + wr * 64 + fr) * ldu + u.pn * 128 + wc * 32 + 8 * fq;
#pragma unroll
        for (int ai = 0; ai < 2; ++ai)
#pragma unroll
            for (int m = 0; m < 4; ++m) { f32x4 r[2];
#pragma unroll
                for (int n = 0; n < 2; ++n) { const f32x4 a = acc[ai][0][m][n], b = acc[ai][1][m][n];
#pragma unroll
                    for (int e = 0; e < 4; ++e) r[n][e] = a[e] * sigmoidf_(a[e]) * b[e]; }
                *(u32x4*)(base + (size_t)(ai * 128 + m * 16) * ldu) = pack8(r[0], r[1]); }
    }
};
struct EpiPlain {
    static constexpr bool PERM = true, AFTER_DRAIN = false;
    bf16_t* Y; int ldy;
    __device__ __forceinline__ void operator()(const f32x4 (&acc)[2][2][4][2], const Unit& u, int wr, int wc, int fr, int fq) const {
        asm volatile("" : "+v"(fr), "+v"(fq));
        bf16_t* base = Y + (size_t)(u.pm * 256 + wr * 64 + fr) * ldy + u.pn * 256 + wc * 32 + 8 * fq;
#pragma unroll
        for (int ai = 0; ai < 2; ++ai)
#pragma unroll
            for (int m = 0; m < 4; ++m)
#pragma unroll
                for (int bj = 0; bj < 2; ++bj) *(u32x4*)(base + (size_t)(ai * 128 + m * 16) * ldy + 128 * bj) = pack8(acc[ai][bj][m][0], acc[ai][bj][m][1]);
    }
};

template <class Epi, class Sched, bool ALIGN_EPI = false, bool SP2 = false>
__device__ __forceinline__ void gemm_phase(PG8_LAS unsigned char* lds, const Gemm g, const Sched& S, const Epi& E) {
    int tid_ = threadIdx.x; asm volatile("" : "+v"(tid_));
    const int tid = tid_, wid = __builtin_amdgcn_readfirstlane(tid >> 6), lane = tid & 63, wr = wid >> 2, wc = wid & 3, fr = lane & 15, fq = lane >> 4;
    const int K = g.K, nt = K / BK, lda = g.lda;
    unsigned voffA[2], voffB[2];
#pragma unroll
    for (int i = 0; i < 2; ++i) { int R, C; stage_rc(tid * 16 + i * 8192, R, C); const int Rb = Epi::PERM ? ((R & ~31) + perm32(R & 31)) : R;
        voffA[i] = (unsigned)(R * lda + C) * 2u; voffB[i] = (unsigned)(Rb * K + C) * 2u; }
    const size_t kstep = (size_t)(BK * 2);
    const size_t hstepA = (size_t)HALF * lda * 2, hstepB = (size_t)HALF * K * 2;
    const size_t tstepA = 2 * hstepA, tstepB = 2 * hstepB;
    const unsigned ldsw = (unsigned)wid * 1024u;
    const int aoff = lds_byte(wr * 64 + fr, fq * 8), boff = lds_byte(wc * 32 + fr, fq * 8);
#define PG8_SA(b, h) (((b) * 2 + (h)) * HTB)
#define PG8_SB(b, h) ((4 + (b) * 2 + (h)) * HTB)
#define PG8_STAGE(bufoff, gbase, voff) do { _Pragma("unroll") for (int _i = 0; _i < 2; ++_i) \
        __builtin_amdgcn_global_load_lds((const unsigned*)((const char*)(gbase) + (voff)[_i]), (PG8_LAS unsigned*)(lds + (bufoff) + ldsw + _i * 8192), 16, 0, 0); } while (0)
#define PG8_LDA(dst, b, h) do { _Pragma("unroll") for (int m = 0; m < 4; ++m) _Pragma("unroll") for (int k = 0; k < 2; ++k) dst[m][k] = *(const PG8_LAS bf16x8*)(lds + PG8_SA(b, h) + aoff + m * 2048 + k * 1024); } while (0)
#define PG8_LDB(dst, b, h) do { _Pragma("unroll") for (int n = 0; n < 2; ++n) _Pragma("unroll") for (int k = 0; k < 2; ++k) dst[n][k] = *(const PG8_LAS bf16x8*)(lds + PG8_SB(b, h) + boff + n * 2048 + k * 1024); } while (0)
#define PG8_MMA(ai, bj, At, Bt) do { __builtin_amdgcn_s_setprio(1); _Pragma("unroll") for (int m = 0; m < 4; ++m) _Pragma("unroll") for (int n = 0; n < 2; ++n) _Pragma("unroll") for (int k = 0; k < 2; ++k) \
        acc[ai][bj][m][n] = __builtin_amdgcn_mfma_f32_16x16x32_bf16(Bt[n][k], At[m][k], acc[ai][bj][m][n], 0, 0, 0); __builtin_amdgcn_s_setprio(0); } while (0)
#define PG8_WAIT_V(n) asm volatile("s_waitcnt vmcnt(" #n ")" ::: "memory")
#define PG8_WAIT_L(n) asm volatile("s_waitcnt lgkmcnt(" #n ")" ::: "memory")
#define PG8_BAR __builtin_amdgcn_s_barrier()
#define PG8_SCHED __builtin_amdgcn_sched_barrier(0)
    Unit cur, nxt; int ui = 0;
    if (!S.next(0, cur)) return;
    f32x4 acc[2][2][4][2];
#pragma unroll
    for (int a = 0; a < 2; ++a)
#pragma unroll
        for (int b = 0; b < 2; ++b)
#pragma unroll
            for (int m = 0; m < 4; ++m)
#pragma unroll
                for (int n = 0; n < 2; ++n) acc[a][b][m][n] = (f32x4){0.f, 0.f, 0.f, 0.f};
    bf16x8 At[4][2], B0[2][2], B1[2][2];
    const char* cA = (const char*)g.A + (size_t)cur.pm * tstepA; const char* cB = (const char*)g.Bt + (size_t)cur.e * g.bstride + (size_t)cur.pn * tstepB;
    S.a_ready(cur);
    if constexpr (SP2) {
        PG8_STAGE(PG8_SB(0, 0), cB, voffB); PG8_STAGE(PG8_SB(0, 1), cB + hstepB, voffB); PG8_STAGE(PG8_SA(0, 0), cA, voffA); PG8_STAGE(PG8_SA(0, 1), cA + hstepA, voffA);
        if (wr == 1) PG8_BAR;
        PG8_WAIT_V(2); PG8_BAR;
        PG8_STAGE(PG8_SB(1, 0), cB + kstep, voffB); PG8_STAGE(PG8_SA(1, 0), cA + kstep, voffA); PG8_STAGE(PG8_SB(1, 1), cB + hstepB + kstep, voffB);
        PG8_WAIT_V(6); PG8_BAR;
    } else {
        PG8_STAGE(PG8_SB(0, 0), cB, voffB); PG8_STAGE(PG8_SA(0, 0), cA, voffA); PG8_STAGE(PG8_SB(0, 1), cB + hstepB, voffB); PG8_STAGE(PG8_SA(0, 1), cA + hstepA, voffA);
        if (wr == 1) PG8_BAR;
        PG8_WAIT_V(4); PG8_BAR;
        PG8_STAGE(PG8_SB(1, 0), cB + kstep, voffB); PG8_STAGE(PG8_SA(1, 0), cA + kstep, voffA); PG8_STAGE(PG8_SB(1, 1), cB + hstepB + kstep, voffB);
        PG8_WAIT_V(6); PG8_BAR;
    }
    for (;;) {
        const bool has_next = S.next(ui + 1, nxt);
        const char* nA = has_next ? (const char*)g.A + (size_t)nxt.pm * tstepA : cA; const char* nB = has_next ? (const char*)g.Bt + (size_t)nxt.e * g.bstride + (size_t)nxt.pn * tstepB : cB;
        for (int t = 0; t < nt; t += 2) {
            const bool last = (t == nt - 2);
            const char* a1 = cA + (size_t)(t + 1) * kstep;
            const char* a2 = last ? nA : cA + (size_t)(t + 2) * kstep; const char* b2 = last ? nB : cB + (size_t)(t + 2) * kstep;
            const char* a3 = a2 + kstep; const char* b3 = b2 + kstep;
            if (last && has_next) S.a_ready(nxt);
            if constexpr (SP2) {
            PG8_LDB(B0, 0, 0); PG8_LDB(B1, 0, 1); PG8_SCHED; PG8_LDA(At, 0, 0); PG8_STAGE(PG8_SA(1, 1), a1 + hstepA, voffA);
            PG8_WAIT_V(8); PG8_WAIT_L(0); PG8_BAR; PG8_MMA(0, 0, At, B0); PG8_MMA(0, 1, At, B1); PG8_BAR; PG8_SCHED;
            PG8_LDA(At, 0, 1); PG8_STAGE(PG8_SB(0, 0), b2, voffB); PG8_STAGE(PG8_SB(0, 1), b2 + hstepB, voffB); PG8_STAGE(PG8_SA(0, 0), a2, voffA);
            PG8_WAIT_V(8); PG8_WAIT_L(0); PG8_BAR; PG8_MMA(1, 0, At, B0); PG8_MMA(1, 1, At, B1); PG8_BAR; PG8_SCHED;
            PG8_LDB(B0, 1, 0); PG8_LDB(B1, 1, 1); PG8_SCHED; PG8_LDA(At, 1, 0); PG8_STAGE(PG8_SA(0, 1), a2 + hstepA, voffA);
            PG8_WAIT_V(8); PG8_WAIT_L(0); PG8_BAR; PG8_MMA(0, 0, At, B0); PG8_MMA(0, 1, At, B1); PG8_BAR; PG8_SCHED;
            PG8_LDA(At, 1, 1); PG8_STAGE(PG8_SB(1, 0), b3, voffB); PG8_STAGE(PG8_SB(1, 1), b3 + hstepB, voffB); PG8_STAGE(PG8_SA(1, 0), a3, voffA);
            PG8_WAIT_V(8); PG8_WAIT_L(0); PG8_BAR; PG8_MMA(1, 0, At, B0); PG8_MMA(1, 1, At, B1); PG8_BAR; PG8_SCHED;
            } else {
            PG8_LDB(B0, 0, 0); PG8_SCHED; PG8_LDA(At, 0, 0); PG8_STAGE(PG8_SA(1, 1), a1 + hstepA, voffA);
            PG8_WAIT_L(8); PG8_BAR; PG8_WAIT_L(0); PG8_MMA(0, 0, At, B0); PG8_BAR; PG8_SCHED;
            PG8_LDB(B1, 0, 1); PG8_STAGE(PG8_SB(0, 0), b2, voffB);
            PG8_BAR; PG8_WAIT_L(0); PG8_MMA(0, 1, At, B1); PG8_BAR;
            PG8_LDA(At, 0, 1); PG8_STAGE(PG8_SA(0, 0), a2, voffA);
            PG8_BAR; PG8_WAIT_L(0); PG8_MMA(1, 0, At, B0); PG8_BAR; PG8_SCHED;
            PG8_STAGE(PG8_SB(0, 1), b2 + hstepB, voffB);
            PG8_WAIT_V(6); PG8_BAR; PG8_MMA(1, 1, At, B1); PG8_BAR;
            PG8_LDB(B0, 1, 0); PG8_SCHED; PG8_LDA(At, 1, 0); PG8_STAGE(PG8_SA(0, 1), a2 + hstepA, voffA);
            PG8_WAIT_L(8); PG8_BAR; PG8_WAIT_L(0); PG8_MMA(0, 0, At, B0); PG8_BAR; PG8_SCHED;
            PG8_LDB(B1, 1, 1); PG8_STAGE(PG8_SB(1, 0), b3, voffB);
            PG8_BAR; PG8_WAIT_L(0); PG8_MMA(0, 1, At, B1); PG8_BAR;
            PG8_LDA(At, 1, 1); PG8_STAGE(PG8_SA(1, 0), a3, voffA);
            PG8_BAR; PG8_WAIT_L(0); PG8_MMA(1, 0, At, B0); PG8_BAR; PG8_SCHED;
            PG8_STAGE(PG8_SB(1, 1), b3 + hstepB, voffB);
            PG8_WAIT_V(6); PG8_BAR; PG8_MMA(1, 1, At, B1); PG8_BAR;
            }
        }
        if constexpr (ALIGN_EPI) { if (wr == 0) PG8_BAR; }
        if constexpr (!Epi::AFTER_DRAIN) { E(acc, cur, wr, wc, fr, fq); S.done(cur); }
        if (!has_next) break;
#pragma unroll
        for (int a = 0; a < 2; ++a)
#pragma unroll
            for (int b = 0; b < 2; ++b)
#pragma unroll
                for (int m = 0; m < 4; ++m)
#pragma unroll
                    for (int n = 0; n < 2; ++n) acc[a][b][m][n] = (f32x4){0.f, 0.f, 0.f, 0.f};
        cur = nxt; cA = nA; cB = nB; ++ui;
        if constexpr (ALIGN_EPI) { if (wr == 1) PG8_BAR; }
    }
    PG8_WAIT_V(0);
    if constexpr (!ALIGN_EPI) { if (wr == 0) PG8_BAR; }
    PG8_BAR;
    if constexpr (Epi::AFTER_DRAIN) { E.fused(acc, cur, wr, wc, fr, fq, lds, wid, lane); S.done(cur); }
#undef PG8_SA
#undef PG8_SB
#undef PG8_STAGE
#undef PG8_LDA
#undef PG8_LDB
#undef PG8_MMA
#undef PG8_WAIT_V
#undef PG8_WAIT_L
#undef PG8_BAR
#undef PG8_SCHED
}
}

#include <hip/hip_bf16.h>
#include <cmath>
namespace attn_body {
using bf16=__hip_bfloat16;
using bf16x8=__attribute__((ext_vector_type(8)))short;
using s16x4=__attribute__((ext_vector_type(4)))short;
using f32x16=__attribute__((ext_vector_type(16)))float;
using u32x4=__attribute__((ext_vector_type(4)))unsigned;
constexpr int D=64;
constexpr int NW=8,QBLK=32,QB=QBLK*NW,KVBLK=64;
__device__ __forceinline__ int crow(int r,int hi){return (r&3)+8*(r>>2)+4*hi;}
#define SBAR() __builtin_amdgcn_sched_barrier(0)
constexpr int NSLOT=3, SLOTB=8192;
constexpr int LDS_K=0, LDS_V=NSLOT*SLOTB, LDS_WS=2*NSLOT*SLOTB, LDS_OST=LDS_WS+NW*64*4, LDS_BYTES=LDS_OST+NW*4096;
constexpr int VSLOTB=16384, LDS_V2=NSLOT*SLOTB, LDS_WS2=LDS_V2+NSLOT*VSLOTB, LDS_OST2=LDS_WS2+NW*64*4, LDS_BYTES2=LDS_OST2+NW*4096;
constexpr float C2=0.125f*1.4426950408889634f;
__device__ __forceinline__ void glds16(const void*gsrc,unsigned lds_dst){unsigned keep;
  asm volatile("s_mov_b32 %0, m0\n\ts_mov_b32 m0, %2\n\ts_nop 0\n\tglobal_load_lds_dwordx4 %1, off\n\ts_mov_b32 m0, %0":"=&s"(keep):"v"(gsrc),"s"(lds_dst):"memory");}
__device__ __forceinline__ float max3f(float a,float b,float c){float r;asm("v_max3_f32 %0, %1, %2, %3":"=v"(r):"v"(a),"v"(b),"v"(c));return r;}
__device__ __forceinline__ float max2f(float a,float b){float r;asm("v_max_f32_e32 %0, %1, %2":"=v"(r):"v"(a),"v"(b));return r;}
__device__ __forceinline__ float fadd_s(float a,float b){float r;asm("v_add_f32_e32 %0, %1, %2":"=v"(r):"v"(a),"v"(b));return r;}
__device__ __forceinline__ float fsub_s(float a,float b){float r;asm("v_sub_f32_e32 %0, %1, %2":"=v"(r):"v"(a),"v"(b));return r;}
typedef float f32x2_t __attribute__((ext_vector_type(2))); typedef __bf16 bf16x2_t __attribute__((ext_vector_type(2)));
__device__ __forceinline__ unsigned cvtpk_s(float lo,float hi){f32x2_t v={lo,hi};bf16x2_t b=__builtin_convertvector(v,bf16x2_t);return __builtin_bit_cast(unsigned,b);}
#define WAIT_BAR(N) asm volatile("s_waitcnt vmcnt(" #N ") lgkmcnt(0)\n\ts_barrier":::"memory")

__device__ __forceinline__ void qkt(f32x16&p0,f32x16&p1,const char*Kslot,const bf16x8*qr,const f32x16&negm,int r32,int hi){
  const char*kb=Kslot+hi*1024+r32*16;
  #pragma unroll
  for(int d0=0;d0<4;++d0){
    const bf16x8 b0=*reinterpret_cast<const bf16x8*>(kb+d0*2048);
    const bf16x8 b1=*reinterpret_cast<const bf16x8*>(kb+d0*2048+512);
    if(d0==0){p0=__builtin_amdgcn_mfma_f32_32x32x16_bf16(b0,qr[0],negm,0,0,0);p1=__builtin_amdgcn_mfma_f32_32x32x16_bf16(b1,qr[0],negm,0,0,0);}
    else{p0=__builtin_amdgcn_mfma_f32_32x32x16_bf16(b0,qr[d0],p0,0,0,0);p1=__builtin_amdgcn_mfma_f32_32x32x16_bf16(b1,qr[d0],p1,0,0,0);}}
}
typedef __attribute__((address_space(3))) const char* lds_cptr;
typedef short v4i16_t __attribute__((ext_vector_type(4)));
__device__ __forceinline__ void kload8(bf16x8*kf,lds_cptr kp){
  kf[0]=*(const __attribute__((address_space(3))) bf16x8*)(kp);      kf[1]=*(const __attribute__((address_space(3))) bf16x8*)(kp+512);
  kf[2]=*(const __attribute__((address_space(3))) bf16x8*)(kp+2048); kf[3]=*(const __attribute__((address_space(3))) bf16x8*)(kp+2560);
  kf[4]=*(const __attribute__((address_space(3))) bf16x8*)(kp+4096); kf[5]=*(const __attribute__((address_space(3))) bf16x8*)(kp+4608);
  kf[6]=*(const __attribute__((address_space(3))) bf16x8*)(kp+6144); kf[7]=*(const __attribute__((address_space(3))) bf16x8*)(kp+6656);
}
__device__ __forceinline__ void kload2(bf16x8*kf,lds_cptr kp,int j){ kf[2*j]=*(const __attribute__((address_space(3))) bf16x8*)(kp+j*2048); kf[2*j+1]=*(const __attribute__((address_space(3))) bf16x8*)(kp+j*2048+512); }
__device__ __forceinline__ s16x4 vtr(lds_cptr p){ return __builtin_bit_cast(s16x4,__builtin_amdgcn_ds_read_tr16_b64_v4i16((__attribute__((address_space(3))) v4i16_t*)p)); }
__device__ __forceinline__ float rowmax(const f32x16&p0,const f32x16&p1){
  float a=max3f(p0[0],p0[1],p1[0]),b=max3f(p0[2],p0[3],p1[1]);a=max3f(a,p1[2],p1[3]);
  #pragma unroll
  for(int r=4;r<16;r+=4){a=max3f(a,p0[r],p0[r+1]);b=max3f(b,p0[r+2],p0[r+3]);a=max3f(a,p1[r],p1[r+1]);b=max3f(b,p1[r+2],p1[r+3]);}
  const float m=max2f(a,b);
  auto rr=__builtin_amdgcn_permlane32_swap(__float_as_uint(m),__float_as_uint(m),false,false);
  return max2f(__uint_as_float(rr[0]),__uint_as_float(rr[1]));
}
__device__ __forceinline__ void pv(f32x16*o,int vb,bf16x8 pa0,bf16x8 pa1,bf16x8 pa2,bf16x8 pa3){
  #pragma unroll
  for(int d0=0;d0<2;++d0){s16x4 lo[4],hi[4];
    #pragma unroll
    for(int ks=0;ks<4;++ks){
      asm volatile("ds_read_b64_tr_b16 %0,%1 offset:%c2":"=&v"(lo[ks]):"v"(vb),"i"(d0*4096+ks*1024):"memory");
      asm volatile("ds_read_b64_tr_b16 %0,%1 offset:%c2":"=&v"(hi[ks]):"v"(vb),"i"(d0*4096+ks*1024+512):"memory");}
    asm volatile("s_waitcnt lgkmcnt(0)":::"memory");SBAR();
    #define PK(k) (bf16x8){lo[k][0],lo[k][1],lo[k][2],lo[k][3],hi[k][0],hi[k][1],hi[k][2],hi[k][3]}
    o[d0]=__builtin_amdgcn_mfma_f32_32x32x16_bf16(pa0,PK(0),o[d0],0,0,0);
    o[d0]=__builtin_amdgcn_mfma_f32_32x32x16_bf16(pa1,PK(1),o[d0],0,0,0);
    o[d0]=__builtin_amdgcn_mfma_f32_32x32x16_bf16(pa2,PK(2),o[d0],0,0,0);
    o[d0]=__builtin_amdgcn_mfma_f32_32x32x16_bf16(pa3,PK(3),o[d0],0,0,0);
    #undef PK
  }
}

__device__ __forceinline__ void pv4(f32x16*o,int vb,bf16x8 pa0,bf16x8 pa1,bf16x8 pa2,bf16x8 pa3){
  #pragma unroll
  for(int d0=0;d0<4;++d0){s16x4 lo[4],hi[4];
    #pragma unroll
    for(int ks=0;ks<4;++ks){
      asm volatile("ds_read_b64_tr_b16 %0,%1 offset:%c2":"=&v"(lo[ks]):"v"(vb),"i"(d0*4096+ks*1024):"memory");
      asm volatile("ds_read_b64_tr_b16 %0,%1 offset:%c2":"=&v"(hi[ks]):"v"(vb),"i"(d0*4096+ks*1024+512):"memory");}
    asm volatile("s_waitcnt lgkmcnt(0)":::"memory");SBAR();
    #define PK(k) (bf16x8){lo[k][0],lo[k][1],lo[k][2],lo[k][3],hi[k][0],hi[k][1],hi[k][2],hi[k][3]}
    o[d0]=__builtin_amdgcn_mfma_f32_32x32x16_bf16(pa0,PK(0),o[d0],0,0,0);
    o[d0]=__builtin_amdgcn_mfma_f32_32x32x16_bf16(pa1,PK(1),o[d0],0,0,0);
    o[d0]=__builtin_amdgcn_mfma_f32_32x32x16_bf16(pa2,PK(2),o[d0],0,0,0);
    o[d0]=__builtin_amdgcn_mfma_f32_32x32x16_bf16(pa3,PK(3),o[d0],0,0,0);
    #undef PK
  }
}

#ifndef ATTN_STORE16
#define ATTN_STORE16(p,v) (*(u32x4*)(p)=(v))
#endif
template<int THRL> __device__ __forceinline__ void attn_unit(const bf16*Q0,int qp,const bf16*__restrict__ K0,int kp,const bf16*__restrict__ V0,int vp,bf16*O0,int op,const int NT,char*shm){
  int tid_=threadIdx.x; asm volatile("":"+v"(tid_)); const int tid=tid_,lane=tid&63,r32=lane&31,hi=lane>>5; const int wid=__builtin_amdgcn_readfirstlane(tid>>6);
  const bf16*Qw=Q0+(long)(wid*QBLK)*qp;
  const bf16*Kh=K0,*Vh=V0;
  const unsigned lds0=(unsigned)(uintptr_t)shm;
  float*wsf=(float*)(shm+LDS_WS)+wid*64;
  const bf16*ksrc=Kh+(long)lane*kp+wid*8;
  const bf16*vsrc=Vh+(long)(16*(wid&3)+(lane>>2))*vp+(wid>>2)*32+(lane&3)*8;
  const unsigned kdst=lds0+LDS_K+wid*1024, vdst=lds0+LDS_V+wid*1024;
  #define DMA_K(t,slot) glds16(ksrc+(long)(t)*KVBLK*kp,(unsigned)__builtin_amdgcn_readfirstlane(kdst+(slot)))
  #define DMA_V(t,slot) glds16(vsrc+(long)(t)*KVBLK*vp,(unsigned)__builtin_amdgcn_readfirstlane(vdst+(slot)))
  const int vb0=(int)(lds0+LDS_V)+((lane>>4)&1)*32+(lane&3)*8+(4*hi+((lane&15)>>2))*64;
  const char*Kbase=shm+LDS_K; bf16x8 kf[8];
  const lds_cptr shm3=(lds_cptr)shm; const lds_cptr kp0=shm3+LDS_K+hi*1024+r32*16; const lds_cptr vp0=shm3+LDS_V+((lane>>4)&1)*32+(lane&3)*8+(4*hi+((lane&15)>>2))*64;
  DMA_K(0,0);DMA_V(0,0);DMA_K(1,SLOTB);
  bf16x8 qr[4];
  #pragma unroll
  for(int d0=0;d0<4;++d0)qr[d0]=*reinterpret_cast<const bf16x8*>(&Qw[(long)r32*qp+d0*16+hi*8]);
  float mhat=0.f,l_reg=0.f;f32x16 o[2];o[0]=f32x16{};o[1]=f32x16{};f32x16 negm=f32x16{};asm volatile("":"+v"(negm));
  #define CMASK(P0,P1,t) do{}while(0)
  bool resc=false;
  #define START(P0,P1) do{ const float rm=rowmax(P0,P1); resc=false; \
    { const float dl=rm; mhat=fadd_s(mhat,dl); \
      _Pragma("unroll") for(int r=0;r<16;++r){P0[r]=fsub_s(P0[r],dl);P1[r]=fsub_s(P1[r],dl);} \
      _Pragma("unroll") for(int r=0;r<16;++r)negm[r]=-mhat; asm volatile("":"+v"(negm)); } \
    _Pragma("unroll") for(int r=0;r<16;++r)P0[r]=__builtin_amdgcn_exp2f(P0[r]); }while(0)
  #define RESC() do{ if(resc){ asm volatile("s_waitcnt lgkmcnt(0)":::"memory"); \
      _Pragma("unroll") for(int d_=0;d_<2;++d_) _Pragma("unroll") for(int r=0;r<16;++r)o[d_][r]*=wsf[crow(r,hi)]; } }while(0)
  f32x16 pA0,pA1,pB0,pB1;
  int sl_prev=0,sl_cur=0,sl_next=SLOTB;
  #define ROT() do{sl_prev=sl_cur;sl_cur=sl_next;sl_next=(sl_next==(NSLOT-1)*SLOTB)?0:sl_next+SLOTB;}while(0)
  DMA_K(2,2*SLOTB);
  WAIT_BAR(3);
  qkt(pA0,pA1,Kbase,qr,negm,r32,hi);asm volatile("s_nop 15\n\ts_nop 7":"+v"(pA0),"+v"(pA1));CMASK(pA0,pA1,0);
  START(pA0,pA1);
  _Pragma("unroll") for(int r=0;r<16;++r)pA1[r]=__builtin_amdgcn_exp2f(pA1[r]);
  WAIT_BAR(0);
  DMA_K(3,0);DMA_V(1,SLOTB);
  ROT();
  kload8(kf,kp0+sl_cur);
  WAIT_BAR(2);
  s16x4 vlo[8],vhi[8]; u32x4 pw0,pw1,pw2,pw3;
  #define PKW(P,B) cvtpk_s(P[B],P[B+1])
  #define PAF(k) __builtin_bit_cast(bf16x8,pw##k)
  #define VFR(i) (bf16x8){vlo[i][0],vlo[i][1],vlo[i][2],vlo[i][3],vhi[i][0],vhi[i][1],vhi[i][2],vhi[i][3]}
  #define PIN(x) asm volatile("":"+v"(x))
  #define MX3(a,b,c) __builtin_fmaxf(__builtin_fmaxf((a),(b)),(c))
  #define GAPA(MF,A0,A1,A2,A3,W0,W1,PW) do{ MF; sacc+=A0; sacc+=A1; sacc+=A2; sacc+=A3; PIN(sacc); W0; W1; PIN(PW); SBAR(); }while(0)
  #define EX(v) __builtin_amdgcn_exp2f(v)
  #define GAPB(MF,X,B) do{ MF; X[B]=EX(X[B]); X[B+1]=EX(X[B+1]); X[B+2]=EX(X[B+2]); X[B+3]=EX(X[B+3]); PIN(X); SBAR(); }while(0)
  #define VRD(i) do{ vlo[i]=vtr(vp_+(((i)>>2)*4096+((i)&3)*1024)); vhi[i]=vtr(vp_+(((i)>>2)*4096+((i)&3)*1024+512)); }while(0)
  #define KRD(G,j) do{ if(G){ kload2(kf,kp0+sl_next,j); SBAR(); } }while(0)
  #define STEP(C0,C1,P0,P1,t,GK,GV,GL) do{ SBAR(); \
    const lds_cptr vp_=vp0+sl_prev; \
    VRD(0); SBAR(); float sacc=(P0[0]+P0[1]); \
    GAPA(C0=__builtin_amdgcn_mfma_f32_32x32x16_bf16(kf[0],qr[0],negm,0,0,0), P0[2],P0[3],P0[4],P0[5],     pw0[0]=PKW(P0,0), pw0[1]=PKW(P0,2), pw0); \
    VRD(4); SBAR(); GAPA(C1=__builtin_amdgcn_mfma_f32_32x32x16_bf16(kf[1],qr[0],negm,0,0,0), P0[6],P0[7],P0[8],P0[9],     pw0[2]=PKW(P0,4), pw0[3]=PKW(P0,6), pw0); \
    VRD(1); SBAR(); GAPA(C0=__builtin_amdgcn_mfma_f32_32x32x16_bf16(kf[2],qr[1],C0,0,0,0),   P0[10],P0[11],P0[12],P0[13], pw1[0]=PKW(P0,8), pw1[1]=PKW(P0,10), pw1); \
    VRD(5); SBAR(); GAPA(C1=__builtin_amdgcn_mfma_f32_32x32x16_bf16(kf[3],qr[1],C1,0,0,0),   P0[14],P0[15],P1[0],P1[1],   pw1[2]=PKW(P0,12),pw1[3]=PKW(P0,14), pw1); \
    VRD(2); SBAR(); GAPA(C0=__builtin_amdgcn_mfma_f32_32x32x16_bf16(kf[4],qr[2],C0,0,0,0),   P1[2],P1[3],P1[4],P1[5],     pw2[0]=PKW(P1,0), pw2[1]=PKW(P1,2), pw2); \
    VRD(6); SBAR(); GAPA(C1=__builtin_amdgcn_mfma_f32_32x32x16_bf16(kf[5],qr[2],C1,0,0,0),   P1[6],P1[7],P1[8],P1[9],     pw2[2]=PKW(P1,4), pw2[3]=PKW(P1,6), pw2); \
    VRD(3); SBAR(); GAPA(C0=__builtin_amdgcn_mfma_f32_32x32x16_bf16(kf[6],qr[3],C0,0,0,0),   P1[10],P1[11],P1[12],P1[13], pw3[0]=PKW(P1,8), pw3[1]=PKW(P1,10), pw3); \
    VRD(7); SBAR(); GAPA(C1=__builtin_amdgcn_mfma_f32_32x32x16_bf16(kf[7],qr[3],C1,0,0,0),   P1[14],P1[15],0.f,0.f,       pw3[2]=PKW(P1,12),pw3[3]=PKW(P1,14), pw3); \
    l_reg+=sacc; \
    if(GK){DMA_K((t)+3,sl_cur);} if(GV){DMA_V((t)+1,sl_next);} \
    CMASK(C0,C1,t); \
    { float a=MX3(C0[0],C0[1],C1[0]),b=MX3(C0[2],C0[3],C1[1]); a=MX3(a,C1[2],C1[3]); \
      _Pragma("unroll") for(int r=4;r<16;r+=4){a=MX3(a,C0[r],C0[r+1]);b=MX3(b,C0[r+2],C0[r+3]);a=MX3(a,C1[r],C1[r+1]);b=MX3(b,C1[r+2],C1[r+3]);} \
      float rm=__builtin_fmaxf(a,b); { auto rr=__builtin_amdgcn_permlane32_swap(__float_as_uint(rm),__float_as_uint(rm),false,false); rm=__builtin_fmaxf(__uint_as_float(rr[0]),__uint_as_float(rr[1])); } \
      resc=false; \
      if(__builtin_expect(__any(rm>(float)THRL),0)){ const float dl=__builtin_fmaxf(rm,0.f); mhat+=dl; \
        _Pragma("unroll") for(int r=0;r<16;++r){C0[r]-=dl;C1[r]-=dl;} \
        _Pragma("unroll") for(int r=0;r<16;++r)negm[r]=-mhat; asm volatile("":"+v"(negm)); \
        const float f=__builtin_amdgcn_exp2f(-dl); l_reg*=f; if(hi==0)wsf[r32]=f; resc=true; } } \
    SBAR(); \
    GAPB(o[0]=__builtin_amdgcn_mfma_f32_32x32x16_bf16(PAF(0),VFR(0),o[0],0,0,0), C0,0); \
    GAPB(o[1]=__builtin_amdgcn_mfma_f32_32x32x16_bf16(PAF(0),VFR(4),o[1],0,0,0), C0,4); \
    KRD(GL,0); GAPB(o[0]=__builtin_amdgcn_mfma_f32_32x32x16_bf16(PAF(1),VFR(1),o[0],0,0,0), C0,8); \
    KRD(GL,1); GAPB(o[1]=__builtin_amdgcn_mfma_f32_32x32x16_bf16(PAF(1),VFR(5),o[1],0,0,0), C0,12); \
    KRD(GL,2); GAPB(o[0]=__builtin_amdgcn_mfma_f32_32x32x16_bf16(PAF(2),VFR(2),o[0],0,0,0), C1,0); \
    KRD(GL,3); GAPB(o[1]=__builtin_amdgcn_mfma_f32_32x32x16_bf16(PAF(2),VFR(6),o[1],0,0,0), C1,4); \
    GAPB(o[0]=__builtin_amdgcn_mfma_f32_32x32x16_bf16(PAF(3),VFR(3),o[0],0,0,0), C1,8); \
    GAPB(o[1]=__builtin_amdgcn_mfma_f32_32x32x16_bf16(PAF(3),VFR(7),o[1],0,0,0), C1,12); \
    }while(0)
  int t=1;
  #undef CMASK
  #define CMASK(P0,P1,t) do{}while(0)
  for(;t+5<NT;t+=2){
    STEP(pB0,pB1,pA0,pA1,t,true,true,true);     WAIT_BAR(2); RESC(); ROT();
    STEP(pA0,pA1,pB0,pB1,t+1,true,true,true);   WAIT_BAR(2); RESC(); ROT();
  }
  #undef CMASK
  #define CMASK(P0,P1,t) do{}while(0)
  #define ENDW(tt) do{ if((tt)+3<NT){WAIT_BAR(2);} else if((tt)+2<NT){WAIT_BAR(1);} else {WAIT_BAR(0);} }while(0)
  for(;t+1<NT;t+=2){
    STEP(pB0,pB1,pA0,pA1,t,(t+3<NT),(t+1<NT),(t+1<NT));       ENDW(t);   RESC(); ROT();
    STEP(pA0,pA1,pB0,pB1,t+1,(t+4<NT),(t+2<NT),(t+2<NT));     ENDW(t+1); RESC(); ROT();
  }
  STEP(pB0,pB1,pA0,pA1,NT-1,false,false,false); RESC();
  { float sacc=pB0[0]+pB0[1]; _Pragma("unroll") for(int r=2;r<16;++r)sacc+=pB0[r]; _Pragma("unroll") for(int r=0;r<16;++r)sacc+=pB1[r]; l_reg+=sacc;
    pw0=(u32x4){PKW(pB0,0),PKW(pB0,2),PKW(pB0,4),PKW(pB0,6)};pw1=(u32x4){PKW(pB0,8),PKW(pB0,10),PKW(pB0,12),PKW(pB0,14)};pw2=(u32x4){PKW(pB1,0),PKW(pB1,2),PKW(pB1,4),PKW(pB1,6)};pw3=(u32x4){PKW(pB1,8),PKW(pB1,10),PKW(pB1,12),PKW(pB1,14)};
    SBAR(); pv(o,vb0+sl_cur,PAF(0),PAF(1),PAF(2),PAF(3)); }
  #undef PKW
  #undef PAF
  #undef VFR
  #undef PIN
  #undef MX3
  #undef GAPA
  #undef GAPB
  #undef EX
  #undef VRD
  #undef KRD
  #undef STEP
  #undef ENDW
  {auto rr=__builtin_amdgcn_permlane32_swap(__float_as_uint(l_reg),__float_as_uint(l_reg),false,false);l_reg=__uint_as_float(rr[0])+__uint_as_float(rr[1]);}
  if(hi==0)wsf[32+r32]=l_reg;asm volatile("s_waitcnt lgkmcnt(0)":::"memory");
  float rli[16];
  #pragma unroll
  for(int r=0;r<16;++r)rli[r]=__builtin_amdgcn_rcpf(wsf[32+crow(r,hi)]);
  bf16*Ow=O0+(long)(wid*QBLK)*op;
  { bf16*stg=(bf16*)(shm+LDS_OST)+wid*2048;
    #pragma unroll
    for(int r=0;r<16;++r){const int orow=crow(r,hi);
      #pragma unroll
      for(int d0=0;d0<2;++d0)stg[orow*64+d0*32+r32]=__float2bfloat16(o[d0][r]*rli[r]);}
    asm volatile("s_waitcnt lgkmcnt(0)":::"memory");
    #pragma unroll
    for(int i=0;i<4;++i){const int row=i*8+(lane>>3),ch=lane&7; const u32x4 v=*(const u32x4*)(stg+row*64+ch*8); ATTN_STORE16(Ow+(long)row*op+ch*8,v);} }
  asm volatile("s_waitcnt lgkmcnt(0)\n\ts_barrier":::"memory");
  #undef DMA_K
  #undef DMA_V
  #undef CMASK
  #undef START
  #undef RESC
  #undef ROT
}
template<int THRL> __device__ __forceinline__ void attn_unit_dv(const bf16*Q0,int qp,const bf16*__restrict__ K0,int kp,const bf16*__restrict__ V0,int vp,bf16*O0,int op,const int NT,char*shm){
  int tid_=threadIdx.x; asm volatile("":"+v"(tid_)); const int tid=tid_,lane=tid&63,r32=lane&31,hi=lane>>5; const int wid=__builtin_amdgcn_readfirstlane(tid>>6);
  const bf16*Qw=Q0+(long)(wid*QBLK)*qp;
  const bf16*Kh=K0,*Vh=V0;
  const unsigned lds0=(unsigned)(uintptr_t)shm;
  float*wsf=(float*)(shm+LDS_WS2)+wid*64;
  const bf16*ksrc=Kh+(long)lane*kp+wid*8;
  const bf16*vsrc=Vh+(long)(16*(wid&3)+(lane>>2))*vp+(wid>>2)*32+(lane&3)*8;
  const unsigned kdst=lds0+LDS_K+wid*1024, vdst=lds0+LDS_V2+wid*1024;
  #define DMA_K(t,slot) glds16(ksrc+(long)(t)*KVBLK*kp,(unsigned)__builtin_amdgcn_readfirstlane(kdst+(slot)))
  #define DMA_V(t,slot) do{ glds16(vsrc+(long)(t)*KVBLK*vp,(unsigned)__builtin_amdgcn_readfirstlane(vdst+2*(slot))); glds16(vsrc+(long)(t)*KVBLK*vp+64,(unsigned)__builtin_amdgcn_readfirstlane(vdst+2*(slot)+8192)); }while(0)
  const int vb0=(int)(lds0+LDS_V2)+((lane>>4)&1)*32+(lane&3)*8+(4*hi+((lane&15)>>2))*64;
  const char*Kbase=shm+LDS_K; bf16x8 kf[8];
  const lds_cptr shm3=(lds_cptr)shm; const lds_cptr kp0=shm3+LDS_K+hi*1024+r32*16; const lds_cptr vp0=shm3+LDS_V2+((lane>>4)&1)*32+(lane&3)*8+(4*hi+((lane&15)>>2))*64;
  DMA_K(0,0);DMA_V(0,0);DMA_K(1,SLOTB);
  bf16x8 qr[4];
  #pragma unroll
  for(int d0=0;d0<4;++d0)qr[d0]=*reinterpret_cast<const bf16x8*>(&Qw[(long)r32*qp+d0*16+hi*8]);
  float mhat=0.f,l_reg=0.f;f32x16 o[4];o[0]=f32x16{};o[1]=f32x16{};o[2]=f32x16{};o[3]=f32x16{};f32x16 negm=f32x16{};asm volatile("":"+v"(negm));
  #define CMASK(P0,P1,t) do{}while(0)
  bool resc=false;
  #define START(P0,P1) do{ const float rm=rowmax(P0,P1); resc=false; \
    { const float dl=rm; mhat=fadd_s(mhat,dl); \
      _Pragma("unroll") for(int r=0;r<16;++r){P0[r]=fsub_s(P0[r],dl);P1[r]=fsub_s(P1[r],dl);} \
      _Pragma("unroll") for(int r=0;r<16;++r)negm[r]=-mhat; asm volatile("":"+v"(negm)); } \
    _Pragma("unroll") for(int r=0;r<16;++r)P0[r]=__builtin_amdgcn_exp2f(P0[r]); }while(0)
  #define RESC() do{ if(resc){ asm volatile("s_waitcnt lgkmcnt(0)":::"memory"); \
      _Pragma("unroll") for(int d_=0;d_<4;++d_) _Pragma("unroll") for(int r=0;r<16;++r)o[d_][r]*=wsf[crow(r,hi)]; } }while(0)
  f32x16 pA0,pA1,pB0,pB1;
  int sl_prev=0,sl_cur=0,sl_next=SLOTB;
  #define ROT() do{sl_prev=sl_cur;sl_cur=sl_next;sl_next=(sl_next==(NSLOT-1)*SLOTB)?0:sl_next+SLOTB;}while(0)
  DMA_K(2,2*SLOTB);
  WAIT_BAR(4);
  qkt(pA0,pA1,Kbase,qr,negm,r32,hi);asm volatile("s_nop 15\n\ts_nop 7":"+v"(pA0),"+v"(pA1));CMASK(pA0,pA1,0);
  START(pA0,pA1);
  _Pragma("unroll") for(int r=0;r<16;++r)pA1[r]=__builtin_amdgcn_exp2f(pA1[r]);
  WAIT_BAR(0);
  DMA_K(3,0);DMA_V(1,SLOTB);
  ROT();
  kload8(kf,kp0+sl_cur);
  WAIT_BAR(3);
  s16x4 vlo[16],vhi[16]; u32x4 pw0,pw1,pw2,pw3;
  #define PKW(P,B) cvtpk_s(P[B],P[B+1])
  #define PAF(k) __builtin_bit_cast(bf16x8,pw##k)
  #define VFR(i) (bf16x8){vlo[i][0],vlo[i][1],vlo[i][2],vlo[i][3],vhi[i][0],vhi[i][1],vhi[i][2],vhi[i][3]}
  #define PIN(x) asm volatile("":"+v"(x))
  #define MX3(a,b,c) __builtin_fmaxf(__builtin_fmaxf((a),(b)),(c))
  #define GAPA(MF,A0,A1,A2,A3,W0,W1,PW) do{ MF; sacc+=A0; sacc+=A1; sacc+=A2; sacc+=A3; PIN(sacc); W0; W1; PIN(PW); SBAR(); }while(0)
  #define EX(v) __builtin_amdgcn_exp2f(v)
  #define GAPB(MF,X,B) do{ MF; X[B]=EX(X[B]); X[B+1]=EX(X[B+1]); PIN(X); SBAR(); }while(0)
  #define VRD(i) do{ vlo[i]=vtr(vp_+(((i)>>2)*4096+((i)&3)*1024)); vhi[i]=vtr(vp_+(((i)>>2)*4096+((i)&3)*1024+512)); }while(0)
  #define KRD(G,j) do{ if(G){ kload2(kf,kp0+sl_next,j); SBAR(); } }while(0)
  #define STEP(C0,C1,P0,P1,t,GK,GV,GL) do{ SBAR(); \
    const lds_cptr vp_=vp0+2*sl_prev; \
    float sacc=(P0[0]+P0[1]); \
    GAPA(C0=__builtin_amdgcn_mfma_f32_32x32x16_bf16(kf[0],qr[0],negm,0,0,0), P0[2],P0[3],P0[4],P0[5],     pw0[0]=PKW(P0,0), pw0[1]=PKW(P0,2), pw0); \
    GAPA(C1=__builtin_amdgcn_mfma_f32_32x32x16_bf16(kf[1],qr[0],negm,0,0,0), P0[6],P0[7],P0[8],P0[9],     pw0[2]=PKW(P0,4), pw0[3]=PKW(P0,6), pw0); \
    GAPA(C0=__builtin_amdgcn_mfma_f32_32x32x16_bf16(kf[2],qr[1],C0,0,0,0),   P0[10],P0[11],P0[12],P0[13], pw1[0]=PKW(P0,8), pw1[1]=PKW(P0,10), pw1); \
    GAPA(C1=__builtin_amdgcn_mfma_f32_32x32x16_bf16(kf[3],qr[1],C1,0,0,0),   P0[14],P0[15],P1[0],P1[1],   pw1[2]=PKW(P0,12),pw1[3]=PKW(P0,14), pw1); \
    VRD(0); SBAR(); GAPA(C0=__builtin_amdgcn_mfma_f32_32x32x16_bf16(kf[4],qr[2],C0,0,0,0),   P1[2],P1[3],P1[4],P1[5],     pw2[0]=PKW(P1,0), pw2[1]=PKW(P1,2), pw2); \
    VRD(4); SBAR(); GAPA(C1=__builtin_amdgcn_mfma_f32_32x32x16_bf16(kf[5],qr[2],C1,0,0,0),   P1[6],P1[7],P1[8],P1[9],     pw2[2]=PKW(P1,4), pw2[3]=PKW(P1,6), pw2); \
    VRD(1); SBAR(); GAPA(C0=__builtin_amdgcn_mfma_f32_32x32x16_bf16(kf[6],qr[3],C0,0,0,0),   P1[10],P1[11],P1[12],P1[13], pw3[0]=PKW(P1,8), pw3[1]=PKW(P1,10), pw3); \
    VRD(5); SBAR(); GAPA(C1=__builtin_amdgcn_mfma_f32_32x32x16_bf16(kf[7],qr[3],C1,0,0,0),   P1[14],P1[15],0.f,0.f,       pw3[2]=PKW(P1,12),pw3[3]=PKW(P1,14), pw3); \
    l_reg+=sacc; \
    if(GK){DMA_K((t)+3,sl_cur);} if(GV){DMA_V((t)+1,sl_next);} \
    CMASK(C0,C1,t); \
    { float a=MX3(C0[0],C0[1],C1[0]),b=MX3(C0[2],C0[3],C1[1]); a=MX3(a,C1[2],C1[3]); \
      _Pragma("unroll") for(int r=4;r<16;r+=4){a=MX3(a,C0[r],C0[r+1]);b=MX3(b,C0[r+2],C0[r+3]);a=MX3(a,C1[r],C1[r+1]);b=MX3(b,C1[r+2],C1[r+3]);} \
      float rm=__builtin_fmaxf(a,b); { auto rr=__builtin_amdgcn_permlane32_swap(__float_as_uint(rm),__float_as_uint(rm),false,false); rm=__builtin_fmaxf(__uint_as_float(rr[0]),__uint_as_float(rr[1])); } \
      resc=false; \
      if(__builtin_expect(__any(rm>(float)THRL),0)){ const float dl=__builtin_fmaxf(rm,0.f); mhat+=dl; \
        _Pragma("unroll") for(int r=0;r<16;++r){C0[r]-=dl;C1[r]-=dl;} \
        _Pragma("unroll") for(int r=0;r<16;++r)negm[r]=-mhat; asm volatile("":"+v"(negm)); \
        const float f=__builtin_amdgcn_exp2f(-dl); l_reg*=f; if(hi==0)wsf[r32]=f; resc=true; } } \
    SBAR(); \
    VRD(2); SBAR(); GAPB(o[0]=__builtin_amdgcn_mfma_f32_32x32x16_bf16(PAF(0),VFR(0),o[0],0,0,0), C0,0); \
    VRD(6); SBAR(); GAPB(o[1]=__builtin_amdgcn_mfma_f32_32x32x16_bf16(PAF(0),VFR(4),o[1],0,0,0), C0,2); \
    VRD(3); SBAR(); GAPB(o[0]=__builtin_amdgcn_mfma_f32_32x32x16_bf16(PAF(1),VFR(1),o[0],0,0,0), C0,4); \
    VRD(7); SBAR(); GAPB(o[1]=__builtin_amdgcn_mfma_f32_32x32x16_bf16(PAF(1),VFR(5),o[1],0,0,0), C0,6); \
    VRD(8); SBAR(); GAPB(o[0]=__builtin_amdgcn_mfma_f32_32x32x16_bf16(PAF(2),VFR(2),o[0],0,0,0), C0,8); \
    VRD(12); SBAR(); GAPB(o[1]=__builtin_amdgcn_mfma_f32_32x32x16_bf16(PAF(2),VFR(6),o[1],0,0,0), C0,10); \
    VRD(9); SBAR(); GAPB(o[0]=__builtin_amdgcn_mfma_f32_32x32x16_bf16(PAF(3),VFR(3),o[0],0,0,0), C0,12); \
    VRD(13); SBAR(); GAPB(o[1]=__builtin_amdgcn_mfma_f32_32x32x16_bf16(PAF(3),VFR(7),o[1],0,0,0), C0,14); \
    VRD(10); SBAR(); GAPB(o[2]=__builtin_amdgcn_mfma_f32_32x32x16_bf16(PAF(0),VFR(8),o[2],0,0,0), C1,0); \
    VRD(14); SBAR(); GAPB(o[3]=__builtin_amdgcn_mfma_f32_32x32x16_bf16(PAF(0),VFR(12),o[3],0,0,0), C1,2); \
    VRD(11); SBAR(); GAPB(o[2]=__builtin_amdgcn_mfma_f32_32x32x16_bf16(PAF(1),VFR(9),o[2],0,0,0), C1,4); \
    VRD(15); SBAR(); GAPB(o[3]=__builtin_amdgcn_mfma_f32_32x32x16_bf16(PAF(1),VFR(13),o[3],0,0,0), C1,6); \
    KRD(GL,0); GAPB(o[2]=__builtin_amdgcn_mfma_f32_32x32x16_bf16(PAF(2),VFR(10),o[2],0,0,0), C1,8); \
    KRD(GL,1); GAPB(o[3]=__builtin_amdgcn_mfma_f32_32x32x16_bf16(PAF(2),VFR(14),o[3],0,0,0), C1,10); \
    KRD(GL,2); GAPB(o[2]=__builtin_amdgcn_mfma_f32_32x32x16_bf16(PAF(3),VFR(11),o[2],0,0,0), C1,12); \
    KRD(GL,3); GAPB(o[3]=__builtin_amdgcn_mfma_f32_32x32x16_bf16(PAF(3),VFR(15),o[3],0,0,0), C1,14); \
    }while(0)
  int t=1;
  #undef CMASK
  #define CMASK(P0,P1,t) do{}while(0)
  for(;t+5<NT;t+=2){
    STEP(pB0,pB1,pA0,pA1,t,true,true,true);     WAIT_BAR(3); RESC(); ROT();
    STEP(pA0,pA1,pB0,pB1,t+1,true,true,true);   WAIT_BAR(3); RESC(); ROT();
  }
  #undef CMASK
  #define CMASK(P0,P1,t) do{}while(0)
  #define ENDW(tt) do{ if((tt)+3<NT){WAIT_BAR(3);} else if((tt)+2<NT){WAIT_BAR(2);} else {WAIT_BAR(0);} }while(0)
  for(;t+1<NT;t+=2){
    STEP(pB0,pB1,pA0,pA1,t,(t+3<NT),(t+1<NT),(t+1<NT));       ENDW(t);   RESC(); ROT();
    STEP(pA0,pA1,pB0,pB1,t+1,(t+4<NT),(t+2<NT),(t+2<NT));     ENDW(t+1); RESC(); ROT();
  }
  STEP(pB0,pB1,pA0,pA1,NT-1,false,false,false); RESC();
  { float sacc=pB0[0]+pB0[1]; _Pragma("unroll") for(int r=2;r<16;++r)sacc+=pB0[r]; _Pragma("unroll") for(int r=0;r<16;++r)sacc+=pB1[r]; l_reg+=sacc;
    pw0=(u32x4){PKW(pB0,0),PKW(pB0,2),PKW(pB0,4),PKW(pB0,6)};pw1=(u32x4){PKW(pB0,8),PKW(pB0,10),PKW(pB0,12),PKW(pB0,14)};pw2=(u32x4){PKW(pB1,0),PKW(pB1,2),PKW(pB1,4),PKW(pB1,6)};pw3=(u32x4){PKW(pB1,8),PKW(pB1,10),PKW(pB1,12),PKW(pB1,14)};
    SBAR(); pv4(o,vb0+2*sl_cur,PAF(0),PAF(1),PAF(2),PAF(3)); }
  #undef PKW
  #undef PAF
  #undef VFR
  #undef PIN
  #undef MX3
  #undef GAPA
  #undef GAPB
  #undef EX
  #undef VRD
  #undef KRD
  #undef STEP
  #undef ENDW
  {auto rr=__builtin_amdgcn_permlane32_swap(__float_as_uint(l_reg),__float_as_uint(l_reg),false,false);l_reg=__uint_as_float(rr[0])+__uint_as_float(rr[1]);}
  if(hi==0)wsf[32+r32]=l_reg;asm volatile("s_waitcnt lgkmcnt(0)":::"memory");
  float rli[16];
  #pragma unroll
  for(int r=0;r<16;++r)rli[r]=__builtin_amdgcn_rcpf(wsf[32+crow(r,hi)]);
  bf16*Ow=O0+(long)(wid*QBLK)*op;
  { bf16*stg=(bf16*)(shm+LDS_OST2)+wid*2048;
    #pragma unroll
    for(int hh=0;hh<2;++hh){
      #pragma unroll
      for(int r=0;r<16;++r){const int orow=crow(r,hi);
        #pragma unroll
        for(int d0=0;d0<2;++d0)stg[orow*64+d0*32+r32]=__float2bfloat16(o[2*hh+d0][r]*rli[r]);}
      asm volatile("s_waitcnt lgkmcnt(0)":::"memory");
      #pragma unroll
      for(int i=0;i<4;++i){const int row=i*8+(lane>>3),ch=lane&7; const u32x4 v=*(const u32x4*)(stg+row*64+ch*8); ATTN_STORE16(Ow+(long)row*op+hh*64+ch*8,v);}
      asm volatile("s_waitcnt lgkmcnt(0)":::"memory"); } }
  asm volatile("s_waitcnt lgkmcnt(0)\n\ts_barrier":::"memory");
  #undef DMA_K
  #undef DMA_V
  #undef CMASK
  #undef START
  #undef RESC
  #undef ROT
}
#undef SBAR
#undef WAIT_BAR
}

constexpr size_t MiB = 1u << 20;
constexpr size_t WS_CTL = 0, CTL_ZERO_BYTES = 1 * MiB;
constexpr size_t WS_MOD = 1 * MiB;
constexpr size_t WS_TAB = 1 * MiB + 256 * 1024;
constexpr size_t WS_LAM = 1 * MiB + 272 * 1024;
constexpr size_t WS_ME = 2 * MiB, WS_MP = 2 * MiB + 128 * 1024, WS_MW = 2 * MiB + 256 * 1024;
constexpr size_t WS_WIN = 4 * MiB;
constexpr size_t WS_WPRJ = 30 * MiB;
constexpr size_t WS_W13 = 42 * MiB;
constexpr size_t WS_W2F = 53 * MiB;
constexpr size_t WS_XC = 60 * MiB;
constexpr size_t WS_H = 64 * MiB;
constexpr size_t WS_P = 98 * MiB;
constexpr size_t WS_OA = 319 * MiB;
constexpr size_t WS_MX = 421 * MiB;
constexpr size_t WS_U = 98 * MiB;
constexpr size_t WS_MW2 = 4 * MiB;
constexpr size_t WS_HS = 98 * MiB;
constexpr size_t WS_U2 = 166 * MiB;
constexpr size_t WS_MW13 = 404 * MiB;
constexpr size_t WS_END = 516 * MiB;
static_assert(WS_P + (size_t)MEXT * INW * 2 <= WS_OA && WS_OA + (size_t)MEXT * OAW * 2 <= WS_MX && WS_MX + (size_t)MEXT * DM * 2 <= WS_END, "attention-phase map");
static_assert(WS_HS + (size_t)MOE_ROWS * DM * 2 <= WS_U2 && WS_U2 + (size_t)MOE_ROWS * DFE * 2 <= WS_MW13 && WS_MW13 + (size_t)NEXP * 2 * DFE * DM * 2 <= WS_END && WS_MW2 + (size_t)NEXP * DFE * DM * 2 <= WS_XC, "MoE-phase map");
static_assert(WS_W2F + (size_t)DM * DFF * 2 <= WS_XC && WS_U + (size_t)MEXT * DFF * 2 <= WS_OA && WS_H + (size_t)MEXT * DM * 2 <= WS_P, "dense map");
constexpr int CW_BAR = 4096;
constexpr int CW_MOE = 8192;

constexpr int NWAVES = 8;
constexpr int RING_OFF = 0, RING_BYTES = 131072;
constexpr int LDSCTL_OFF = RING_BYTES, MISC_OFF = LDSCTL_OFF + 320;
constexpr int LDS_BYTES = 147456;
static_assert(MISC_OFF + 128 <= LDS_BYTES, "LDS map");

#define GAS __attribute__((address_space(1)))
#define LAS __attribute__((address_space(3)))
typedef unsigned short bf16;
typedef unsigned v4u __attribute__((ext_vector_type(4)));
typedef float f32x4 __attribute__((ext_vector_type(4)));
typedef short bf16x8 __attribute__((ext_vector_type(8)));
typedef GAS unsigned gu32;
typedef GAS unsigned long long gu64;
#define RLX_AGENT __ATOMIC_RELAXED, __HIP_MEMORY_SCOPE_AGENT
#define LDS_WAIT() asm volatile("s_waitcnt lgkmcnt(0)" ::: "memory")
#define VM_WAIT() asm volatile("s_waitcnt vmcnt(0)" ::: "memory")
__device__ __forceinline__ unsigned long long rt() { return __builtin_amdgcn_s_memrealtime(); }
__device__ __forceinline__ unsigned f2bf(float f) { unsigned u = __builtin_bit_cast(unsigned, f); return (u + 0x7fffu + ((u >> 16) & 1u)) >> 16; }
__device__ __forceinline__ unsigned pk2(float lo, float hi) { return f2bf(lo) | (f2bf(hi) << 16); }

#define XB_TMO      128
#define XB_XCNT(j)  (256  + 64 * (j))
#define XB_XSUB(j)  (1280 + 64 * (j))
#define XB_XGEN(j)  (2304 + 64 * (j))
#define XB_TOP      3328
#define XB_TOPGEN   3392
#define XCD_BAR_WORDS 3456
#define XB_SPIN_CAP (1u << 22)

__device__ __forceinline__ unsigned xb_ld(unsigned* p)              { return __hip_atomic_load(p, __ATOMIC_RELAXED, __HIP_MEMORY_SCOPE_AGENT); }
__device__ __forceinline__ unsigned xb_add(unsigned* p, unsigned v) { return __hip_atomic_fetch_add(p, v, __ATOMIC_RELAXED, __HIP_MEMORY_SCOPE_AGENT); }
__device__ __forceinline__ unsigned xb_xcc_id() { return (unsigned)__builtin_amdgcn_s_getreg((3 << 11) | 20) & 0xFu; }
#define XB_SPIN(cond, bar) do { unsigned _sp = 0; while (cond) { __builtin_amdgcn_s_sleep(1); \
    if ((++_sp & 255u) == 0u) { if (xb_ld(&(bar)[XB_TMO])) break; if (_sp > XB_SPIN_CAP) { atomicAdd(&(bar)[XB_TMO], 1u); break; } } } } while (0)

struct XcdBarrier {
    unsigned* bar; unsigned x;
    volatile LAS unsigned* st;
};

__device__ __forceinline__ XcdBarrier xcd_barrier_post(unsigned* bar, volatile LAS unsigned* st) {
    XcdBarrier b; b.bar = bar; b.x = xb_xcc_id(); b.st = st;
    if (threadIdx.x == 0) (void)xb_add(&bar[XB_XCNT(b.x)], 1u);
    return b;
}
__device__ __forceinline__ void xcd_barrier_complete(unsigned* bar, unsigned x, unsigned& nloc, unsigned& nx) {
    const unsigned G = gridDim.x * gridDim.y * gridDim.z;
    unsigned sum, cnt, mine, sp = 0u;
    for (;;) {
        sum = 0u; cnt = 0u; mine = 0u;
#pragma unroll
        for (unsigned j = 0; j < 16; ++j) { const unsigned c = xb_ld(&bar[XB_XCNT(j)]); sum += c; cnt += (c > 0u) ? 1u : 0u; mine = (j == x) ? c : mine; }
        if (sum == G) break;
        __builtin_amdgcn_s_sleep(1);
        if ((++sp & 255u) == 0u) { if (xb_ld(&bar[XB_TMO])) break; if (sp > XB_SPIN_CAP) { atomicAdd(&bar[XB_TMO], 1u); break; } }
    }
    nloc = mine > 0u ? mine : 1u; nx = cnt > 0u ? cnt : 1u;
}

__device__ __forceinline__ void xcd_barrier(const XcdBarrier& b) {
    asm volatile("s_waitcnt vmcnt(0)" ::: "memory");
    __syncthreads();
    if (threadIdx.x == 0) {
        unsigned* bar = b.bar;
        __builtin_amdgcn_s_waitcnt(0);
        unsigned nloc = b.st[0], nx = b.st[1];
        if (nloc == 0u) { xcd_barrier_complete(bar, b.x, nloc, nx); b.st[0] = nloc; b.st[1] = nx; }
        const unsigned old = xb_add(&bar[XB_XSUB(b.x)], 1u);
        const unsigned gen = old / nloc;
        if (old + 1u == (gen + 1u) * nloc) {
            __builtin_amdgcn_fence(__ATOMIC_RELEASE, "agent");
            asm volatile("s_waitcnt vmcnt(0)" ::: "memory");
            const unsigned og = xb_add(&bar[XB_TOP], 1u);
            const unsigned tg = og / nx;
            if (og + 1u == (tg + 1u) * nx) xb_add(&bar[XB_TOPGEN], 1u);
            else XB_SPIN(xb_ld(&bar[XB_TOPGEN]) == tg, bar);
            __builtin_amdgcn_fence(__ATOMIC_ACQUIRE, "agent");
            xb_add(&bar[XB_XGEN(b.x)], 1u);
            asm volatile("s_waitcnt vmcnt(0)" ::: "memory");
        } else {
            XB_SPIN(xb_ld(&bar[XB_XGEN(b.x)]) == gen, bar);
            __builtin_amdgcn_fence(__ATOMIC_ACQUIRE, "agent");
            asm volatile("s_waitcnt vmcnt(0)" ::: "memory");
        }
    }
    __syncthreads();
}

__device__ __forceinline__ float wave_sum(float v) {
#pragma unroll
    for (int o = 1; o < 64; o <<= 1) v += __shfl_xor(v, o);
    return v;
}
__device__ __forceinline__ unsigned pkbf(float lo, float hi) { return pg8::cvt_pk_bf16(lo, hi); }
__device__ __forceinline__ int dst_row0(int mode, int n0) {
    if (mode == 0) return n0;
    if (mode == 1) { const int t = n0 >> 8, blk = (n0 & 255) >> 5, wc = blk >> 1, bj = blk & 1; return (t << 8) + 32 * (4 * bj + wc); }
    const int r = ((n0 >> 7) << 8) + (n0 & 127); return mode == 2 ? r : r + 128;
}
__device__ __forceinline__ void transpose_item(const float* W, int K, int N, bf16* WT, int mode, LAS float* scr, int item, int lane) {
    const int nblk = N / 32, kb = item / nblk, nb = item % nblk, k0 = 64 * kb, n0 = 32 * nb, d0 = dst_row0(mode, n0);
#pragma unroll 8
    for (int i = 0; i < 32; ++i) { const int kk = 2 * i + (lane >> 5); scr[kk * 33 + (lane & 31)] = W[(size_t)(k0 + kk) * N + n0 + (lane & 31)]; }
    LDS_WAIT(); asm volatile("" ::: "memory");
    const int c = lane & 7;
#pragma unroll
    for (int j = 0; j < 4; ++j) { const int n = (lane >> 3) + 8 * j; const LAS float* s = scr + (8 * c) * 33 + n;
        v4u o; o.x = pkbf(s[0 * 33], s[1 * 33]); o.y = pkbf(s[2 * 33], s[3 * 33]); o.z = pkbf(s[4 * 33], s[5 * 33]); o.w = pkbf(s[6 * 33], s[7 * 33]);
        *(GAS v4u*)(WT + (size_t)(d0 + n) * K + k0 + 8 * c) = o; }
    LDS_WAIT(); asm volatile("" ::: "memory");
}
__device__ __forceinline__ void norm_mod_row(const float* xrow, const float* g, const float* sh, const float* sc, bf16* orow, int lane, f32x4 (&h)[4]) {
    const GAS f32x4* xr = (const GAS f32x4*)xrow + lane; float ss = 0.f;
#pragma unroll
    for (int j = 0; j < 4; ++j) { h[j] = xr[64 * j]; ss += (h[j].x * h[j].x + h[j].y * h[j].y) + (h[j].z * h[j].z + h[j].w * h[j].w); }
    const float rs = 1.f / sqrtf(wave_sum(ss) * (1.f / DM) + EPS);
    GAS unsigned long long* o8 = (GAS unsigned long long*)orow + lane;
#pragma unroll
    for (int j = 0; j < 4; ++j) { const f32x4 g4 = ((const GAS f32x4*)g)[lane + 64 * j], s4 = ((const GAS f32x4*)sc)[lane + 64 * j], b4 = ((const GAS f32x4*)sh)[lane + 64 * j];
        h[j] = h[j] * rs * g4 * (s4 + 1.f) + b4;
        o8[64 * j] = (unsigned long long)pkbf(h[j].x, h[j].y) | ((unsigned long long)pkbf(h[j].z, h[j].w) << 32); }
}
struct Args { const float* in[24]; float* out; unsigned char* ws; };
enum { I_X = 0, I_C, I_CTX, I_CCTX, I_ADAW, I_ADAB, I_NAG, I_NFG, I_WIN, I_QNG, I_KNG, I_DLAM, I_SUBG, I_WPD, I_WPG, I_WO, I_FW1, I_FW3, I_FW2, I_ROUTER, I_MW1, I_MW3, I_MW2, I_FNG };

#ifndef REP_ATT
#define REP_ATT 1
#endif
#ifndef REP_GEMM
#define REP_GEMM 1
#endif
#define CAS __attribute__((address_space(4)))
#define PH_BEGIN \
    const CAS Args* ap = (const CAS Args*)__builtin_amdgcn_kernarg_segment_ptr(); asm volatile("" : "+s"(ap)); \
    unsigned char* const ws = (unsigned char*)(GAS unsigned char*)ap->ws; \
    int tid = threadIdx.x; asm volatile("" : "+v"(tid)); \
    const int lane = tid & 63, wave = __builtin_amdgcn_readfirstlane(tid >> 6); \
    const int G = gridDim.x, bx = blockIdx.x, vcu = (G % 8 == 0) ? (bx % 8) * (G / 8) + bx / 8 : bx, gw = vcu * NWAVES + wave, NGW = G * NWAVES; \
    (void)lane; (void)gw; (void)NGW; (void)bx; (void)ws;
#define INP(i) ((const float*)(const GAS float*)ap->in[i])
#define WSP(T, off) ((T*)(ws + (off)))
#define LDSP ((LAS unsigned char*)lds)

__global__ void __launch_bounds__(NWAVES * 64, 2) fwd_kernel(Args args) {
    extern __shared__ __attribute__((aligned(16))) unsigned char lds[];
    for (int u = threadIdx.x; u < (LDS_BYTES - LDSCTL_OFF) / 4; u += NWAVES * 64) ((LAS unsigned*)(LDSP + LDSCTL_OFF))[u] = 0u;
    __syncthreads();
    const XcdBarrier bar = xcd_barrier_post((unsigned*)(args.ws + WS_CTL) + CW_BAR, (volatile LAS unsigned*)(LDSP + MISC_OFF) + 8);
#define GRID_BAR() do { XcdBarrier b_ = bar; asm volatile("" : "+s"(b_.bar), "+s"(b_.x)); b_.bar = (unsigned*)(GAS unsigned*)b_.bar; xcd_barrier(b_); } while (0)

#define D_MOD WSP(float, WS_MOD)
#define D_TAB WSP(float, WS_TAB)
#define D_LAM WSP(float, WS_LAM)
#define D_H WSP(bf16, WS_H)
#define D_P WSP(bf16, WS_P)
#define D_OA WSP(bf16, WS_OA)
#define D_MX WSP(bf16, WS_MX)
#define D_XC WSP(float, WS_XC)
#define D_X ((float*)(GAS float*)ap->out)
#define D_SCR ((LAS float*)(LDSP + RING_OFF + wave * 8448))
#define D_MODL (D_MOD + (size_t)l * 5 * 6144)
#define D_CNT ((gu32*)(GAS unsigned*)(ws + WS_CTL) + CW_MOE)
#define D_ME WSP(int2, WS_ME)
#define D_MP WSP(int2, WS_MP)
#define D_MW WSP(float2, WS_MW)
#define PS_LOAD int ps[9]; ps[0] = 0; _Pragma("unroll") for (int e_ = 0; e_ < 8; ++e_) { const int n_ = (int)__builtin_amdgcn_readfirstlane(__hip_atomic_load(D_CNT + 64 * e_, RLX_AGENT)); ps[e_ + 1] = ps[e_] + ((n_ + 255) >> 8); }
    {
        PH_BEGIN
        LAS float* const st = (LAS float*)(LDSP + RING_OFF + 69632);
        for (int i = tid; i < 5 * DM; i += NWAVES * 64) { const float x = i < 4 * DM ? INP(I_C)[i] : INP(I_CCTX)[i - 4 * DM]; st[i] = x / (1.f + __expf(-x)); }
        __syncthreads();
        constexpr int N_MOD = 2 * 384, N_ROPE = 16, N_LAM = 1, N_WIN = 16 * (INW / 32), N_PRJ = 16 * 32, N_W1 = 16 * (DFF / 32), N_W2 = (DFF / 64) * 32;
        constexpr int NITEMS = N_MOD + N_ROPE + N_LAM + 2 * N_WIN + 6 * N_PRJ + 2 * N_W1 + N_W2;
        for (int it = gw; it < NITEMS; it += NGW) {
            int r = it;
            if (r < N_MOD) {
                const int l = r / 384, cb = r - l * 384, cl = lane & 15, kg = lane >> 4, col = 16 * cb + cl;
                const float* w = INP(I_ADAW) + (size_t)l * DM * 6144 + col; float a0 = 0.f, a1 = 0.f, a2 = 0.f, a3 = 0.f, a4 = 0.f;
#pragma unroll 8
                for (int k = kg; k < DM; k += 4) { const float wv = w[(size_t)k * 6144]; a0 += st[k] * wv; a1 += st[DM + k] * wv; a2 += st[2 * DM + k] * wv; a3 += st[3 * DM + k] * wv; a4 += st[4 * DM + k] * wv; }
                a0 += __shfl_xor(a0, 16); a0 += __shfl_xor(a0, 32); a1 += __shfl_xor(a1, 16); a1 += __shfl_xor(a1, 32); a2 += __shfl_xor(a2, 16); a2 += __shfl_xor(a2, 32);
                a3 += __shfl_xor(a3, 16); a3 += __shfl_xor(a3, 32); a4 += __shfl_xor(a4, 16); a4 += __shfl_xor(a4, 32);
                if (kg == 0) { const float bb = INP(I_ADAB)[l * 6144 + col]; float* m = D_MOD + (size_t)l * 5 * 6144 + col;
                    m[0] = a0 + bb; m[6144] = a1 + bb; m[2 * 6144] = a2 + bb; m[3 * 6144] = a3 + bb; m[4 * 6144] = a4 + bb; }
                continue; }
            r -= N_MOD;
            if (r < N_ROPE) { const int idx = r * 64 + lane, pos = idx >> 4, f = idx & 15; const float invf = powf(10000.f, -(float)f / 16.f), ang = (float)pos * invf;
                D_TAB[2 * idx] = cosf(ang); D_TAB[2 * idx + 1] = sinf(ang); continue; }
            r -= N_ROPE;
            if (r < N_LAM) {
                for (int l = 0; l < 2; ++l) { const float* dl = INP(I_DLAM) + l * 256; const float s1 = wave_sum(dl[lane] * dl[64 + lane]), s2 = wave_sum(dl[128 + lane] * dl[192 + lane]);
                    if (lane == 0) D_LAM[l] = expf(s1) - expf(s2) + (0.8f - 0.6f * expf(-0.3f * (float)l)); }
                continue; }
            r -= N_LAM;
            if (r < 2 * N_WIN) { const int l = r / N_WIN; transpose_item(INP(I_WIN) + (size_t)l * DM * INW, DM, INW, (bf16*)(ws + WS_WIN) + (size_t)l * INW * DM, 1, D_SCR, r - l * N_WIN, lane); continue; }
            r -= 2 * N_WIN;
            if (r < 6 * N_PRJ) { const int j = r / N_PRJ, l = j / 3, w = j - 3 * l;
                const float* src = (w == 0 ? INP(I_WPD) : w == 1 ? INP(I_WPG) : INP(I_WO)) + (size_t)l * DM * DM;
                transpose_item(src, DM, DM, (bf16*)(ws + WS_WPRJ) + (size_t)j * DM * DM, 0, D_SCR, r - j * N_PRJ, lane); continue; }
            r -= 6 * N_PRJ;
            if (r < N_W1) { transpose_item(INP(I_FW1), DM, DFF, (bf16*)(ws + WS_W13), 2, D_SCR, r, lane); continue; }
            r -= N_W1;
            if (r < N_W1) { transpose_item(INP(I_FW3), DM, DFF, (bf16*)(ws + WS_W13), 3, D_SCR, r, lane); continue; }
            r -= N_W1;
            transpose_item(INP(I_FW2), DFF, DM, (bf16*)(ws + WS_W2F), 0, D_SCR, r, lane);
        }
    }
    GRID_BAR();

    for (int l = 0; l < 2; ++l) {
        {
            PH_BEGIN
            const float* xl = l == 0 ? INP(I_X) : D_X; const float* xc = l == 0 ? INP(I_CTX) : D_XC; f32x4 hv[4];
            for (int e = gw; e < MEXT; e += NGW) { const int b = e / EXT, s = e - b * EXT; const bool lat = s < SEQ;
                const float* xrow = lat ? xl + (size_t)(b * SEQ + s) * DM : xc + (size_t)(b * CTXL + s - SEQ) * DM; const float* mv = D_MODL + (lat ? b : 4) * 6144;
                norm_mod_row(xrow, INP(I_NAG) + l * DM, mv, mv + DM, D_H + (size_t)e * DM, lane, hv); }
        }
        GRID_BAR();
for (int rep_ = 0; rep_ < REP_GEMM; ++rep_) {
        {
            PH_BEGIN
            pg8::Gemm g{(const pg8::bf16_t*)D_H, (const pg8::bf16_t*)(ws + WS_WIN) + (size_t)l * INW * DM, DM, DM, 0};
            pg8::RectOrder S; if (l == 0) S.init(NPAN, INW / 256, G, bx, 0, 0, 0); else S.init(64, INW / 256, G, bx, 1, 8, 10);
            pg8::EpiInProj E{(pg8::bf16_t*)D_P, INP(I_QNG) + l * 64, INP(I_KNG) + l * 64, D_TAB, attn_body::C2};
            pg8::gemm_phase<pg8::EpiInProj, pg8::RectOrder, true, true>(LDSP + RING_OFF, g, S, E);
        }
        GRID_BAR();
        }
for (int rep_ = 0; rep_ < REP_ATT; ++rep_) {
        {
            PH_BEGIN
            const int nun = l == 0 ? 2048 + 128 : 2048;
            for (int i = 0;; ++i) {
                const int Lu = i * G + vcu; if (Lu >= nun) break;
                int b, k, qb; bool diff;
                if (Lu < 2048) { const int pr = Lu >> 4, rnd = pr >> 4, idx = (rnd >> 1) * 16 + (pr & 15); qb = Lu & 15; diff = (rnd & 1) == 0; b = idx >> 4; k = idx & 15; }
                else { const int x = Lu - 2048; b = x >> 5; const int kk = x & 31; diff = kk < 16; k = kk & 15; qb = 16; }
                const size_t qrow = (size_t)b * EXT + qb * 256, krow = (size_t)b * EXT + (qb < 16 ? 0 : SEQ); const int NT = qb < 16 ? EXT / 64 : CTXL / 64;
                const attn_body::bf16* Pq = (const attn_body::bf16*)D_P + qrow * INW; const attn_body::bf16* Pk = (const attn_body::bf16*)D_P + krow * INW; attn_body::bf16* Oq = (attn_body::bf16*)D_OA + qrow * OAW;
                if (diff) { const int h = k >> 1, c = k & 1;
                    attn_body::attn_unit_dv<8>(Pq + PC_QD + h * 128 + c * 64, INW, Pk + PC_KD + h * 128 + c * 64, INW, Pk + PC_VD + h * 128, INW, Oq + c * 1024 + h * 128, OAW, NT, (char*)lds + RING_OFF); }
                else { const int gk = k >> 2;
                    attn_body::attn_unit<8>(Pq + PC_QG + k * 64, INW, Pk + PC_KG + gk * 64, INW, Pk + PC_VG + gk * 64, INW, Oq + 2048 + k * 64, OAW, NT, (char*)lds + RING_OFF); }
            }
        }
        GRID_BAR();
        }
        {
            PH_BEGIN
            const float lam = D_LAM[l], li = 1.f - (0.8f - 0.6f * expf(-0.3f * (float)l)); const float* sg = INP(I_SUBG) + l * 128 + 16 * (lane & 7);
            f32x4 g4[4];
#pragma unroll
            for (int j = 0; j < 4; ++j) g4[j] = ((const GAS f32x4*)sg)[j];
            for (int e = gw; e < MEXT; e += NGW) { bf16* row = D_OA + (size_t)e * OAW + 16 * lane;
                const v4u ra0 = *(const GAS v4u*)row, ra1 = *(const GAS v4u*)(row + 8), rc0 = *(const GAS v4u*)(row + 1024), rc1 = *(const GAS v4u*)(row + 1032);
                f32x4 a[4], c[4]; pg8::unpack8(ra0, a[0], a[1]); pg8::unpack8(ra1, a[2], a[3]); pg8::unpack8(rc0, c[0], c[1]); pg8::unpack8(rc1, c[2], c[3]);
                float ss = 0.f;
#pragma unroll
                for (int j = 0; j < 4; ++j) { a[j] = a[j] - c[j] * lam; ss += (a[j].x * a[j].x + a[j].y * a[j].y) + (a[j].z * a[j].z + a[j].w * a[j].w); }
                ss += __shfl_xor(ss, 1); ss += __shfl_xor(ss, 2); ss += __shfl_xor(ss, 4);
                const float rs = li / sqrtf(ss * (1.f / 128.f) + EPS);
#pragma unroll
                for (int j = 0; j < 4; ++j) a[j] = a[j] * rs * g4[j];
                *(GAS v4u*)row = pg8::pack8(a[0], a[1]); *(GAS v4u*)(row + 8) = pg8::pack8(a[2], a[3]); }
        }
        GRID_BAR();
        {
            PH_BEGIN
            pg8::Gemm g{(const pg8::bf16_t*)D_OA, (const pg8::bf16_t*)(ws + WS_WPRJ) + (size_t)(l * 3 + 0) * DM * DM, DM, OAW, 0};
            pg8::RectOrder S; if (l == 0) S.init(NPAN, 4, G, bx, 0, 0, 0); else S.init(64, 4, G, bx, 1, 0, 0);
            pg8::EpiGate E{(pg8::bf16_t*)D_MX, (const pg8::bf16_t*)D_P + PC_G1, 0};
            pg8::gemm_phase<pg8::EpiGate, pg8::RectOrder, true, true>(LDSP + RING_OFF, g, S, E);
        }
        GRID_BAR();
        {
            PH_BEGIN
            pg8::Gemm g{(const pg8::bf16_t*)D_OA + 2048, (const pg8::bf16_t*)(ws + WS_WPRJ) + (size_t)(l * 3 + 1) * DM * DM, DM, OAW, 0};
            pg8::RectOrder S; if (l == 0) S.init(NPAN, 4, G, bx, 0, 0, 0); else S.init(64, 4, G, bx, 1, 0, 0);
            pg8::EpiGate E{(pg8::bf16_t*)D_MX, (const pg8::bf16_t*)D_P + PC_G2, 1};
            pg8::gemm_phase<pg8::EpiGate, pg8::RectOrder, true, true>(LDSP + RING_OFF, g, S, E);
        }
        GRID_BAR();
        {
            PH_BEGIN
            pg8::Gemm g{(const pg8::bf16_t*)D_MX, (const pg8::bf16_t*)(ws + WS_WPRJ) + (size_t)(l * 3 + 2) * DM * DM, DM, DM, 0};
            pg8::RectOrder S; if (l == 0) S.init(NPAN, 4, G, bx, 0, 0, 0); else S.init(64, 4, G, bx, 1, 0, 0);
            pg8::EpiResid E{l == 0 ? INP(I_X) : D_X, l == 0 ? INP(I_CTX) : D_XC, D_X, D_XC, D_MODL + 2 * DM};
            pg8::gemm_phase<pg8::EpiResid, pg8::RectOrder, true, true>(LDSP + RING_OFF, g, S, E);
        }
        GRID_BAR();
        if (l == 0) {
            { PH_BEGIN
              f32x4 hv[4];
              for (int e = gw; e < MEXT; e += NGW) { const int b = e / EXT, s = e - b * EXT; const bool lat = s < SEQ;
                  const float* xrow = lat ? D_X + (size_t)(b * SEQ + s) * DM : D_XC + (size_t)(b * CTXL + s - SEQ) * DM; const float* mv = D_MODL + (lat ? b : 4) * 6144;
                  norm_mod_row(xrow, INP(I_NFG) + l * DM, mv + 3 * DM, mv + 4 * DM, D_H + (size_t)e * DM, lane, hv); } }
            GRID_BAR();
for (int rep_ = 0; rep_ < REP_GEMM; ++rep_) {
            {
                PH_BEGIN
                pg8::Gemm g{(const pg8::bf16_t*)D_H, (const pg8::bf16_t*)(ws + WS_W13), DM, DM, 0};
                pg8::RectOrder S; S.init(NPAN, 2 * DFF / 256, G, bx, 0, 0, 0);
                pg8::EpiSwiGLU E{(pg8::bf16_t*)(ws + WS_U), DFF};
                pg8::gemm_phase<pg8::EpiSwiGLU, pg8::RectOrder, true, true>(LDSP + RING_OFF, g, S, E);
            }
            GRID_BAR();
        }
            {
                PH_BEGIN
                pg8::Gemm g{(const pg8::bf16_t*)(ws + WS_U), (const pg8::bf16_t*)(ws + WS_W2F), DFF, DFF, 0};
                pg8::RectOrder S; S.init(NPAN, 4, G, bx, 0, 0, 0);
                pg8::EpiResid E{D_X, D_XC, D_X, D_XC, D_MODL + 5 * DM};
                pg8::gemm_phase<pg8::EpiResid, pg8::RectOrder, true, true>(LDSP + RING_OFF, g, S, E);
            }
            GRID_BAR();
        } else {
            { PH_BEGIN
              f32x4 hv[4]; const float* router = INP(I_ROUTER);
              for (int t = gw; t < MLAT; t += NGW) { const int b = t / SEQ; const float* mv = D_MODL + b * 6144;
                  norm_mod_row(D_X + (size_t)t * DM, INP(I_NFG) + l * DM, mv + 3 * DM, mv + 4 * DM, D_H + (size_t)t * DM, lane, hv);
                  float lg[8];
#pragma unroll
                  for (int e = 0; e < 8; ++e) lg[e] = 0.f;
#pragma unroll
                  for (int j = 0; j < 4; ++j)
#pragma unroll
                      for (int i = 0; i < 4; ++i) { const GAS f32x4* rp = (const GAS f32x4*)(router + (size_t)(4 * lane + 256 * j + i) * 8); const f32x4 r0 = rp[0], r1 = rp[1]; const float hx = hv[j][i];
                          lg[0] += hx * r0.x; lg[1] += hx * r0.y; lg[2] += hx * r0.z; lg[3] += hx * r0.w; lg[4] += hx * r1.x; lg[5] += hx * r1.y; lg[6] += hx * r1.z; lg[7] += hx * r1.w; }
#pragma unroll
                  for (int e = 0; e < 8; ++e) lg[e] = wave_sum(lg[e]);
                  int i0 = 0; float v0 = lg[0];
#pragma unroll
                  for (int e = 1; e < 8; ++e) if (lg[e] > v0) { v0 = lg[e]; i0 = e; }
                  int i1 = -1; float v1 = -INFINITY;
#pragma unroll
                  for (int e = 0; e < 8; ++e) if (e != i0 && lg[e] > v1) { v1 = lg[e]; i1 = e; }
                  if (lane == 0) { const float w0 = 1.f / (1.f + expf(v1 - v0));
                      const int p0 = (int)__hip_atomic_fetch_add(D_CNT + 64 * i0, 1u, RLX_AGENT), p1 = (int)__hip_atomic_fetch_add(D_CNT + 64 * i1, 1u, RLX_AGENT);
                      D_ME[t] = make_int2(i0, i1); D_MP[t] = make_int2(p0, p1); D_MW[t] = make_float2(w0, 1.f - w0); } } }
            {
                PH_BEGIN
                constexpr int N_E1 = 16 * (DFE / 32), N_E2 = (DFE / 64) * 32;
                for (int it = gw; it < NEXP * (2 * N_E1 + N_E2); it += NGW) { const int e = it / (2 * N_E1 + N_E2); int r = it - e * (2 * N_E1 + N_E2);
                    if (r < N_E1) { transpose_item(INP(I_MW1) + (size_t)e * DM * DFE, DM, DFE, (bf16*)(ws + WS_MW13) + (size_t)e * 2 * DFE * DM, 2, D_SCR, r, lane); continue; }
                    r -= N_E1;
                    if (r < N_E1) { transpose_item(INP(I_MW3) + (size_t)e * DM * DFE, DM, DFE, (bf16*)(ws + WS_MW13) + (size_t)e * 2 * DFE * DM, 3, D_SCR, r, lane); continue; }
                    r -= N_E1;
                    transpose_item(INP(I_MW2) + (size_t)e * DFE * DM, DFE, DM, (bf16*)(ws + WS_MW2) + (size_t)e * DM * DFE, 0, D_SCR, r, lane); }
            }
            GRID_BAR();
            {
                PH_BEGIN
                PS_LOAD
                bf16* const HS = (bf16*)(ws + WS_HS);
                for (int it = gw; it < 2 * MLAT; it += NGW) { const int t = it >> 1, k = it & 1; const int2 ee = D_ME[t], pp = D_MP[t]; const int e = k ? ee.y : ee.x, p = k ? pp.y : pp.x;
                    int pe = 0;
#pragma unroll
                    for (int q = 1; q < 8; ++q) pe = (e == q) ? ps[q] : pe;
                    const GAS v4u* src = (const GAS v4u*)(D_H + (size_t)t * DM); GAS v4u* dst = (GAS v4u*)(HS + ((size_t)pe * 256 + p) * DM);
                    dst[lane] = src[lane]; dst[lane + 64] = src[lane + 64]; }
            }
            GRID_BAR();
for (int rep_ = 0; rep_ < REP_GEMM; ++rep_) {
            {
                PH_BEGIN
                PS_LOAD
                pg8::Gemm g{(const pg8::bf16_t*)(ws + WS_HS), (const pg8::bf16_t*)(ws + WS_MW13), DM, DM, (size_t)2 * DFE * DM * 2};
                pg8::MoeOrder S{ps[8], 2 * DFE / 256, ps[8] * (2 * DFE / 256), G, bx, ps[1], ps[2], ps[3], ps[4], ps[5], ps[6], ps[7]};
                pg8::EpiSwiGLU E{(pg8::bf16_t*)(ws + WS_U2), DFE};
                pg8::gemm_phase<pg8::EpiSwiGLU, pg8::MoeOrder, true, true>(LDSP + RING_OFF, g, S, E);
            }
            GRID_BAR();
        }
for (int rep_ = 0; rep_ < REP_GEMM; ++rep_) {
            {
                PH_BEGIN
                PS_LOAD
                pg8::Gemm g{(const pg8::bf16_t*)(ws + WS_U2), (const pg8::bf16_t*)(ws + WS_MW2), DFE, DFE, (size_t)DM * DFE * 2};
                pg8::MoeOrder S{ps[8], 4, ps[8] * 4, G, bx, ps[1], ps[2], ps[3], ps[4], ps[5], ps[6], ps[7]};
                pg8::EpiPlain E{(pg8::bf16_t*)(ws + WS_HS), DM};
                pg8::gemm_phase<pg8::EpiPlain, pg8::MoeOrder, true, true>(LDSP + RING_OFF, g, S, E);
            }
            GRID_BAR();
        }
            {
                PH_BEGIN
                PS_LOAD
                const bf16* const Y = (const bf16*)(ws + WS_HS); const float* fg = INP(I_FNG);
                for (int t = gw; t < MLAT; t += NGW) { const int b = t / SEQ; const int2 ee = D_ME[t], pp = D_MP[t]; const float2 ww = D_MW[t];
                    int pe0 = 0, pe1 = 0;
#pragma unroll
                    for (int q = 1; q < 8; ++q) { pe0 = (ee.x == q) ? ps[q] : pe0; pe1 = (ee.y == q) ? ps[q] : pe1; }
                    const GAS unsigned long long* y0 = (const GAS unsigned long long*)(Y + ((size_t)pe0 * 256 + pp.x) * DM) + lane; const GAS unsigned long long* y1 = (const GAS unsigned long long*)(Y + ((size_t)pe1 * 256 + pp.y) * DM) + lane;
                    GAS f32x4* xr = (GAS f32x4*)(D_X + (size_t)t * DM) + lane; const GAS f32x4* gt = (const GAS f32x4*)(D_MODL + b * 6144 + 5 * DM) + lane;
                    f32x4 v[4]; float ss = 0.f;
#pragma unroll
                    for (int j = 0; j < 4; ++j) { const unsigned long long a = y0[64 * j], c = y1[64 * j]; const unsigned a0 = (unsigned)a, a1 = (unsigned)(a >> 32), c0 = (unsigned)c, c1 = (unsigned)(c >> 32);
                        const f32x4 ya = {__builtin_bit_cast(float, a0 << 16), __builtin_bit_cast(float, a0 & 0xffff0000u), __builtin_bit_cast(float, a1 << 16), __builtin_bit_cast(float, a1 & 0xffff0000u)};
                        const f32x4 yc = {__builtin_bit_cast(float, c0 << 16), __builtin_bit_cast(float, c0 & 0xffff0000u), __builtin_bit_cast(float, c1 << 16), __builtin_bit_cast(float, c1 & 0xffff0000u)};
                        v[j] = xr[64 * j] + gt[64 * j] * (ya * ww.x + yc * ww.y);
                        ss += (v[j].x * v[j].x + v[j].y * v[j].y) + (v[j].z * v[j].z + v[j].w * v[j].w); }
                    const float rs = 1.f / sqrtf(wave_sum(ss) * (1.f / DM) + EPS);
#pragma unroll
                    for (int j = 0; j < 4; ++j) xr[64 * j] = v[j] * rs * ((const GAS f32x4*)fg)[lane + 64 * j]; }
            }
        }
    }
#undef GRID_BAR
}

extern "C" void kernel_launch(void* const* d_in, const int* in_sizes, int n_in, void* d_out, int out_size, void* d_ws, size_t ws_size, hipStream_t stream) {
    static int grid = 0;
    if (grid == 0) {
        if (n_in != 24 || out_size != MLAT * DM || ws_size < WS_END) { fprintf(stderr, "kernel_launch: built for 24 inputs, %d outputs, >= %zu bytes of workspace; got n_in %d, out %d, ws %zu; nothing launched\n", MLAT * DM, (size_t)WS_END, n_in, out_size, ws_size); grid = -1; return; }
        int dev = 0, cus = 0, per_cu = 0;
        if (hipGetDevice(&dev) != hipSuccess || hipDeviceGetAttribute(&cus, hipDeviceAttributeMultiprocessorCount, dev) != hipSuccess) { fprintf(stderr, "kernel_launch: device query failed\n"); grid = -1; return; }
        if (hipFuncSetAttribute((const void*)fwd_kernel, hipFuncAttributeMaxDynamicSharedMemorySize, LDS_BYTES) != hipSuccess) { fprintf(stderr, "kernel_launch: hipFuncSetAttribute failed\n"); grid = -1; return; }
        if (hipOccupancyMaxActiveBlocksPerMultiprocessor(&per_cu, (const void*)fwd_kernel, NWAVES * 64, LDS_BYTES) != hipSuccess || per_cu < 1) { fprintf(stderr, "kernel_launch: occupancy query reports %d workgroups per CU\n", per_cu); }
        (void)hipGetLastError();
        grid = cus;
    }
    if (grid < 0) return;
    if (hipMemsetAsync((char*)d_ws + WS_CTL, 0, CTL_ZERO_BYTES, stream) != hipSuccess) { fprintf(stderr, "kernel_launch: hipMemsetAsync failed\n"); return; }
    Args a{};
    for (int i = 0; i < 24; ++i) a.in[i] = (const float*)d_in[i];
    a.out = (float*)d_out; a.ws = (unsigned char*)d_ws;
    hipLaunchKernelGGL(fwd_kernel, dim3(grid), dim3(NWAVES * 64), LDS_BYTES, stream, a);
    const hipError_t le = hipPeekAtLastError();
    if (le != hipSuccess) fprintf(stderr, "kernel_launch: launch failed: %s\n", hipGetErrorName(le));
}
```

```cpp
#include <hip/hip_runtime.h>
#include <hip/hip_bf16.h>
#include <cstdio>
#include <cstdint>
#include <cmath>

constexpr int DM = 1024, NB = 4, SEQ = 4096, CTXL = 256, EXT = SEQ + CTXL, MEXT = NB * EXT, MLAT = NB * SEQ, MCTX = NB * CTXL;
constexpr int PANB = EXT / 256  , NPAN = NB * PANB  ;
constexpr int INW = 6656;
constexpr int PC_QD = 0, PC_QG = 1024, PC_KD = 2048, PC_VD = 3072, PC_KG = 4096, PC_VG = 4352, PC_G1 = 4608, PC_G2 = 5632;
constexpr int OAW = 3072;
constexpr int DFF = 2816, NEXP = 8, DFE = 3584;
constexpr int MOE_ROWS = 2 * MLAT + NEXP * 256;
constexpr float EPS = 1e-6f;
constexpr int NHU = 48;
namespace pg8 {
#define PG8_LAS __attribute__((address_space(3)))
typedef unsigned short bf16_t;
typedef short bf16x8 __attribute__((ext_vector_type(8)));
typedef float f32x4 __attribute__((ext_vector_type(4)));
typedef unsigned u32x4 __attribute__((ext_vector_type(4)));
constexpr int BM = 256, BK = 64, HALF = 128, HTB = HALF * BK * 2  , STAGE_BYTES = 8 * HTB, NXCD = 8, WGM = 8;

__host__ __device__ __forceinline__ int lds_byte(int r, int c) { const int st = (r >> 4) * 2 + (c >> 5), rr = r & 15, cc = c & 31, ob = rr * 64 + cc * 2; return st * 1024 + (ob ^ (((ob >> 9) & 1) << 5)); }
__host__ __device__ __forceinline__ void stage_rc(int b, int& R, int& C) { const int st = b / 1024, sb = b % 1024, swz = sb ^ (((sb >> 9) & 1) << 5); R = (st >> 1) * 16 + swz / 64; C = (st & 1) * 32 + (swz % 64) / 2; }
__host__ __device__ __forceinline__ int perm32(int rho) { const int n = rho >> 4, i = rho & 15; return 8 * (i >> 2) + 4 * n + (i & 3); }

struct Unit { int pm, pn, e; };
struct Gemm { const bf16_t* A; const bf16_t* Bt; int K, lda; size_t bstride; };
__device__ __forceinline__ void rect_map(int wgid, int nM, int nN, int& pm, int& pn) {
    const int nwg = nM * nN; { const int q = nwg / NXCD, r = nwg % NXCD, xcd = wgid % NXCD, off = wgid / NXCD; wgid = (xcd < r ? xcd * (q + 1) : r * (q + 1) + (xcd - r) * q) + off; }
    const int nig = WGM * nN, gid = wgid / nig, fm = gid * WGM, gsz = (nM - fm) < WGM ? (nM - fm) : WGM;
    pm = fm + ((wgid % nig) % gsz); pn = (wgid % nig) / gsz;
}
struct RectOrder {
    int nMq, nN, nrect, G, c, latmode, exlo, exn, nextra;
    __device__ __forceinline__ void init(int nMq_, int nN_, int G_, int c_, int latmode_, int exlo_, int exn_) { nMq = nMq_; nN = nN_; nrect = nMq_ * nN_; G = G_; c = c_; latmode = latmode_; exlo = exlo_; exn = exn_; nextra = 4 * exn_; }
    __device__ __forceinline__ bool next(int i, Unit& u) const {
        int L = i * G + c; u.e = 0;
        if (L < nrect) { int q, pn; rect_map(L, nMq, nN, q, pn); u.pm = latmode ? (q >> 4) * 17 + (q & 15) : q; u.pn = pn; return true; }
        L -= nrect; if (L >= nextra) return false;
        const int b = L / exn; u.pm = b * 17 + 16; u.pn = exlo + (L - b * exn); return true;
    }
    __device__ __forceinline__ void a_ready(const Unit&) const {}
    __device__ __forceinline__ void done(const Unit&) const {}
};
struct MoeOrder {
    int P, nN, nwg, G, c, p1, p2, p3, p4, p5, p6, p7;
    __device__ __forceinline__ bool next(int i, Unit& u) const {
        const int L = i * G + c; if (L >= nwg) return false;
        int pm, pn; rect_map(L, P, nN, pm, pn); u.pm = pm; u.pn = pn;
        u.e = (pm >= p1) + (pm >= p2) + (pm >= p3) + (pm >= p4) + (pm >= p5) + (pm >= p6) + (pm >= p7); return true;
    }
    __device__ __forceinline__ void a_ready(const Unit&) const {}
    __device__ __forceinline__ void done(const Unit&) const {}
};

__device__ __forceinline__ unsigned cvt_pk_bf16(float lo, float hi) { unsigned r; asm volatile("v_cvt_pk_bf16_f32 %0, %1, %2" : "=v"(r) : "v"(lo), "v"(hi)); return r; }
__device__ __forceinline__ u32x4 pack8(const f32x4& a, const f32x4& b) { u32x4 w; w.x = cvt_pk_bf16(a[0], a[1]); w.y = cvt_pk_bf16(a[2], a[3]); w.z = cvt_pk_bf16(b[0], b[1]); w.w = cvt_pk_bf16(b[2], b[3]); return w; }
__device__ __forceinline__ void unpack8(const u32x4& w, f32x4& a, f32x4& b) {
    a[0] = __builtin_bit_cast(float, w.x << 16); a[1] = __builtin_bit_cast(float, w.x & 0xffff0000u); a[2] = __builtin_bit_cast(float, w.y << 16); a[3] = __builtin_bit_cast(float, w.y & 0xffff0000u);
    b[0] = __builtin_bit_cast(float, w.z << 16); b[1] = __builtin_bit_cast(float, w.z & 0xffff0000u); b[2] = __builtin_bit_cast(float, w.w << 16); b[3] = __builtin_bit_cast(float, w.w & 0xffff0000u); }
__device__ __forceinline__ float sigmoidf_(float v) { return __builtin_amdgcn_rcpf(1.f + __expf(-v)); }

struct EpiInProj {
    static constexpr bool PERM = true, AFTER_DRAIN = false;
    bf16_t* P; const float* qg; const float* kg; const float* tab; float c2;
    __device__ __forceinline__ void operator()(const f32x4 (&acc)[2][2][4][2], const Unit& u, int wr, int wc, int fr, int fq) const {
        asm volatile("" : "+v"(fr), "+v"(fq));
        const int pn = u.pn, seg = u.pm % 17; const bool lat = seg < 16;
        bf16_t* base = P + (size_t)(u.pm * 256 + wr * 64 + fr) * INW + 256 * pn + 64 * wc + 8 * fq;
        if (pn >= 18) {
#pragma unroll
            for (int ai = 0; ai < 2; ++ai)
#pragma unroll
                for (int m = 0; m < 4; ++m)
#pragma unroll
                    for (int bj = 0; bj < 2; ++bj) { f32x4 v0 = acc[ai][bj][m][0], v1 = acc[ai][bj][m][1];
#pragma unroll
                        for (int e = 0; e < 4; ++e) { v0[e] = sigmoidf_(v0[e]); v1[e] = sigmoidf_(v1[e]); }
                        *(u32x4*)(base + (size_t)(ai * 128 + m * 16) * INW + 32 * bj) = pack8(v0, v1); }
            return;
        }
        const bool donorm = (pn >= 4 && pn < 8) || pn == 16, dorope = lat && (pn < 12 || pn == 16);
        const float osc = pn < 8 ? c2 : 1.f;
        f32x4 gv[2][2];
#pragma unroll
        for (int bj = 0; bj < 2; ++bj)
#pragma unroll
            for (int n = 0; n < 2; ++n) gv[bj][n] = donorm ? *(const f32x4*)((pn == 16 ? kg : qg) + 32 * bj + 8 * fq + 4 * n) : (f32x4){1.f, 1.f, 1.f, 1.f};
        f32x4 tr[2][2], tc[4][2];
#pragma unroll
        for (int n = 0; n < 2; ++n) {
#pragma unroll
            for (int ai = 0; ai < 2; ++ai) tr[ai][n] = dorope ? *(const f32x4*)(tab + ((4 * seg + 2 * ai + wr) * 16 + 4 * fq + 2 * n) * 2) : (f32x4){1.f, 0.f, 1.f, 0.f};
#pragma unroll
            for (int m = 0; m < 4; ++m) tc[m][n] = dorope ? *(const f32x4*)(tab + ((16 * m + fr) * 16 + 4 * fq + 2 * n) * 2) : (f32x4){1.f, 0.f, 1.f, 0.f};
        }
#pragma unroll
        for (int ai = 0; ai < 2; ++ai)
#pragma unroll
            for (int m = 0; m < 4; ++m) {
                f32x4 v[2][2];
#pragma unroll
                for (int bj = 0; bj < 2; ++bj)
#pragma unroll
                    for (int n = 0; n < 2; ++n) v[bj][n] = acc[ai][bj][m][n];
                if (donorm) {
                    float ss = 0.f;
#pragma unroll
                    for (int bj = 0; bj < 2; ++bj)
#pragma unroll
                        for (int n = 0; n < 2; ++n) ss += (v[bj][n][0] * v[bj][n][0] + v[bj][n][1] * v[bj][n][1]) + (v[bj][n][2] * v[bj][n][2] + v[bj][n][3] * v[bj][n][3]);
                    ss += __shfl_xor(ss, 16); ss += __shfl_xor(ss, 32);
                    const float rs = 1.f / sqrtf(ss * (1.f / 64.f) + EPS);
#pragma unroll
                    for (int bj = 0; bj < 2; ++bj)
#pragma unroll
                        for (int n = 0; n < 2; ++n) v[bj][n] = v[bj][n] * rs * gv[bj][n];
                }
#pragma unroll
                for (int bj = 0; bj < 2; ++bj) {
#pragma unroll
                    for (int n = 0; n < 2; ++n) { const f32x4 t = bj == 0 ? tr[ai][n] : tc[m][n]; const f32x4 x = v[bj][n];
                        v[bj][n] = (f32x4){(x[0] * t[0] - x[1] * t[1]) * osc, (x[0] * t[1] + x[1] * t[0]) * osc, (x[2] * t[2] - x[3] * t[3]) * osc, (x[2] * t[3] + x[3] * t[2]) * osc}; }
                    *(u32x4*)(base + (size_t)(ai * 128 + m * 16) * INW + 32 * bj) = pack8(v[bj][0], v[bj][1]);
                }
            }
    }
};
struct EpiGate {
    static constexpr bool PERM = true, AFTER_DRAIN = false;
    bf16_t* Mx; const bf16_t* G; int accum;
    __device__ __forceinline__ void operator()(const f32x4 (&acc)[2][2][4][2], const Unit& u, int wr, int wc, int fr, int fq) const {
        asm volatile("" : "+v"(fr), "+v"(fq));
        const int row0 = u.pm * 256 + wr * 64 + fr, col0 = u.pn * 256 + wc * 32 + 8 * fq;
#pragma unroll
        for (int ai = 0; ai < 2; ++ai)
#pragma unroll
            for (int m = 0; m < 4; ++m) { const size_t row = (size_t)(row0 + ai * 128 + m * 16);
#pragma unroll
                for (int bj = 0; bj < 2; ++bj) { const int col = col0 + 128 * bj;
                    f32x4 g0, g1; unpack8(*(const u32x4*)(G + row * INW + col), g0, g1);
                    f32x4 v0 = acc[ai][bj][m][0] * g0, v1 = acc[ai][bj][m][1] * g1;
                    if (accum) { f32x4 o0, o1; unpack8(*(const u32x4*)(Mx + row * DM + col), o0, o1); v0 = v0 + o0; v1 = v1 + o1; }
                    *(u32x4*)(Mx + row * DM + col) = pack8(v0, v1); } }
    }
};
struct EpiResid {
    static constexpr bool PERM = true, AFTER_DRAIN = false;
    const float* XoL; const float* XoC; float* XnL; float* XnC; const float* mod;
    __device__ __forceinline__ void operator()(const f32x4 (&acc)[2][2][4][2], const Unit& u, int wr, int wc, int fr, int fq) const {
        asm volatile("" : "+v"(fr), "+v"(fq));
        const int b = u.pm / 17, seg = u.pm - b * 17; const bool lat = seg < 16;
        const size_t rb = (lat ? (size_t)(b * SEQ + seg * 256) : (size_t)(b * CTXL)) + wr * 64 + fr;
        const float* xo = lat ? XoL : XoC; float* xn = lat ? XnL : XnC;
        const int col0 = u.pn * 256 + wc * 32 + 8 * fq; const float* gp = mod + (lat ? b : 4) * 6144 + col0;
        f32x4 gt[2][2];
#pragma unroll
        for (int bj = 0; bj < 2; ++bj)
#pragma unroll
            for (int n = 0; n < 2; ++n) gt[bj][n] = *(const f32x4*)(gp + 128 * bj + 4 * n);
#pragma unroll
        for (int ai = 0; ai < 2; ++ai)
#pragma unroll
            for (int m = 0; m < 4; ++m) { const size_t ro = (rb + ai * 128 + m * 16) * DM + col0;
#pragma unroll
                for (int bj = 0; bj < 2; ++bj)
#pragma unroll
                    for (int n = 0; n < 2; ++n) { const f32x4 o = *(const f32x4*)(xo + ro + 128 * bj + 4 * n); *(f32x4*)(xn + ro + 128 * bj + 4 * n) = o + gt[bj][n] * acc[ai][bj][m][n]; } }
    }
};
struct EpiSwiGLU {
    static constexpr bool PERM = true, AFTER_DRAIN = false;
    bf16_t* U; int ldu;
    __device__ __forceinline__ void operator()(const f32x4 (&acc)[2][2][4][2], const Unit& u, int wr, int wc, int fr, int fq) const {
        asm volatile("" : "+v"(fr), "+v"(fq));
        bf16_t* base = U + (size_t)(u.pm * 256 + wr * 64 + fr) * ldu + u.pn * 128 + wc * 32 + 8 * fq;
#pragma unroll
        for (int ai = 0; ai < 2; ++ai)
#pragma unroll
            for (int m = 0; m < 4; ++m) { f32x4 r[2];
#pragma unroll
                for (int n = 0; n < 2; ++n) { const f32x4 a = acc[ai][0][m][n], b = acc[ai][1][m][n];
#pragma unroll
                    for (int e = 0; e < 4; ++e) r[n][e] = a[e] * sigmoidf_(a[e]) * b[e]; }
                *(u32x4*)(base + (size_t)(ai * 128 + m * 16) * ldu) = pack8(r[0], r[1]); }
    }
};
struct EpiPlain {
    static constexpr bool PERM = true, AFTER_DRAIN = false;
    bf16_t* Y; int ldy;
    __device__ __forceinline__ void operator()(const f32x4 (&acc)[2][2][4][2], const Unit& u, int wr, int wc, int fr, int fq) const {
        asm volatile("" : "+v"(fr), "+v"(fq));
        bf16_t* base = Y + (size_t)(u.pm * 256 + wr * 64 + fr) * ldy + u.pn * 256 + wc * 32 + 8 * fq;
#pragma unroll
        for (int ai = 0; ai < 2; ++ai)
#pragma unroll
            for (int m = 0; m < 4; ++m)
#pragma unroll
                for (int bj = 0; bj < 2; ++bj) *(u32x4*)(base + (size_t)(ai * 128 + m * 16) * ldy + 128 * bj) = pack8(acc[ai][bj][m][0], acc[ai][bj][m][1]);
    }
};

template <class Epi, class Sched, bool ALIGN_EPI = false, bool SP2 = false>
__device__ __forceinline__ void gemm_phase(PG8_LAS unsigned char* lds, const Gemm g, const Sched& S, const Epi& E) {
    int tid_ = threadIdx.x; asm volatile("" : "+v"(tid_));
    const int tid = tid_, wid = __builtin_amdgcn_readfirstlane(tid >> 6), lane = tid & 63, wr = wid >> 2, wc = wid & 3, fr = lane & 15, fq = lane >> 4;
    const int K = g.K, nt = K / BK, lda = g.lda;
    unsigned voffA[2], voffB[2];
#pragma unroll
    for (int i = 0; i < 2; ++i) { int R, C; stage_rc(tid * 16 + i * 8192, R, C); const int Rb = Epi::PERM ? ((R & ~31) + perm32(R & 31)) : R;
        voffA[i] = (unsigned)(R * lda + C) * 2u; voffB[i] = (unsigned)(Rb * K + C) * 2u; }
    const size_t kstep = (size_t)(BK * 2);
    const size_t hstepA = (size_t)HALF * lda * 2, hstepB = (size_t)HALF * K * 2;
    const size_t tstepA = 2 * hstepA, tstepB = 2 * hstepB;
    const unsigned ldsw = (unsigned)wid * 1024u;
    const int aoff = lds_byte(wr * 64 + fr, fq * 8), boff = lds_byte(wc * 32 + fr, fq * 8);
#define PG8_SA(b, h) (((b) * 2 + (h)) * HTB)
#define PG8_SB(b, h) ((4 + (b) * 2 + (h)) * HTB)
#define PG8_STAGE(bufoff, gbase, voff) do { _Pragma("unroll") for (int _i = 0; _i < 2; ++_i) \
        __builtin_amdgcn_global_load_lds((const unsigned*)((const char*)(gbase) + (voff)[_i]), (PG8_LAS unsigned*)(lds + (bufoff) + ldsw + _i * 8192), 16, 0, 0); } while (0)
#define PG8_LDA(dst, b, h) do { _Pragma("unroll") for (int m = 0; m < 4; ++m) _Pragma("unroll") for (int k = 0; k < 2; ++k) dst[m][k] = *(const PG8_LAS bf16x8*)(lds + PG8_SA(b, h) + aoff + m * 2048 + k * 1024); } while (0)
#define PG8_LDB(dst, b, h) do { _Pragma("unroll") for (int n = 0; n < 2; ++n) _Pragma("unroll") for (int k = 0; k < 2; ++k) dst[n][k] = *(const PG8_LAS bf16x8*)(lds + PG8_SB(b, h) + boff + n * 2048 + k * 1024); } while (0)
#define PG8_MMA(ai, bj, At, Bt) do { __builtin_amdgcn_s_setprio(1); _Pragma("unroll") for (int m = 0; m < 4; ++m) _Pragma("unroll") for (int n = 0; n < 2; ++n) _Pragma("unroll") for (int k = 0; k < 2; ++k) \
        acc[ai][bj][m][n] = __builtin_amdgcn_mfma_f32_16x16x32_bf16(Bt[n][k], At[m][k], acc[ai][bj][m][n], 0, 0, 0); __builtin_amdgcn_s_setprio(0); } while (0)
#define PG8_WAIT_V(n) asm volatile("s_waitcnt vmcnt(" #n ")" ::: "memory")
#define PG8_WAIT_L(n) asm volatile("s_waitcnt lgkmcnt(" #n ")" ::: "memory")
#define PG8_BAR __builtin_amdgcn_s_barrier()
#define PG8_SCHED __builtin_amdgcn_sched_barrier(0)
    Unit cur, nxt; int ui = 0;
    if (!S.next(0, cur)) return;
    f32x4 acc[2][2][4][2];
#pragma unroll
    for (int a = 0; a < 2; ++a)
#pragma unroll
        for (int b = 0; b < 2; ++b)
#pragma unroll
            for (int m = 0; m < 4; ++m)
#pragma unroll
                for (int n = 0; n < 2; ++n) acc[a][b][m][n] = (f32x4){0.f, 0.f, 0.f, 0.f};
    bf16x8 At[4][2], B0[2][2], B1[2][2];
    const char* cA = (const char*)g.A + (size_t)cur.pm * tstepA; const char* cB = (const char*)g.Bt + (size_t)cur.e * g.bstride + (size_t)cur.pn * tstepB;
    S.a_ready(cur);
    if constexpr (SP2) {
        PG8_STAGE(PG8_SB(0, 0), cB, voffB); PG8_STAGE(PG8_SB(0, 1), cB + hstepB, voffB); PG8_STAGE(PG8_SA(0, 0), cA, voffA); PG8_STAGE(PG8_SA(0, 1), cA + hstepA, voffA);
        if (wr == 1) PG8_BAR;
        PG8_WAIT_V(2); PG8_BAR;
        PG8_STAGE(PG8_SB(1, 0), cB + kstep, voffB); PG8_STAGE(PG8_SA(1, 0), cA + kstep, voffA); PG8_STAGE(PG8_SB(1, 1), cB + hstepB + kstep, voffB);
        PG8_WAIT_V(6); PG8_BAR;
    } else {
        PG8_STAGE(PG8_SB(0, 0), cB, voffB); PG8_STAGE(PG8_SA(0, 0), cA, voffA); PG8_STAGE(PG8_SB(0, 1), cB + hstepB, voffB); PG8_STAGE(PG8_SA(0, 1), cA + hstepA, voffA);
        if (wr == 1) PG8_BAR;
        PG8_WAIT_V(4); PG8_BAR;
        PG8_STAGE(PG8_SB(1, 0), cB + kstep, voffB); PG8_STAGE(PG8_SA(1, 0), cA + kstep, voffA); PG8_STAGE(PG8_SB(1, 1), cB + hstepB + kstep, voffB);
        PG8_WAIT_V(6); PG8_BAR;
    }
    for (;;) {
        const bool has_next = S.next(ui + 1, nxt);
        const char* nA = has_next ? (const char*)g.A + (size_t)nxt.pm * tstepA : cA; const char* nB = has_next ? (const char*)g.Bt + (size_t)nxt.e * g.bstride + (size_t)nxt.pn * tstepB : cB;
        for (int t = 0; t < nt; t += 2) {
            const bool last = (t == nt - 2);
            const char* a1 = cA + (size_t)(t + 1) * kstep;
            const char* a2 = last ? nA : cA + (size_t)(t + 2) * kstep; const char* b2 = last ? nB : cB + (size_t)(t + 2) * kstep;
            const char* a3 = a2 + kstep; const char* b3 = b2 + kstep;
            if (last && has_next) S.a_ready(nxt);
            if constexpr (SP2) {
            PG8_LDB(B0, 0, 0); PG8_LDB(B1, 0, 1); PG8_SCHED; PG8_LDA(At, 0, 0); PG8_STAGE(PG8_SA(1, 1), a1 + hstepA, voffA);
            PG8_WAIT_V(8); PG8_WAIT_L(0); PG8_BAR; PG8_MMA(0, 0, At, B0); PG8_MMA(0, 1, At, B1); PG8_BAR; PG8_SCHED;
            PG8_LDA(At, 0, 1); PG8_STAGE(PG8_SB(0, 0), b2, voffB); PG8_STAGE(PG8_SB(0, 1), b2 + hstepB, voffB); PG8_STAGE(PG8_SA(0, 0), a2, voffA);
            PG8_WAIT_V(8); PG8_WAIT_L(0); PG8_BAR; PG8_MMA(1, 0, At, B0); PG8_MMA(1, 1, At, B1); PG8_BAR; PG8_SCHED;
            PG8_LDB(B0, 1, 0); PG8_LDB(B1, 1, 1); PG8_SCHED; PG8_LDA(At, 1, 0); PG8_STAGE(PG8_SA(0, 1), a2 + hstepA, voffA);
            PG8_WAIT_V(8); PG8_WAIT_L(0); PG8_BAR; PG8_MMA(0, 0, At, B0); PG8_MMA(0, 1, At, B1); PG8_BAR; PG8_SCHED;
            PG8_LDA(At, 1, 1); PG8_STAGE(PG8_SB(1, 0), b3, voffB); PG8_STAGE(PG8_SB(1, 1), b3 + hstepB, voffB); PG8_STAGE(PG8_SA(1, 0), a3, voffA);
            PG8_WAIT_V(8); PG8_WAIT_L(0); PG8_BAR; PG8_MMA(1, 0, At, B0); PG8_MMA(1, 1, At, B1); PG8_BAR; PG8_SCHED;
            } else {
            PG8_LDB(B0, 0, 0); PG8_SCHED; PG8_LDA(At, 0, 0); PG8_STAGE(PG8_SA(1, 1), a1 + hstepA, voffA);
            PG8_WAIT_L(8); PG8_BAR; PG8_WAIT_L(0); PG8_MMA(0, 0, At, B0); PG8_BAR; PG8_SCHED;
            PG8_LDB(B1, 0, 1); PG8_STAGE(PG8_SB(0, 0), b2, voffB);
            PG8_BAR; PG8_WAIT_L(0); PG8_MMA(0, 1, At, B1); PG8_BAR;
            PG8_LDA(At, 0, 1); PG8_STAGE(PG8_SA(0, 0), a2, voffA);
            PG8_BAR; PG8_WAIT_L(0); PG8_MMA(1, 0, At, B0); PG8_BAR; PG8_SCHED;
            PG8_STAGE(PG8_SB(0, 1), b2 + hstepB, voffB);
            PG8_WAIT_V(6); PG8_BAR; PG8_MMA(1, 1, At, B1); PG8_BAR;
            PG8_LDB(B0, 1, 0); PG8_SCHED; PG8_LDA(At, 1, 0); PG8_STAGE(PG8_SA(0, 1), a2 + hstepA, voffA);
            PG8_WAIT_L(8); PG8_BAR; PG8_WAIT_L(0); PG8_MMA(0, 0, At, B0); PG8_BAR; PG8_SCHED;
            PG8_LDB(B1, 1, 1); PG8_STAGE(PG8_SB(1, 0), b3, voffB);
            PG8_BAR; PG8_WAIT_L(0); PG8_MMA(0, 1, At, B1); PG8_BAR;
            PG8_LDA(At, 1, 1); PG8_STAGE(PG8_SA(1, 0), a3, voffA);
            PG8_BAR; PG8_WAIT_L(0); PG8_MMA(1, 0, At, B0); PG8_BAR; PG8_SCHED;
            PG8_STAGE(PG8_SB(1, 1), b3 + hstepB, voffB);
            PG8_WAIT_V(6); PG8_BAR; PG8_MMA(1, 1, At, B1); PG8_BAR;
            }
        }
        if constexpr (ALIGN_EPI) { if (wr == 0) PG8_BAR; }
        if constexpr (!Epi::AFTER_DRAIN) { E(acc, cur, wr, wc, fr, fq); S.done(cur); }
        if (!has_next) break;
#pragma unroll
        for (int a = 0; a < 2; ++a)
#pragma unroll
            for (int b = 0; b < 2; ++b)
#pragma unroll
                for (int m = 0; m < 4; ++m)
#pragma unroll
                    for (int n = 0; n < 2; ++n) acc[a][b][m][n] = (f32x4){0.f, 0.f, 0.f, 0.f};
        cur = nxt; cA = nA; cB = nB; ++ui;
        if constexpr (ALIGN_EPI) { if (wr == 1) PG8_BAR; }
    }
    PG8_WAIT_V(0);
    if constexpr (!ALIGN_EPI) { if (wr == 0) PG8_BAR; }
    PG8_BAR;
    if constexpr (Epi::AFTER_DRAIN) { E.fused(acc, cur, wr, wc, fr, fq, lds, wid, lane); S.done(cur); }
#undef PG8_SA
#undef PG8_SB
#undef PG8_STAGE
#undef PG8_LDA
#undef PG8_LDB
#undef PG8_MMA
#undef PG8_WAIT_V
#undef PG8_WAIT_L
#undef PG8_BAR
#undef PG8_SCHED
}
}

#include <hip/hip_bf16.h>
#include <cmath>
namespace attn_body {
using bf16=__hip_bfloat16;
using bf16x8=__attribute__((ext_vector_type(8)))short;
using s16x4=__attribute__((ext_vector_type(4)))short;
using f32x16=__attribute__((ext_vector_type(16)))float;
using u32x4=__attribute__((ext_vector_type(4)))unsigned;
constexpr int D=64;
constexpr int NW=8,QBLK=32,QB=QBLK*NW,KVBLK=64;
__device__ __forceinline__ int crow(int r,int hi){return (r&3)+8*(r>>2)+4*hi;}
#define SBAR() __builtin_amdgcn_sched_barrier(0)
constexpr int NSLOT=3, SLOTB=8192;
constexpr int LDS_K=0, LDS_V=NSLOT*SLOTB, LDS_WS=2*NSLOT*SLOTB, LDS_OST=LDS_WS+NW*64*4, LDS_BYTES=LDS_OST+NW*4096;
constexpr int VSLOTB=16384, LDS_V2=NSLOT*SLOTB, LDS_WS2=LDS_V2+NSLOT*VSLOTB, LDS_OST2=LDS_WS2+NW*64*4, LDS_BYTES2=LDS_OST2+NW*4096;
constexpr float C2=0.125f*1.4426950408889634f;
__device__ __forceinline__ void glds16(const void*gsrc,unsigned lds_dst){unsigned keep;
  asm volatile("s_mov_b32 %0, m0\n\ts_mov_b32 m0, %2\n\ts_nop 0\n\tglobal_load_lds_dwordx4 %1, off\n\ts_mov_b32 m0, %0":"=&s"(keep):"v"(gsrc),"s"(lds_dst):"memory");}
__device__ __forceinline__ float max3f(float a,float b,float c){float r;asm("v_max3_f32 %0, %1, %2, %3":"=v"(r):"v"(a),"v"(b),"v"(c));return r;}
__device__ __forceinline__ float max2f(float a,float b){float r;asm("v_max_f32_e32 %0, %1, %2":"=v"(r):"v"(a),"v"(b));return r;}
__device__ __forceinline__ float fadd_s(float a,float b){float r;asm("v_add_f32_e32 %0, %1, %2":"=v"(r):"v"(a),"v"(b));return r;}
__device__ __forceinline__ float fsub_s(float a,float b){float r;asm("v_sub_f32_e32 %0, %1, %2":"=v"(r):"v"(a),"v"(b));return r;}
typedef float f32x2_t __attribute__((ext_vector_type(2))); typedef __bf16 bf16x2_t __attribute__((ext_vector_type(2)));
__device__ __forceinline__ unsigned cvtpk_s(float lo,float hi){f32x2_t v={lo,hi};bf16x2_t b=__builtin_convertvector(v,bf16x2_t);return __builtin_bit_cast(unsigned,b);}
#define WAIT_BAR(N) asm volatile("s_waitcnt vmcnt(" #N ") lgkmcnt(0)\n\ts_barrier":::"memory")

__device__ __forceinline__ void qkt(f32x16&p0,f32x16&p1,const char*Kslot,const bf16x8*qr,const f32x16&negm,int r32,int hi){
  const char*kb=Kslot+hi*1024+r32*16;
  #pragma unroll
  for(int d0=0;d0<4;++d0){
    const bf16x8 b0=*reinterpret_cast<const bf16x8*>(kb+d0*2048);
    const bf16x8 b1=*reinterpret_cast<const bf16x8*>(kb+d0*2048+512);
    if(d0==0){p0=__builtin_amdgcn_mfma_f32_32x32x16_bf16(b0,qr[0],negm,0,0,0);p1=__builtin_amdgcn_mfma_f32_32x32x16_bf16(b1,qr[0],negm,0,0,0);}
    else{p0=__builtin_amdgcn_mfma_f32_32x32x16_bf16(b0,qr[d0],p0,0,0,0);p1=__builtin_amdgcn_mfma_f32_32x32x16_bf16(b1,qr[d0],p1,0,0,0);}}
}
typedef __attribute__((address_space(3))) const char* lds_cptr;
typedef short v4i16_t __attribute__((ext_vector_type(4)));
__device__ __forceinline__ void kload8(bf16x8*kf,lds_cptr kp){
  kf[0]=*(const __attribute__((address_space(3))) bf16x8*)(kp);      kf[1]=*(const __attribute__((address_space(3))) bf16x8*)(kp+512);
  kf[2]=*(const __attribute__((address_space(3))) bf16x8*)(kp+2048); kf[3]=*(const __attribute__((address_space(3))) bf16x8*)(kp+2560);
  kf[4]=*(const __attribute__((address_space(3))) bf16x8*)(kp+4096); kf[5]=*(const __attribute__((address_space(3))) bf16x8*)(kp+4608);
  kf[6]=*(const __attribute__((address_space(3))) bf16x8*)(kp+6144); kf[7]=*(const __attribute__((address_space(3))) bf16x8*)(kp+6656);
}
__device__ __forceinline__ void kload2(bf16x8*kf,lds_cptr kp,int j){ kf[2*j]=*(const __attribute__((address_space(3))) bf16x8*)(kp+j*2048); kf[2*j+1]=*(const __attribute__((address_space(3))) bf16x8*)(kp+j*2048+512); }
__device__ __forceinline__ s16x4 vtr(lds_cptr p){ return __builtin_bit_cast(s16x4,__builtin_amdgcn_ds_read_tr16_b64_v4i16((__attribute__((address_space(3))) v4i16_t*)p)); }
__device__ __forceinline__ float rowmax(const f32x16&p0,const f32x16&p1){
  float a=max3f(p0[0],p0[1],p1[0]),b=max3f(p0[2],p0[3],p1[1]);a=max3f(a,p1[2],p1[3]);
  #pragma unroll
  for(int r=4;r<16;r+=4){a=max3f(a,p0[r],p0[r+1]);b=max3f(b,p0[r+2],p0[r+3]);a=max3f(a,p1[r],p1[r+1]);b=max3f(b,p1[r+2],p1[r+3]);}
  const float m=max2f(a,b);
  auto rr=__builtin_amdgcn_permlane32_swap(__float_as_uint(m),__float_as_uint(m),false,false);
  return max2f(__uint_as_float(rr[0]),__uint_as_float(rr[1]));
}
__device__ __forceinline__ void pv(f32x16*o,int vb,bf16x8 pa0,bf16x8 pa1,bf16x8 pa2,bf16x8 pa3){
  #pragma unroll
  for(int d0=0;d0<2;++d0){s16x4 lo[4],hi[4];
    #pragma unroll
    for(int ks=0;ks<4;++ks){
      asm volatile("ds_read_b64_tr_b16 %0,%1 offset:%c2":"=&v"(lo[ks]):"v"(vb),"i"(d0*4096+ks*1024):"memory");
      asm volatile("ds_read_b64_tr_b16 %0,%1 offset:%c2":"=&v"(hi[ks]):"v"(vb),"i"(d0*4096+ks*1024+512):"memory");}
    asm volatile("s_waitcnt lgkmcnt(0)":::"memory");SBAR();
    #define PK(k) (bf16x8){lo[k][0],lo[k][1],lo[k][2],lo[k][3],hi[k][0],hi[k][1],hi[k][2],hi[k][3]}
    o[d0]=__builtin_amdgcn_mfma_f32_32x32x16_bf16(pa0,PK(0),o[d0],0,0,0);
    o[d0]=__builtin_amdgcn_mfma_f32_32x32x16_bf16(pa1,PK(1),o[d0],0,0,0);
    o[d0]=__builtin_amdgcn_mfma_f32_32x32x16_bf16(pa2,PK(2),o[d0],0,0,0);
    o[d0]=__builtin_amdgcn_mfma_f32_32x32x16_bf16(pa3,PK(3),o[d0],0,0,0);
    #undef PK
  }
}

__device__ __forceinline__ void pv4(f32x16*o,int vb,bf16x8 pa0,bf16x8 pa1,bf16x8 pa2,bf16x8 pa3){
  #pragma unroll
  for(int d0=0;d0<4;++d0){s16x4 lo[4],hi[4];
    #pragma unroll
    for(int ks=0;ks<4;++ks){
      asm volatile("ds_read_b64_tr_b16 %0,%1 offset:%c2":"=&v"(lo[ks]):"v"(vb),"i"(d0*4096+ks*1024):"memory");
      asm volatile("ds_read_b64_tr_b16 %0,%1 offset:%c2":"=&v"(hi[ks]):"v"(vb),"i"(d0*4096+ks*1024+512):"memory");}
    asm volatile("s_waitcnt lgkmcnt(0)":::"memory");SBAR();
    #define PK(k) (bf16x8){lo[k][0],lo[k][1],lo[k][2],lo[k][3],hi[k][0],hi[k][1],hi[k][2],hi[k][3]}
    o[d0]=__builtin_amdgcn_mfma_f32_32x32x16_bf16(pa0,PK(0),o[d0],0,0,0);
    o[d0]=__builtin_amdgcn_mfma_f32_32x32x16_bf16(pa1,PK(1),o[d0],0,0,0);
    o[d0]=__builtin_amdgcn_mfma_f32_32x32x16_bf16(pa2,PK(2),o[d0],0,0,0);
    o[d0]=__builtin_amdgcn_mfma_f32_32x32x16_bf16(pa3,PK(3),o[d0],0,0,0);
    #undef PK
  }
}

#ifndef ATTN_STORE16
#define ATTN_STORE16(p,v) (*(u32x4*)(p)=(v))
#endif
template<int THRL> __device__ __forceinline__ void attn_unit(const bf16*Q0,int qp,const bf16*__restrict__ K0,int kp,const bf16*__restrict__ V0,int vp,bf16*O0,int op,const int NT,char*shm){
  int tid_=threadIdx.x; asm volatile("":"+v"(tid_)); const int tid=tid_,lane=tid&63,r32=lane&31,hi=lane>>5; const int wid=__builtin_amdgcn_readfirstlane(tid>>6);
  const bf16*Qw=Q0+(long)(wid*QBLK)*qp;
  const bf16*Kh=K0,*Vh=V0;
  const unsigned lds0=(unsigned)(uintptr_t)shm;
  float*wsf=(float*)(shm+LDS_WS)+wid*64;
  const bf16*ksrc=Kh+(long)lane*kp+wid*8;
  const bf16*vsrc=Vh+(long)(16*(wid&3)+(lane>>2))*vp+(wid>>2)*32+(lane&3)*8;
  const unsigned kdst=lds0+LDS_K+wid*1024, vdst=lds0+LDS_V+wid*1024;
  #define DMA_K(t,slot) glds16(ksrc+(long)(t)*KVBLK*kp,(unsigned)__builtin_amdgcn_readfirstlane(kdst+(slot)))
  #define DMA_V(t,slot) glds16(vsrc+(long)(t)*KVBLK*vp,(unsigned)__builtin_amdgcn_readfirstlane(vdst+(slot)))
  const int vb0=(int)(lds0+LDS_V)+((lane>>4)&1)*32+(lane&3)*8+(4*hi+((lane&15)>>2))*64;
  const char*Kbase=shm+LDS_K; bf16x8 kf[8];
  const lds_cptr shm3=(lds_cptr)shm; const lds_cptr kp0=shm3+LDS_K+hi*1024+r32*16; const lds_cptr vp0=shm3+LDS_V+((lane>>4)&1)*32+(lane&3)*8+(4*hi+((lane&15)>>2))*64;
  DMA_K(0,0);DMA_V(0,0);DMA_K(1,SLOTB);
  bf16x8 qr[4];
  #pragma unroll
  for(int d0=0;d0<4;++d0)qr[d0]=*reinterpret_cast<const bf16x8*>(&Qw[(long)r32*qp+d0*16+hi*8]);
  float mhat=0.f,l_reg=0.f;f32x16 o[2];o[0]=f32x16{};o[1]=f32x16{};f32x16 negm=f32x16{};asm volatile("":"+v"(negm));
  #define CMASK(P0,P1,t) do{}while(0)
  bool resc=false;
  #define START(P0,P1) do{ const float rm=rowmax(P0,P1); resc=false; \
    { const float dl=rm; mhat=fadd_s(mhat,dl); \
      _Pragma("unroll") for(int r=0;r<16;++r){P0[r]=fsub_s(P0[r],dl);P1[r]=fsub_s(P1[r],dl);} \
      _Pragma("unroll") for(int r=0;r<16;++r)negm[r]=-mhat; asm volatile("":"+v"(negm)); } \
    _Pragma("unroll") for(int r=0;r<16;++r)P0[r]=__builtin_amdgcn_exp2f(P0[r]); }while(0)
  #define RESC() do{ if(resc){ asm volatile("s_waitcnt lgkmcnt(0)":::"memory"); \
      _Pragma("unroll") for(int d_=0;d_<2;++d_) _Pragma("unroll") for(int r=0;r<16;++r)o[d_][r]*=wsf[crow(r,hi)]; } }while(0)
  f32x16 pA0,pA1,pB0,pB1;
  int sl_prev=0,sl_cur=0,sl_next=SLOTB;
  #define ROT() do{sl_prev=sl_cur;sl_cur=sl_next;sl_next=(sl_next==(NSLOT-1)*SLOTB)?0:sl_next+SLOTB;}while(0)
  DMA_K(2,2*SLOTB);
  WAIT_BAR(3);
  qkt(pA0,pA1,Kbase,qr,negm,r32,hi);asm volatile("s_nop 15\n\ts_nop 7":"+v"(pA0),"+v"(pA1));CMASK(pA0,pA1,0);
  START(pA0,pA1);
  _Pragma("unroll") for(int r=0;r<16;++r)pA1[r]=__builtin_amdgcn_exp2f(pA1[r]);
  WAIT_BAR(0);
  DMA_K(3,0);DMA_V(1,SLOTB);
  ROT();
  kload8(kf,kp0+sl_cur);
  WAIT_BAR(2);
  s16x4 vlo[8],vhi[8]; u32x4 pw0,pw1,pw2,pw3;
  #define PKW(P,B) cvtpk_s(P[B],P[B+1])
  #define PAF(k) __builtin_bit_cast(bf16x8,pw##k)
  #define VFR(i) (bf16x8){vlo[i][0],vlo[i][1],vlo[i][2],vlo[i][3],vhi[i][0],vhi[i][1],vhi[i][2],vhi[i][3]}
  #define PIN(x) asm volatile("":"+v"(x))
  #define MX3(a,b,c) __builtin_fmaxf(__builtin_fmaxf((a),(b)),(c))
  #define GAPA(MF,A0,A1,A2,A3,W0,W1,PW) do{ MF; sacc+=A0; sacc+=A1; sacc+=A2; sacc+=A3; PIN(sacc); W0; W1; PIN(PW); SBAR(); }while(0)
  #define EX(v) __builtin_amdgcn_exp2f(v)
  #define GAPB(MF,X,B) do{ MF; X[B]=EX(X[B]); X[B+1]=EX(X[B+1]); X[B+2]=EX(X[B+2]); X[B+3]=EX(X[B+3]); PIN(X); SBAR(); }while(0)
  #define VRD(i) do{ vlo[i]=vtr(vp_+(((i)>>2)*4096+((i)&3)*1024)); vhi[i]=vtr(vp_+(((i)>>2)*4096+((i)&3)*1024+512)); }while(0)
  #define KRD(G,j) do{ if(G){ kload2(kf,kp0+sl_next,j); SBAR(); } }while(0)
  #define STEP(C0,C1,P0,P1,t,GK,GV,GL) do{ SBAR(); \
    const lds_cptr vp_=vp0+sl_prev; \
    VRD(0); SBAR(); float sacc=(P0[0]+P0[1]); \
    GAPA(C0=__builtin_amdgcn_mfma_f32_32x32x16_bf16(kf[0],qr[0],negm,0,0,0), P0[2],P0[3],P0[4],P0[5],     pw0[0]=PKW(P0,0), pw0[1]=PKW(P0,2), pw0); \
    VRD(4); SBAR(); GAPA(C1=__builtin_amdgcn_mfma_f32_32x32x16_bf16(kf[1],qr[0],negm,0,0,0), P0[6],P0[7],P0[8],P0[9],     pw0[2]=PKW(P0,4), pw0[3]=PKW(P0,6), pw0); \
    VRD(1); SBAR(); GAPA(C0=__builtin_amdgcn_mfma_f32_32x32x16_bf16(kf[2],qr[1],C0,0,0,0),   P0[10],P0[11],P0[12],P0[13], pw1[0]=PKW(P0,8), pw1[1]=PKW(P0,10), pw1); \
    VRD(5); SBAR(); GAPA(C1=__builtin_amdgcn_mfma_f32_32x32x16_bf16(kf[3],qr[1],C1,0,0,0),   P0[14],P0[15],P1[0],P1[1],   pw1[2]=PKW(P0,12),pw1[3]=PKW(P0,14), pw1); \
    VRD(2); SBAR(); GAPA(C0=__builtin_amdgcn_mfma_f32_32x32x16_bf16(kf[4],qr[2],C0,0,0,0),   P1[2],P1[3],P1[4],P1[5],     pw2[0]=PKW(P1,0), pw2[1]=PKW(P1,2), pw2); \
    VRD(6); SBAR(); GAPA(C1=__builtin_amdgcn_mfma_f32_32x32x16_bf16(kf[5],qr[2],C1,0,0,0),   P1[6],P1[7],P1[8],P1[9],     pw2[2]=PKW(P1,4), pw2[3]=PKW(P1,6), pw2); \
    VRD(3); SBAR(); GAPA(C0=__builtin_amdgcn_mfma_f32_32x32x16_bf16(kf[6],qr[3],C0,0,0,0),   P1[10],P1[11],P1[12],P1[13], pw3[0]=PKW(P1,8), pw3[1]=PKW(P1,10), pw3); \
    VRD(7); SBAR(); GAPA(C1=__builtin_amdgcn_mfma_f32_32x32x16_bf16(kf[7],qr[3],C1,0,0,0),   P1[14],P1[15],0.f,0.f,       pw3[2]=PKW(P1,12),pw3[3]=PKW(P1,14), pw3); \
    l_reg+=sacc; \
    if(GK){DMA_K((t)+3,sl_cur);} if(GV){DMA_V((t)+1,sl_next);} \
    CMASK(C0,C1,t); \
    { float a=MX3(C0[0],C0[1],C1[0]),b=MX3(C0[2],C0[3],C1[1]); a=MX3(a,C1[2],C1[3]); \
      _Pragma("unroll") for(int r=4;r<16;r+=4){a=MX3(a,C0[r],C0[r+1]);b=MX3(b,C0[r+2],C0[r+3]);a=MX3(a,C1[r],C1[r+1]);b=MX3(b,C1[r+2],C1[r+3]);} \
      float rm=__builtin_fmaxf(a,b); { auto rr=__builtin_amdgcn_permlane32_swap(__float_as_uint(rm),__float_as_uint(rm),false,false); rm=__builtin_fmaxf(__uint_as_float(rr[0]),__uint_as_float(rr[1])); } \
      resc=false; \
      if(__builtin_expect(__any(rm>(float)THRL),0)){ const float dl=__builtin_fmaxf(rm,0.f); mhat+=dl; \
        _Pragma("unroll") for(int r=0;r<16;++r){C0[r]-=dl;C1[r]-=dl;} \
        _Pragma("unroll") for(int r=0;r<16;++r)negm[r]=-mhat; asm volatile("":"+v"(negm)); \
        const float f=__builtin_amdgcn_exp2f(-dl); l_reg*=f; if(hi==0)wsf[r32]=f; resc=true; } } \
    SBAR(); \
    GAPB(o[0]=__builtin_amdgcn_mfma_f32_32x32x16_bf16(PAF(0),VFR(0),o[0],0,0,0), C0,0); \
    GAPB(o[1]=__builtin_amdgcn_mfma_f32_32x32x16_bf16(PAF(0),VFR(4),o[1],0,0,0), C0,4); \
    KRD(GL,0); GAPB(o[0]=__builtin_amdgcn_mfma_f32_32x32x16_bf16(PAF(1),VFR(1),o[0],0,0,0), C0,8); \
    KRD(GL,1); GAPB(o[1]=__builtin_amdgcn_mfma_f32_32x32x16_bf16(PAF(1),VFR(5),o[1],0,0,0), C0,12); \
    KRD(GL,2); GAPB(o[0]=__builtin_amdgcn_mfma_f32_32x32x16_bf16(PAF(2),VFR(2),o[0],0,0,0), C1,0); \
    KRD(GL,3); GAPB(o[1]=__builtin_amdgcn_mfma_f32_32x32x16_bf16(PAF(2),VFR(6),o[1],0,0,0), C1,4); \
    GAPB(o[0]=__builtin_amdgcn_mfma_f32_32x32x16_bf16(PAF(3),VFR(3),o[0],0,0,0), C1,8); \
    GAPB(o[1]=__builtin_amdgcn_mfma_f32_32x32x16_bf16(PAF(3),VFR(7),o[1],0,0,0), C1,12); \
    }while(0)
  int t=1;
  #undef CMASK
  #define CMASK(P0,P1,t) do{}while(0)
  for(;t+5<NT;t+=2){
    STEP(pB0,pB1,pA0,pA1,t,true,true,true);     WAIT_BAR(2); RESC(); ROT();
    STEP(pA0,pA1,pB0,pB1,t+1,true,true,true);   WAIT_BAR(2); RESC(); ROT();
  }
  #undef CMASK
  #define CMASK(P0,P1,t) do{}while(0)
  #define ENDW(tt) do{ if((tt)+3<NT){WAIT_BAR(2);} else if((tt)+2<NT){WAIT_BAR(1);} else {WAIT_BAR(0);} }while(0)
  for(;t+1<NT;t+=2){
    STEP(pB0,pB1,pA0,pA1,t,(t+3<NT),(t+1<NT),(t+1<NT));       ENDW(t);   RESC(); ROT();
    STEP(pA0,pA1,pB0,pB1,t+1,(t+4<NT),(t+2<NT),(t+2<NT));     ENDW(t+1); RESC(); ROT();
  }
  STEP(pB0,pB1,pA0,pA1,NT-1,false,false,false); RESC();
  { float sacc=pB0[0]+pB0[1]; _Pragma("unroll") for(int r=2;r<16;++r)sacc+=pB0[r]; _Pragma("unroll") for(int r=0;r<16;++r)sacc+=pB1[r]; l_reg+=sacc;
    pw0=(u32x4){PKW(pB0,0),PKW(pB0,2),PKW(pB0,4),PKW(pB0,6)};pw1=(u32x4){PKW(pB0,8),PKW(pB0,10),PKW(pB0,12),PKW(pB0,14)};pw2=(u32x4){PKW(pB1,0),PKW(pB1,2),PKW(pB1,4),PKW(pB1,6)};pw3=(u32x4){PKW(pB1,8),PKW(pB1,10),PKW(pB1,12),PKW(pB1,14)};
    SBAR(); pv(o,vb0+sl_cur,PAF(0),PAF(1),PAF(2),PAF(3)); }
  #undef PKW
  #undef PAF
  #undef VFR
  #undef PIN
  #undef MX3
  #undef GAPA
  #undef GAPB
  #undef EX
  #undef VRD
  #undef KRD
  #undef STEP
  #undef ENDW
  {auto rr=__builtin_amdgcn_permlane32_swap(__float_as_uint(l_reg),__float_as_uint(l_reg),false,false);l_reg=__uint_as_float(rr[0])+__uint_as_float(rr[1]);}
  if(hi==0)wsf[32+r32]=l_reg;asm volatile("s_waitcnt lgkmcnt(0)":::"memory");
  float rli[16];
  #pragma unroll
  for(int r=0;r<16;++r)rli[r]=__builtin_amdgcn_rcpf(wsf[32+crow(r,hi)]);
  bf16*Ow=O0+(long)(wid*QBLK)*op;
  { bf16*stg=(bf16*)(shm+LDS_OST)+wid*2048;
    #pragma unroll
    for(int r=0;r<16;++r){const int orow=crow(r,hi);
      #pragma unroll
      for(int d0=0;d0<2;++d0)stg[orow*64+d0*32+r32]=__float2bfloat16(o[d0][r]*rli[r]);}
    asm volatile("s_waitcnt lgkmcnt(0)":::"memory");
    #pragma unroll
    for(int i=0;i<4;++i){const int row=i*8+(lane>>3),ch=lane&7; const u32x4 v=*(const u32x4*)(stg+row*64+ch*8); ATTN_STORE16(Ow+(long)row*op+ch*8,v);} }
  asm volatile("s_waitcnt lgkmcnt(0)\n\ts_barrier":::"memory");
  #undef DMA_K
  #undef DMA_V
  #undef CMASK
  #undef START
  #undef RESC
  #undef ROT
}
template<int THRL> __device__ __forceinline__ void attn_unit_dv(const bf16*Q0,int qp,const bf16*__restrict__ K0,int kp,const bf16*__restrict__ V0,int vp,bf16*O0,int op,const int NT,char*shm){
  int tid_=threadIdx.x; asm volatile("":"+v"(tid_)); const int tid=tid_,lane=tid&63,r32=lane&31,hi=lane>>5; const int wid=__builtin_amdgcn_readfirstlane(tid>>6);
  const bf16*Qw=Q0+(long)(wid*QBLK)*qp;
  const bf16*Kh=K0,*Vh=V0;
  const unsigned lds0=(unsigned)(uintptr_t)shm;
  float*wsf=(float*)(shm+LDS_WS2)+wid*64;
  const bf16*ksrc=Kh+(long)lane*kp+wid*8;
  const bf16*vsrc=Vh+(long)(16*(wid&3)+(lane>>2))*vp+(wid>>2)*32+(lane&3)*8;
  const unsigned kdst=lds0+LDS_K+wid*1024, vdst=lds0+LDS_V2+wid*1024;
  #define DMA_K(t,slot) glds16(ksrc+(long)(t)*KVBLK*kp,(unsigned)__builtin_amdgcn_readfirstlane(kdst+(slot)))
  #define DMA_V(t,slot) do{ glds16(vsrc+(long)(t)*KVBLK*vp,(unsigned)__builtin_amdgcn_readfirstlane(vdst+2*(slot))); glds16(vsrc+(long)(t)*KVBLK*vp+64,(unsigned)__builtin_amdgcn_readfirstlane(vdst+2*(slot)+8192)); }while(0)
  const int vb0=(int)(lds0+LDS_V2)+((lane>>4)&1)*32+(lane&3)*8+(4*hi+((lane&15)>>2))*64;
  const char*Kbase=shm+LDS_K; bf16x8 kf[8];
  const lds_cptr shm3=(lds_cptr)shm; const lds_cptr kp0=shm3+LDS_K+hi*1024+r32*16; const lds_cptr vp0=shm3+LDS_V2+((lane>>4)&1)*32+(lane&3)*8+(4*hi+((lane&15)>>2))*64;
  DMA_K(0,0);DMA_V(0,0);DMA_K(1,SLOTB);
  bf16x8 qr[4];
  #pragma unroll
  for(int d0=0;d0<4;++d0)qr[d0]=*reinterpret_cast<const bf16x8*>(&Qw[(long)r32*qp+d0*16+hi*8]);
  float mhat=0.f,l_reg=0.f;f32x16 o[4];o[0]=f32x16{};o[1]=f32x16{};o[2]=f32x16{};o[3]=f32x16{};f32x16 negm=f32x16{};asm volatile("":"+v"(negm));
  #define CMASK(P0,P1,t) do{}while(0)
  bool resc=false;
  #define START(P0,P1) do{ const float rm=rowmax(P0,P1); resc=false; \
    { const float dl=rm; mhat=fadd_s(mhat,dl); \
      _Pragma("unroll") for(int r=0;r<16;++r){P0[r]=fsub_s(P0[r],dl);P1[r]=fsub_s(P1[r],dl);} \
      _Pragma("unroll") for(int r=0;r<16;++r)negm[r]=-mhat; asm volatile("":"+v"(negm)); } \
    _Pragma("unroll") for(int r=0;r<16;++r)P0[r]=__builtin_amdgcn_exp2f(P0[r]); }while(0)
  #define RESC() do{ if(resc){ asm volatile("s_waitcnt lgkmcnt(0)":::"memory"); \
      _Pragma("unroll") for(int d_=0;d_<4;++d_) _Pragma("unroll") for(int r=0;r<16;++r)o[d_][r]*=wsf[crow(r,hi)]; } }while(0)
  f32x16 pA0,pA1,pB0,pB1;
  int sl_prev=0,sl_cur=0,sl_next=SLOTB;
  #define ROT() do{sl_prev=sl_cur;sl_cur=sl_next;sl_next=(sl_next==(NSLOT-1)*SLOTB)?0:sl_next+SLOTB;}while(0)
  DMA_K(2,2*SLOTB);
  WAIT_BAR(4);
  qkt(pA0,pA1,Kbase,qr,negm,r32,hi);asm volatile("s_nop 15\n\ts_nop 7":"+v"(pA0),"+v"(pA1));CMASK(pA0,pA1,0);
  START(pA0,pA1);
  _Pragma("unroll") for(int r=0;r<16;++r)pA1[r]=__builtin_amdgcn_exp2f(pA1[r]);
  WAIT_BAR(0);
  DMA_K(3,0);DMA_V(1,SLOTB);
  ROT();
  kload8(kf,kp0+sl_cur);
  WAIT_BAR(3);
  s16x4 vlo[16],vhi[16]; u32x4 pw0,pw1,pw2,pw3;
  #define PKW(P,B) cvtpk_s(P[B],P[B+1])
  #define PAF(k) __builtin_bit_cast(bf16x8,pw##k)
  #define VFR(i) (bf16x8){vlo[i][0],vlo[i][1],vlo[i][2],vlo[i][3],vhi[i][0],vhi[i][1],vhi[i][2],vhi[i][3]}
  #define PIN(x) asm volatile("":"+v"(x))
  #define MX3(a,b,c) __builtin_fmaxf(__builtin_fmaxf((a),(b)),(c))
  #define GAPA(MF,A0,A1,A2,A3,W0,W1,PW) do{ MF; sacc+=A0; sacc+=A1; sacc+=A2; sacc+=A3; PIN(sacc); W0; W1; PIN(PW); SBAR(); }while(0)
  #define EX(v) __builtin_amdgcn_exp2f(v)
  #define GAPB(MF,X,B) do{ MF; X[B]=EX(X[B]); X[B+1]=EX(X[B+1]); PIN(X); SBAR(); }while(0)
  #define VRD(i) do{ vlo[i]=vtr(vp_+(((i)>>2)*4096+((i)&3)*1024)); vhi[i]=vtr(vp_+(((i)>>2)*4096+((i)&3)*1024+512)); }while(0)
  #define KRD(G,j) do{ if(G){ kload2(kf,kp0+sl_next,j); SBAR(); } }while(0)
  #define STEP(C0,C1,P0,P1,t,GK,GV,GL) do{ SBAR(); \
    const lds_cptr vp_=vp0+2*sl_prev; \
    float sacc=(P0[0]+P0[1]); \
    GAPA(C0=__builtin_amdgcn_mfma_f32_32x32x16_bf16(kf[0],qr[0],negm,0,0,0), P0[2],P0[3],P0[4],P0[5],     pw0[0]=PKW(P0,0), pw0[1]=PKW(P0,2), pw0); \
    GAPA(C1=__builtin_amdgcn_mfma_f32_32x32x16_bf16(kf[1],qr[0],negm,0,0,0), P0[6],P0[7],P0[8],P0[9],     pw0[2]=PKW(P0,4), pw0[3]=PKW(P0,6), pw0); \
    GAPA(C0=__builtin_amdgcn_mfma_f32_32x32x16_bf16(kf[2],qr[1],C0,0,0,0),   P0[10],P0[11],P0[12],P0[13], pw1[0]=PKW(P0,8), pw1[1]=PKW(P0,10), pw1); \
    GAPA(C1=__builtin_amdgcn_mfma_f32_32x32x16_bf16(kf[3],qr[1],C1,0,0,0),   P0[14],P0[15],P1[0],P1[1],   pw1[2]=PKW(P0,12),pw1[3]=PKW(P0,14), pw1); \
    VRD(0); SBAR(); GAPA(C0=__builtin_amdgcn_mfma_f32_32x32x16_bf16(kf[4],qr[2],C0,0,0,0),   P1[2],P1[3],P1[4],P1[5],     pw2[0]=PKW(P1,0), pw2[1]=PKW(P1,2), pw2); \
    VRD(4); SBAR(); GAPA(C1=__builtin_amdgcn_mfma_f32_32x32x16_bf16(kf[5],qr[2],C1,0,0,0),   P1[6],P1[7],P1[8],P1[9],     pw2[2]=PKW(P1,4), pw2[3]=PKW(P1,6), pw2); \
    VRD(1); SBAR(); GAPA(C0=__builtin_amdgcn_mfma_f32_32x32x16_bf16(kf[6],qr[3],C0,0,0,0),   P1[10],P1[11],P1[12],P1[13], pw3[0]=PKW(P1,8), pw3[1]=PKW(P1,10), pw3); \
    VRD(5); SBAR(); GAPA(C1=__builtin_amdgcn_mfma_f32_32x32x16_bf16(kf[7],qr[3],C1,0,0,0),   P1[14],P1[15],0.f,0.f,       pw3[2]=PKW(P1,12),pw3[3]=PKW(P1,14), pw3); \
    l_reg+=sacc; \
    if(GK){DMA_K((t)+3,sl_cur);} if(GV){DMA_V((t)+1,sl_next);} \
    CMASK(C0,C1,t); \
    { float a=MX3(C0[0],C0[1],C1[0]),b=MX3(C0[2],C0[3],C1[1]); a=MX3(a,C1[2],C1[3]); \
      _Pragma("unroll") for(int r=4;r<16;r+=4){a=MX3(a,C0[r],C0[r+1]);b=MX3(b,C0[r+2],C0[r+3]);a=MX3(a,C1[r],C1[r+1]);b=MX3(b,C1[r+2],C1[r+3]);} \
      float rm=__builtin_fmaxf(a,b); { auto rr=__builtin_amdgcn_permlane32_swap(__float_as_uint(rm),__float_as_uint(rm),false,false); rm=__builtin_fmaxf(__uint_as_float(rr[0]),__uint_as_float(rr[1])); } \
      resc=false; \
      if(__builtin_expect(__any(rm>(float)THRL),0)){ const float dl=__builtin_fmaxf(rm,0.f); mhat+=dl; \
        _Pragma("unroll") for(int r=0;r<16;++r){C0[r]-=dl;C1[r]-=dl;} \
        _Pragma("unroll") for(int r=0;r<16;++r)negm[r]=-mhat; asm volatile("":"+v"(negm)); \
        const float f=__builtin_amdgcn_exp2f(-dl); l_reg*=f; if(hi==0)wsf[r32]=f; resc=true; } } \
    SBAR(); \
    VRD(2); SBAR(); GAPB(o[0]=__builtin_amdgcn_mfma_f32_32x32x16_bf16(PAF(0),VFR(0),o[0],0,0,0), C0,0); \
    VRD(6); SBAR(); GAPB(o[1]=__builtin_amdgcn_mfma_f32_32x32x16_bf16(PAF(0),VFR(4),o[1],0,0,0), C0,2); \
    VRD(3); SBAR(); GAPB(o[0]=__builtin_amdgcn_mfma_f32_32x32x16_bf16(PAF(1),VFR(1),o[0],0,0,0), C0,4); \
    VRD(7); SBAR(); GAPB(o[1]=__builtin_amdgcn_mfma_f32_32x32x16_bf16(PAF(1),VFR(5),o[1],0,0,0), C0,6); \
    VRD(8); SBAR(); GAPB(o[0]=__builtin_amdgcn_mfma_f32_32x32x16_bf16(PAF(2),VFR(2),o[0],0,0,0), C0,8); \
    VRD(12); SBAR(); GAPB(o[1]=__builtin_amdgcn_mfma_f32_32x32x16_bf16(PAF(2),VFR(6),o[1],0,0,0), C0,10); \
    VRD(9); SBAR(); GAPB(o[0]=__builtin_amdgcn_mfma_f32_32x32x16_bf16(PAF(3),VFR(3),o[0],0,0,0), C0,12); \
    VRD(13); SBAR(); GAPB(o[1]=__builtin_amdgcn_mfma_f32_32x32x16_bf16(PAF(3),VFR(7),o[1],0,0,0), C0,14); \
    VRD(10); SBAR(); GAPB(o[2]=__builtin_amdgcn_mfma_f32_32x32x16_bf16(PAF(0),VFR(8),o[2],0,0,0), C1,0); \
    VRD(14); SBAR(); GAPB(o[3]=__builtin_amdgcn_mfma_f32_32x32x16_bf16(PAF(0),VFR(12),o[3],0,0,0), C1,2); \
    VRD(11); SBAR(); GAPB(o[2]=__builtin_amdgcn_mfma_f32_32x32x16_bf16(PAF(1),VFR(9),o[2],0,0,0), C1,4); \
    VRD(15); SBAR(); GAPB(o[3]=__builtin_amdgcn_mfma_f32_32x32x16_bf16(PAF(1),VFR(13),o[3],0,0,0), C1,6); \
    KRD(GL,0); GAPB(o[2]=__builtin_amdgcn_mfma_f32_32x32x16_bf16(PAF(2),VFR(10),o[2],0,0,0), C1,8); \
    KRD(GL,1); GAPB(o[3]=__builtin_amdgcn_mfma_f32_32x32x16_bf16(PAF(2),VFR(14),o[3],0,0,0), C1,10); \
    KRD(GL,2); GAPB(o[2]=__builtin_amdgcn_mfma_f32_32x32x16_bf16(PAF(3),VFR(11),o[2],0,0,0), C1,12); \
    KRD(GL,3); GAPB(o[3]=__builtin_amdgcn_mfma_f32_32x32x16_bf16(PAF(3),VFR(15),o[3],0,0,0), C1,14); \
    }while(0)
  int t=1;
  #undef CMASK
  #define CMASK(P0,P1,t) do{}while(0)
  for(;t+5<NT;t+=2){
    STEP(pB0,pB1,pA0,pA1,t,true,true,true);     WAIT_BAR(3); RESC(); ROT();
    STEP(pA0,pA1,pB0,pB1,t+1,true,true,true);   WAIT_BAR(3); RESC(); ROT();
  }
  #undef CMASK
  #define CMASK(P0,P1,t) do{}while(0)
  #define ENDW(tt) do{ if((tt)+3<NT){WAIT_BAR(3);} else if((tt)+2<NT){WAIT_BAR(2);} else {WAIT_BAR(0);} }while(0)
  for(;t+1<NT;t+=2){
    STEP(pB0,pB1,pA0,pA1,t,(t+3<NT),(t+1<NT),(t+1<NT));       ENDW(t);   RESC(); ROT();
    STEP(pA0,pA1,pB0,pB1,t+1,(t+4<NT),(t+2<NT),(t+2<NT));     ENDW(t+1); RESC(); ROT();
  }
  STEP(pB0,pB1,pA0,pA1,NT-1,false,false,false); RESC();
  { float sacc=pB0[0]+pB0[1]; _Pragma("unroll") for(int r=2;r<16;++r)sacc+=pB0[r]; _Pragma("unroll") for(int r=0;r<16;++r)sacc+=pB1[r]; l_reg+=sacc;
    pw0=(u32x4){PKW(pB0,0),PKW(pB0,2),PKW(pB0,4),PKW(pB0,6)};pw1=(u32x4){PKW(pB0,8),PKW(pB0,10),PKW(pB0,12),PKW(pB0,14)};pw2=(u32x4){PKW(pB1,0),PKW(pB1,2),PKW(pB1,4),PKW(pB1,6)};pw3=(u32x4){PKW(pB1,8),PKW(pB1,10),PKW(pB1,12),PKW(pB1,14)};
    SBAR(); pv4(o,vb0+2*sl_cur,PAF(0),PAF(1),PAF(2),PAF(3)); }
  #undef PKW
  #undef PAF
  #undef VFR
  #undef PIN
  #undef MX3
  #undef GAPA
  #undef GAPB
  #undef EX
  #undef VRD
  #undef KRD
  #undef STEP
  #undef ENDW
  {auto rr=__builtin_amdgcn_permlane32_swap(__float_as_uint(l_reg),__float_as_uint(l_reg),false,false);l_reg=__uint_as_float(rr[0])+__uint_as_float(rr[1]);}
  if(hi==0)wsf[32+r32]=l_reg;asm volatile("s_waitcnt lgkmcnt(0)":::"memory");
  float rli[16];
  #pragma unroll
  for(int r=0;r<16;++r)rli[r]=__builtin_amdgcn_rcpf(wsf[32+crow(r,hi)]);
  bf16*Ow=O0+(long)(wid*QBLK)*op;
  { bf16*stg=(bf16*)(shm+LDS_OST2)+wid*2048;
    #pragma unroll
    for(int hh=0;hh<2;++hh){
      #pragma unroll
      for(int r=0;r<16;++r){const int orow=crow(r,hi);
        #pragma unroll
        for(int d0=0;d0<2;++d0)stg[orow*64+d0*32+r32]=__float2bfloat16(o[2*hh+d0][r]*rli[r]);}
      asm volatile("s_waitcnt lgkmcnt(0)":::"memory");
      #pragma unroll
      for(int i=0;i<4;++i){const int row=i*8+(lane>>3),ch=lane&7; const u32x4 v=*(const u32x4*)(stg+row*64+ch*8); ATTN_STORE16(Ow+(long)row*op+hh*64+ch*8,v);}
      asm volatile("s_waitcnt lgkmcnt(0)":::"memory"); } }
  asm volatile("s_waitcnt lgkmcnt(0)\n\ts_barrier":::"memory");
  #undef DMA_K
  #undef DMA_V
  #undef CMASK
  #undef START
  #undef RESC
  #undef ROT
}
#undef SBAR
#undef WAIT_BAR
}

constexpr size_t MiB = 1u << 20;
constexpr size_t WS_CTL = 0, CTL_ZERO_BYTES = 1 * MiB;
constexpr size_t WS_MOD = 1 * MiB;
constexpr size_t WS_TAB = 1 * MiB + 256 * 1024;
constexpr size_t WS_LAM = 1 * MiB + 272 * 1024;
constexpr size_t WS_ME = 2 * MiB, WS_MP = 2 * MiB + 128 * 1024, WS_MW = 2 * MiB + 256 * 1024;
constexpr size_t WS_WIN = 4 * MiB;
constexpr size_t WS_WPRJ = 30 * MiB;
constexpr size_t WS_W13 = 42 * MiB;
constexpr size_t WS_W2F = 53 * MiB;
constexpr size_t WS_XC = 60 * MiB;
constexpr size_t WS_H = 64 * MiB;
constexpr size_t WS_P = 98 * MiB;
constexpr size_t WS_OA = 319 * MiB;
constexpr size_t WS_MX = 421 * MiB;
constexpr size_t WS_U = 98 * MiB;
constexpr size_t WS_MW2 = 4 * MiB;
constexpr size_t WS_HS = 98 * MiB;
constexpr size_t WS_U2 = 166 * MiB;
constexpr size_t WS_MW13 = 404 * MiB;
constexpr size_t WS_END = 516 * MiB;
static_assert(WS_P + (size_t)MEXT * INW * 2 <= WS_OA && WS_OA + (size_t)MEXT * OAW * 2 <= WS_MX && WS_MX + (size_t)MEXT * DM * 2 <= WS_END, "attention-phase map");
static_assert(WS_HS + (size_t)MOE_ROWS * DM * 2 <= WS_U2 && WS_U2 + (size_t)MOE_ROWS * DFE * 2 <= WS_MW13 && WS_MW13 + (size_t)NEXP * 2 * DFE * DM * 2 <= WS_END && WS_MW2 + (size_t)NEXP * DFE * DM * 2 <= WS_XC, "MoE-phase map");
static_assert(WS_W2F + (size_t)DM * DFF * 2 <= WS_XC && WS_U + (size_t)MEXT * DFF * 2 <= WS_OA && WS_H + (size_t)MEXT * DM * 2 <= WS_P, "dense map");
constexpr int CW_BAR = 4096;
constexpr int CW_MOE = 8192;

constexpr int NWAVES = 8;
constexpr int RING_OFF = 0, RING_BYTES = 131072;
constexpr int LDSCTL_OFF = RING_BYTES, MISC_OFF = LDSCTL_OFF + 320;
constexpr int LDS_BYTES = 147456;
static_assert(MISC_OFF + 128 <= LDS_BYTES, "LDS map");

#define GAS __attribute__((address_space(1)))
#define LAS __attribute__((address_space(3)))
typedef unsigned short bf16;
typedef unsigned v4u __attribute__((ext_vector_type(4)));
typedef float f32x4 __attribute__((ext_vector_type(4)));
typedef short bf16x8 __attribute__((ext_vector_type(8)));
typedef GAS unsigned gu32;
typedef GAS unsigned long long gu64;
#define RLX_AGENT __ATOMIC_RELAXED, __HIP_MEMORY_SCOPE_AGENT
#define LDS_WAIT() asm volatile("s_waitcnt lgkmcnt(0)" ::: "memory")
#define VM_WAIT() asm volatile("s_waitcnt vmcnt(0)" ::: "memory")
__device__ __forceinline__ unsigned long long rt() { return __builtin_amdgcn_s_memrealtime(); }
__device__ __forceinline__ unsigned f2bf(float f) { unsigned u = __builtin_bit_cast(unsigned, f); return (u + 0x7fffu + ((u >> 16) & 1u)) >> 16; }
__device__ __forceinline__ unsigned pk2(float lo, float hi) { return f2bf(lo) | (f2bf(hi) << 16); }

#define XB_TMO      128
#define XB_XCNT(j)  (256  + 64 * (j))
#define XB_XSUB(j)  (1280 + 64 * (j))
#define XB_XGEN(j)  (2304 + 64 * (j))
#define XB_TOP      3328
#define XB_TOPGEN   3392
#define XCD_BAR_WORDS 3456
#define XB_SPIN_CAP (1u << 22)

__device__ __forceinline__ unsigned xb_ld(unsigned* p)              { return __hip_atomic_load(p, __ATOMIC_RELAXED, __HIP_MEMORY_SCOPE_AGENT); }
__device__ __forceinline__ unsigned xb_add(unsigned* p, unsigned v) { return __hip_atomic_fetch_add(p, v, __ATOMIC_RELAXED, __HIP_MEMORY_SCOPE_AGENT); }
__device__ __forceinline__ unsigned xb_xcc_id() { return (unsigned)__builtin_amdgcn_s_getreg((3 << 11) | 20) & 0xFu; }
#define XB_SPIN(cond, bar) do { unsigned _sp = 0; while (cond) { __builtin_amdgcn_s_sleep(1); \
    if ((++_sp & 255u) == 0u) { if (xb_ld(&(bar)[XB_TMO])) break; if (_sp > XB_SPIN_CAP) { atomicAdd(&(bar)[XB_TMO], 1u); break; } } } } while (0)

struct XcdBarrier {
    unsigned* bar; unsigned x;
    volatile LAS unsigned* st;
};

__device__ __forceinline__ XcdBarrier xcd_barrier_post(unsigned* bar, volatile LAS unsigned* st) {
    XcdBarrier b; b.bar = bar; b.x = xb_xcc_id(); b.st = st;
    if (threadIdx.x == 0) (void)xb_add(&bar[XB_XCNT(b.x)], 1u);
    return b;
}
__device__ __forceinline__ void xcd_barrier_complete(unsigned* bar, unsigned x, unsigned& nloc, unsigned& nx) {
    const unsigned G = gridDim.x * gridDim.y * gridDim.z;
    unsigned sum, cnt, mine, sp = 0u;
    for (;;) {
        sum = 0u; cnt = 0u; mine = 0u;
#pragma unroll
        for (unsigned j = 0; j < 16; ++j) { const unsigned c = xb_ld(&bar[XB_XCNT(j)]); sum += c; cnt += (c > 0u) ? 1u : 0u; mine = (j == x) ? c : mine; }
        if (sum == G) break;
        __builtin_amdgcn_s_sleep(1);
        if ((++sp & 255u) == 0u) { if (xb_ld(&bar[XB_TMO])) break; if (sp > XB_SPIN_CAP) { atomicAdd(&bar[XB_TMO], 1u); break; } }
    }
    nloc = mine > 0u ? mine : 1u; nx = cnt > 0u ? cnt : 1u;
}

__device__ __forceinline__ void xcd_barrier(const XcdBarrier& b) {
    asm volatile("s_waitcnt vmcnt(0)" ::: "memory");
    __syncthreads();
    if (threadIdx.x == 0) {
        unsigned* bar = b.bar;
        __builtin_amdgcn_s_waitcnt(0);
        unsigned nloc = b.st[0], nx = b.st[1];
        if (nloc == 0u) { xcd_barrier_complete(bar, b.x, nloc, nx); b.st[0] = nloc; b.st[1] = nx; }
        const unsigned old = xb_add(&bar[XB_XSUB(b.x)], 1u);
        const unsigned gen = old / nloc;
        if (old + 1u == (gen + 1u) * nloc) {
            __builtin_amdgcn_fence(__ATOMIC_RELEASE, "agent");
            asm volatile("s_waitcnt vmcnt(0)" ::: "memory");
            const unsigned og = xb_add(&bar[XB_TOP], 1u);
            const unsigned tg = og / nx;
            if (og + 1u == (tg + 1u) * nx) xb_add(&bar[XB_TOPGEN], 1u);
            else XB_SPIN(xb_ld(&bar[XB_TOPGEN]) == tg, bar);
            __builtin_amdgcn_fence(__ATOMIC_ACQUIRE, "agent");
            xb_add(&bar[XB_XGEN(b.x)], 1u);
            asm volatile("s_waitcnt vmcnt(0)" ::: "memory");
        } else {
            XB_SPIN(xb_ld(&bar[XB_XGEN(b.x)]) == gen, bar);
            __builtin_amdgcn_fence(__ATOMIC_ACQUIRE, "agent");
            asm volatile("s_waitcnt vmcnt(0)" ::: "memory");
        }
    }
    __syncthreads();
}

__device__ __forceinline__ float wave_sum(float v) {
#pragma unroll
    for (int o = 1; o < 64; o <<= 1) v += __shfl_xor(v, o);
    return v;
}
__device__ __forceinline__ unsigned pkbf(float lo, float hi) { return pg8::cvt_pk_bf16(lo, hi); }
__device__ __forceinline__ int dst_row0(int mode, int n0) {
    if (mode == 0) return n0;
    if (mode == 1) { const int t = n0 >> 8, blk = (n0 & 255) >> 5, wc = blk >> 1, bj = blk & 1; return (t << 8) + 32 * (4 * bj + wc); }
    const int r = ((n0 >> 7) << 8) + (n0 & 127); return mode == 2 ? r : r + 128;
}
__device__ __forceinline__ void transpose_item(const float* W, int K, int N, bf16* WT, int mode, LAS float* scr, int item, int lane) {
    const int nblk = N / 32, kb = item / nblk, nb = item % nblk, k0 = 64 * kb, n0 = 32 * nb, d0 = dst_row0(mode, n0);
    float tv[32];
#pragma unroll
    for (int i = 0; i < 32; ++i) { const int kk = 2 * i + (lane >> 5); tv[i] = W[(size_t)(k0 + kk) * N + n0 + (lane & 31)]; }
#pragma unroll
    for (int i = 0; i < 32; ++i) { const int kk = 2 * i + (lane >> 5); scr[kk * 33 + (lane & 31)] = tv[i]; }
    LDS_WAIT(); asm volatile("" ::: "memory");
    const int c = lane & 7;
#pragma unroll
    for (int j = 0; j < 4; ++j) { const int n = (lane >> 3) + 8 * j; const LAS float* s = scr + (8 * c) * 33 + n;
        v4u o; o.x = pkbf(s[0 * 33], s[1 * 33]); o.y = pkbf(s[2 * 33], s[3 * 33]); o.z = pkbf(s[4 * 33], s[5 * 33]); o.w = pkbf(s[6 * 33], s[7 * 33]);
        *(GAS v4u*)(WT + (size_t)(d0 + n) * K + k0 + 8 * c) = o; }
    LDS_WAIT(); asm volatile("" ::: "memory");
}
__device__ __forceinline__ void row_load(const float* xrow, int lane, f32x4 (&h)[4]) {
    const GAS f32x4* xr = (const GAS f32x4*)xrow + lane;
#pragma unroll
    for (int j = 0; j < 4; ++j) h[j] = xr[64 * j];
}
__device__ __forceinline__ void norm_mod_apply(f32x4 (&h)[4], const float* g, const float* sh, const float* sc, bf16* orow, int lane) {
    float ss = 0.f;
#pragma unroll
    for (int j = 0; j < 4; ++j) ss += (h[j].x * h[j].x + h[j].y * h[j].y) + (h[j].z * h[j].z + h[j].w * h[j].w);
    const float rs = 1.f / sqrtf(wave_sum(ss) * (1.f / DM) + EPS);
    GAS unsigned long long* o8 = (GAS unsigned long long*)orow + lane;
#pragma unroll
    for (int j = 0; j < 4; ++j) { const f32x4 g4 = ((const GAS f32x4*)g)[lane + 64 * j], s4 = ((const GAS f32x4*)sc)[lane + 64 * j], b4 = ((const GAS f32x4*)sh)[lane + 64 * j];
        h[j] = h[j] * rs * g4 * (s4 + 1.f) + b4;
        o8[64 * j] = (unsigned long long)pkbf(h[j].x, h[j].y) | ((unsigned long long)pkbf(h[j].z, h[j].w) << 32); }
}
struct Args { const float* in[24]; float* out; unsigned char* ws; };
enum { I_X = 0, I_C, I_CTX, I_CCTX, I_ADAW, I_ADAB, I_NAG, I_NFG, I_WIN, I_QNG, I_KNG, I_DLAM, I_SUBG, I_WPD, I_WPG, I_WO, I_FW1, I_FW3, I_FW2, I_ROUTER, I_MW1, I_MW3, I_MW2, I_FNG };

#ifndef REP_ATT
#define REP_ATT 1
#endif
#ifndef REP_GEMM
#define REP_GEMM 1
#endif
#define CAS __attribute__((address_space(4)))
#define PH_BEGIN \
    const CAS Args* ap = (const CAS Args*)__builtin_amdgcn_kernarg_segment_ptr(); asm volatile("" : "+s"(ap)); \
    unsigned char* const ws = (unsigned char*)(GAS unsigned char*)ap->ws; \
    int tid = threadIdx.x; asm volatile("" : "+v"(tid)); \
    const int lane = tid & 63, wave = __builtin_amdgcn_readfirstlane(tid >> 6); \
    const int G = gridDim.x, bx = blockIdx.x, vcu = (G % 8 == 0) ? (bx % 8) * (G / 8) + bx / 8 : bx, gw = vcu * NWAVES + wave, NGW = G * NWAVES; \
    (void)lane; (void)gw; (void)NGW; (void)bx; (void)ws;
#define INP(i) ((const float*)(const GAS float*)ap->in[i])
#define WSP(T, off) ((T*)(ws + (off)))
#define LDSP ((LAS unsigned char*)lds)

__global__ void __launch_bounds__(NWAVES * 64, 2) fwd_kernel(Args args) {
    extern __shared__ __attribute__((aligned(16))) unsigned char lds[];
    for (int u = threadIdx.x; u < (LDS_BYTES - LDSCTL_OFF) / 4; u += NWAVES * 64) ((LAS unsigned*)(LDSP + LDSCTL_OFF))[u] = 0u;
    __syncthreads();
    const XcdBarrier bar = xcd_barrier_post((unsigned*)(args.ws + WS_CTL) + CW_BAR, (volatile LAS unsigned*)(LDSP + MISC_OFF) + 8);
#define GRID_BAR() do { XcdBarrier b_ = bar; asm volatile("" : "+s"(b_.bar), "+s"(b_.x)); b_.bar = (unsigned*)(GAS unsigned*)b_.bar; xcd_barrier(b_); } while (0)

#define D_MOD WSP(float, WS_MOD)
#define D_TAB WSP(float, WS_TAB)
#define D_LAM WSP(float, WS_LAM)
#define D_H WSP(bf16, WS_H)
#define D_P WSP(bf16, WS_P)
#define D_OA WSP(bf16, WS_OA)
#define D_MX WSP(bf16, WS_MX)
#define D_XC WSP(float, WS_XC)
#define D_X ((float*)(GAS float*)ap->out)
#define D_SCR ((LAS float*)(LDSP + RING_OFF + wave * 8448))
#define D_MODL (D_MOD + (size_t)l * 5 * 6144)
#define D_CNT ((gu32*)(GAS unsigned*)(ws + WS_CTL) + CW_MOE)
#define D_ME WSP(int2, WS_ME)
#define D_MP WSP(int2, WS_MP)
#define D_MW WSP(float2, WS_MW)
#define PS_LOAD int ps[9]; ps[0] = 0; _Pragma("unroll") for (int e_ = 0; e_ < 8; ++e_) { const int n_ = (int)__builtin_amdgcn_readfirstlane(__hip_atomic_load(D_CNT + 64 * e_, RLX_AGENT)); ps[e_ + 1] = ps[e_] + ((n_ + 255) >> 8); }
    {
        PH_BEGIN
        LAS float* const st = (LAS float*)(LDSP + RING_OFF + 69632);
        for (int i = tid; i < 5 * DM; i += NWAVES * 64) { const float x = i < 4 * DM ? INP(I_C)[i] : INP(I_CCTX)[i - 4 * DM]; st[i] = x / (1.f + __expf(-x)); }
        __syncthreads();
        constexpr int N_MOD = 2 * 384, N_ROPE = 16, N_LAM = 1, N_WIN = 16 * (INW / 32), N_PRJ = 16 * 32, N_W1 = 16 * (DFF / 32), N_W2 = (DFF / 64) * 32;
        constexpr int NITEMS = N_MOD + N_ROPE + N_LAM + 2 * N_WIN + 6 * N_PRJ + 2 * N_W1 + N_W2;
        for (int it = gw; it < NITEMS; it += NGW) {
            int r = it;
            if (r < N_MOD) {
                const int l = r / 384, cb = r - l * 384, cl = lane & 15, kg = lane >> 4, col = 16 * cb + cl;
                const float* w = INP(I_ADAW) + (size_t)l * DM * 6144 + col; float a0 = 0.f, a1 = 0.f, a2 = 0.f, a3 = 0.f, a4 = 0.f;
#pragma unroll 16
                for (int k = kg; k < DM; k += 4) { const float wv = w[(size_t)k * 6144]; a0 += st[k] * wv; a1 += st[DM + k] * wv; a2 += st[2 * DM + k] * wv; a3 += st[3 * DM + k] * wv; a4 += st[4 * DM + k] * wv; }
                a0 += __shfl_xor(a0, 16); a0 += __shfl_xor(a0, 32); a1 += __shfl_xor(a1, 16); a1 += __shfl_xor(a1, 32); a2 += __shfl_xor(a2, 16); a2 += __shfl_xor(a2, 32);
                a3 += __shfl_xor(a3, 16); a3 += __shfl_xor(a3, 32); a4 += __shfl_xor(a4, 16); a4 += __shfl_xor(a4, 32);
                if (kg == 0) { const float bb = INP(I_ADAB)[l * 6144 + col]; float* m = D_MOD + (size_t)l * 5 * 6144 + col;
                    m[0] = a0 + bb; m[6144] = a1 + bb; m[2 * 6144] = a2 + bb; m[3 * 6144] = a3 + bb; m[4 * 6144] = a4 + bb; }
                continue; }
            r -= N_MOD;
            if (r < N_ROPE) { const int idx = r * 64 + lane, pos = idx >> 4, f = idx & 15; const float invf = powf(10000.f, -(float)f / 16.f), ang = (float)pos * invf;
                D_TAB[2 * idx] = cosf(ang); D_TAB[2 * idx + 1] = sinf(ang); continue; }
            r -= N_ROPE;
            if (r < N_LAM) {
                for (int l = 0; l < 2; ++l) { const float* dl = INP(I_DLAM) + l * 256; const float s1 = wave_sum(dl[lane] * dl[64 + lane]), s2 = wave_sum(dl[128 + lane] * dl[192 + lane]);
                    if (lane == 0) D_LAM[l] = expf(s1) - expf(s2) + (0.8f - 0.6f * expf(-0.3f * (float)l)); }
                continue; }
            r -= N_LAM;
            if (r < 2 * N_WIN) { const int l = r / N_WIN; transpose_item(INP(I_WIN) + (size_t)l * DM * INW, DM, INW, (bf16*)(ws + WS_WIN) + (size_t)l * INW * DM, 1, D_SCR, r - l * N_WIN, lane); continue; }
            r -= 2 * N_WIN;
            if (r < 6 * N_PRJ) { const int j = r / N_PRJ, l = j / 3, w = j - 3 * l;
                const float* src = (w == 0 ? INP(I_WPD) : w == 1 ? INP(I_WPG) : INP(I_WO)) + (size_t)l * DM * DM;
                transpose_item(src, DM, DM, (bf16*)(ws + WS_WPRJ) + (size_t)j * DM * DM, 0, D_SCR, r - j * N_PRJ, lane); continue; }
            r -= 6 * N_PRJ;
            if (r < N_W1) { transpose_item(INP(I_FW1), DM, DFF, (bf16*)(ws + WS_W13), 2, D_SCR, r, lane); continue; }
            r -= N_W1;
            if (r < N_W1) { transpose_item(INP(I_FW3), DM, DFF, (bf16*)(ws + WS_W13), 3, D_SCR, r, lane); continue; }
            r -= N_W1;
            transpose_item(INP(I_FW2), DFF, DM, (bf16*)(ws + WS_W2F), 0, D_SCR, r, lane);
        }
    }
    GRID_BAR();

    for (int l = 0; l < 2; ++l) {
        {
            PH_BEGIN
            const float* xl = l == 0 ? INP(I_X) : D_X; const float* xc = l == 0 ? INP(I_CTX) : D_XC; f32x4 hv[4], hn[4];
#define XROW(e_) ((e_) % EXT < SEQ ? xl + (size_t)((e_) / EXT * SEQ + (e_) % EXT) * DM : xc + (size_t)((e_) / EXT * CTXL + (e_) % EXT - SEQ) * DM)
            row_load(XROW(gw), lane, hv);
            for (int e = gw; e < MEXT; e += NGW) { const int b = e / EXT, s = e - b * EXT; const bool lat = s < SEQ;
                const int en = e + NGW < MEXT ? e + NGW : e; row_load(XROW(en), lane, hn);
                const float* mv = D_MODL + (lat ? b : 4) * 6144;
                norm_mod_apply(hv, INP(I_NAG) + l * DM, mv, mv + DM, D_H + (size_t)e * DM, lane);
#pragma unroll
                for (int j = 0; j < 4; ++j) hv[j] = hn[j]; }
#undef XROW
        }
        GRID_BAR();
for (int rep_ = 0; rep_ < REP_GEMM; ++rep_) {
        {
            PH_BEGIN
            pg8::Gemm g{(const pg8::bf16_t*)D_H, (const pg8::bf16_t*)(ws + WS_WIN) + (size_t)l * INW * DM, DM, DM, 0};
            pg8::RectOrder S; if (l == 0) S.init(NPAN, INW / 256, G, bx, 0, 0, 0); else S.init(64, INW / 256, G, bx, 1, 8, 10);
            pg8::EpiInProj E{(pg8::bf16_t*)D_P, INP(I_QNG) + l * 64, INP(I_KNG) + l * 64, D_TAB, attn_body::C2};
            pg8::gemm_phase<pg8::EpiInProj, pg8::RectOrder, true, true>(LDSP + RING_OFF, g, S, E);
        }
        GRID_BAR();
        }
for (int rep_ = 0; rep_ < REP_ATT; ++rep_) {
        {
            PH_BEGIN
            const int nun = l == 0 ? 2048 + 128 : 2048;
            for (int i = 0;; ++i) {
                const int Lu = i * G + vcu; if (Lu >= nun) break;
                int b, k, qb; bool diff;
                if (Lu < 2048) { const int pr = Lu >> 4, rnd = pr >> 4, idx = (rnd >> 1) * 16 + (pr & 15); qb = Lu & 15; diff = (rnd & 1) == 0; b = idx >> 4; k = idx & 15; }
                else { const int x = Lu - 2048; b = x >> 5; const int kk = x & 31; diff = kk < 16; k = kk & 15; qb = 16; }
                const size_t qrow = (size_t)b * EXT + qb * 256, krow = (size_t)b * EXT + (qb < 16 ? 0 : SEQ); const int NT = qb < 16 ? EXT / 64 : CTXL / 64;
                const attn_body::bf16* Pq = (const attn_body::bf16*)D_P + qrow * INW; const attn_body::bf16* Pk = (const attn_body::bf16*)D_P + krow * INW; attn_body::bf16* Oq = (attn_body::bf16*)D_OA + qrow * OAW;
                if (diff) { const int h = k >> 1, c = k & 1;
                    attn_body::attn_unit_dv<8>(Pq + PC_QD + h * 128 + c * 64, INW, Pk + PC_KD + h * 128 + c * 64, INW, Pk + PC_VD + h * 128, INW, Oq + c * 1024 + h * 128, OAW, NT, (char*)lds + RING_OFF); }
                else { const int gk = k >> 2;
                    attn_body::attn_unit<8>(Pq + PC_QG + k * 64, INW, Pk + PC_KG + gk * 64, INW, Pk + PC_VG + gk * 64, INW, Oq + 2048 + k * 64, OAW, NT, (char*)lds + RING_OFF); }
            }
        }
        GRID_BAR();
        }
        {
            PH_BEGIN
            const float lam = D_LAM[l], li = 1.f - (0.8f - 0.6f * expf(-0.3f * (float)l)); const float* sg = INP(I_SUBG) + l * 128 + 16 * (lane & 7);
            f32x4 g4[4];
#pragma unroll
            for (int j = 0; j < 4; ++j) g4[j] = ((const GAS f32x4*)sg)[j];
            for (int e = gw; e < MEXT; e += NGW) { bf16* row = D_OA + (size_t)e * OAW + 16 * lane;
                const v4u ra0 = *(const GAS v4u*)row, ra1 = *(const GAS v4u*)(row + 8), rc0 = *(const GAS v4u*)(row + 1024), rc1 = *(const GAS v4u*)(row + 1032);
                f32x4 a[4], c[4]; pg8::unpack8(ra0, a[0], a[1]); pg8::unpack8(ra1, a[2], a[3]); pg8::unpack8(rc0, c[0], c[1]); pg8::unpack8(rc1, c[2], c[3]);
                float ss = 0.f;
#pragma unroll
                for (int j = 0; j < 4; ++j) { a[j] = a[j] - c[j] * lam; ss += (a[j].x * a[j].x + a[j].y * a[j].y) + (a[j].z * a[j].z + a[j].w * a[j].w); }
                ss += __shfl_xor(ss, 1); ss += __shfl_xor(ss, 2); ss += __shfl_xor(ss, 4);
                const float rs = li / sqrtf(ss * (1.f / 128.f) + EPS);
#pragma unroll
                for (int j = 0; j < 4; ++j) a[j] = a[j] * rs * g4[j];
                *(GAS v4u*)row = pg8::pack8(a[0], a[1]); *(GAS v4u*)(row + 8) = pg8::pack8(a[2], a[3]); }
        }
        GRID_BAR();
        {
            PH_BEGIN
            pg8::Gemm g{(const pg8::bf16_t*)D_OA, (const pg8::bf16_t*)(ws + WS_WPRJ) + (size_t)(l * 3 + 0) * DM * DM, DM, OAW, 0};
            pg8::RectOrder S; if (l == 0) S.init(NPAN, 4, G, bx, 0, 0, 0); else S.init(64, 4, G, bx, 1, 0, 0);
            pg8::EpiGate E{(pg8::bf16_t*)D_MX, (const pg8::bf16_t*)D_P + PC_G1, 0};
            pg8::gemm_phase<pg8::EpiGate, pg8::RectOrder, true, true>(LDSP + RING_OFF, g, S, E);
        }
        GRID_BAR();
        {
            PH_BEGIN
            pg8::Gemm g{(const pg8::bf16_t*)D_OA + 2048, (const pg8::bf16_t*)(ws + WS_WPRJ) + (size_t)(l * 3 + 1) * DM * DM, DM, OAW, 0};
            pg8::RectOrder S; if (l == 0) S.init(NPAN, 4, G, bx, 0, 0, 0); else S.init(64, 4, G, bx, 1, 0, 0);
            pg8::EpiGate E{(pg8::bf16_t*)D_MX, (const pg8::bf16_t*)D_P + PC_G2, 1};
            pg8::gemm_phase<pg8::EpiGate, pg8::RectOrder, true, true>(LDSP + RING_OFF, g, S, E);
        }
        GRID_BAR();
        {
            PH_BEGIN
            pg8::Gemm g{(const pg8::bf16_t*)D_MX, (const pg8::bf16_t*)(ws + WS_WPRJ) + (size_t)(l * 3 + 2) * DM * DM, DM, DM, 0};
            pg8::RectOrder S; if (l == 0) S.init(NPAN, 4, G, bx, 0, 0, 0); else S.init(64, 4, G, bx, 1, 0, 0);
            pg8::EpiResid E{l == 0 ? INP(I_X) : D_X, l == 0 ? INP(I_CTX) : D_XC, D_X, D_XC, D_MODL + 2 * DM};
            pg8::gemm_phase<pg8::EpiResid, pg8::RectOrder, true, true>(LDSP + RING_OFF, g, S, E);
        }
        GRID_BAR();
        if (l == 0) {
            { PH_BEGIN
              f32x4 hv[4], hn[4]; const float* xl = D_X; const float* xc = D_XC;
#define XROW(e_) ((e_) % EXT < SEQ ? xl + (size_t)((e_) / EXT * SEQ + (e_) % EXT) * DM : xc + (size_t)((e_) / EXT * CTXL + (e_) % EXT - SEQ) * DM)
              row_load(XROW(gw), lane, hv);
              for (int e = gw; e < MEXT; e += NGW) { const int b = e / EXT, s = e - b * EXT; const bool lat = s < SEQ;
                  const int en = e + NGW < MEXT ? e + NGW : e; row_load(XROW(en), lane, hn);
                  const float* mv = D_MODL + (lat ? b : 4) * 6144;
                  norm_mod_apply(hv, INP(I_NFG) + l * DM, mv + 3 * DM, mv + 4 * DM, D_H + (size_t)e * DM, lane);
#pragma unroll
                  for (int j = 0; j < 4; ++j) hv[j] = hn[j]; } }
#undef XROW
            GRID_BAR();
for (int rep_ = 0; rep_ < REP_GEMM; ++rep_) {
            {
                PH_BEGIN
                pg8::Gemm g{(const pg8::bf16_t*)D_H, (const pg8::bf16_t*)(ws + WS_W13), DM, DM, 0};
                pg8::RectOrder S; S.init(NPAN, 2 * DFF / 256, G, bx, 0, 0, 0);
                pg8::EpiSwiGLU E{(pg8::bf16_t*)(ws + WS_U), DFF};
                pg8::gemm_phase<pg8::EpiSwiGLU, pg8::RectOrder, true, true>(LDSP + RING_OFF, g, S, E);
            }
            GRID_BAR();
        }
            {
                PH_BEGIN
                pg8::Gemm g{(const pg8::bf16_t*)(ws + WS_U), (const pg8::bf16_t*)(ws + WS_W2F), DFF, DFF, 0};
                pg8::RectOrder S; S.init(NPAN, 4, G, bx, 0, 0, 0);
                pg8::EpiResid E{D_X, D_XC, D_X, D_XC, D_MODL + 5 * DM};
                pg8::gemm_phase<pg8::EpiResid, pg8::RectOrder, true, true>(LDSP + RING_OFF, g, S, E);
            }
            GRID_BAR();
        } else {
            { PH_BEGIN
              f32x4 hv[4], hn[4]; const float* router = INP(I_ROUTER);
              row_load(D_X + (size_t)gw * DM, lane, hn);
              for (int t = gw; t < MLAT; t += NGW) { const int b = t / SEQ; const float* mv = D_MODL + b * 6144;
#pragma unroll
                  for (int j = 0; j < 4; ++j) hv[j] = hn[j];
                  row_load(D_X + (size_t)(t + NGW < MLAT ? t + NGW : t) * DM, lane, hn);
                  norm_mod_apply(hv, INP(I_NFG) + l * DM, mv + 3 * DM, mv + 4 * DM, D_H + (size_t)t * DM, lane);
                  float lg[8];
#pragma unroll
                  for (int e = 0; e < 8; ++e) lg[e] = 0.f;
#pragma unroll
                  for (int j = 0; j < 4; ++j)
#pragma unroll
                      for (int i = 0; i < 4; ++i) { const GAS f32x4* rp = (const GAS f32x4*)(router + (size_t)(4 * lane + 256 * j + i) * 8); const f32x4 r0 = rp[0], r1 = rp[1]; const float hx = hv[j][i];
                          lg[0] += hx * r0.x; lg[1] += hx * r0.y; lg[2] += hx * r0.z; lg[3] += hx * r0.w; lg[4] += hx * r1.x; lg[5] += hx * r1.y; lg[6] += hx * r1.z; lg[7] += hx * r1.w; }
#pragma unroll
                  for (int e = 0; e < 8; ++e) lg[e] = wave_sum(lg[e]);
                  int i0 = 0; float v0 = lg[0];
#pragma unroll
                  for (int e = 1; e < 8; ++e) if (lg[e] > v0) { v0 = lg[e]; i0 = e; }
                  int i1 = -1; float v1 = -INFINITY;
#pragma unroll
                  for (int e = 0; e < 8; ++e) if (e != i0 && lg[e] > v1) { v1 = lg[e]; i1 = e; }
                  if (lane == 0) { const float w0 = 1.f / (1.f + expf(v1 - v0));
                      const int p0 = (int)__hip_atomic_fetch_add(D_CNT + 64 * i0, 1u, RLX_AGENT), p1 = (int)__hip_atomic_fetch_add(D_CNT + 64 * i1, 1u, RLX_AGENT);
                      D_ME[t] = make_int2(i0, i1); D_MP[t] = make_int2(p0, p1); D_MW[t] = make_float2(w0, 1.f - w0); } } }
            {
                PH_BEGIN
                constexpr int N_E1 = 16 * (DFE / 32), N_E2 = (DFE / 64) * 32;
                for (int it = gw; it < NEXP * (2 * N_E1 + N_E2); it += NGW) { const int e = it / (2 * N_E1 + N_E2); int r = it - e * (2 * N_E1 + N_E2);
                    if (r < N_E1) { transpose_item(INP(I_MW1) + (size_t)e * DM * DFE, DM, DFE, (bf16*)(ws + WS_MW13) + (size_t)e * 2 * DFE * DM, 2, D_SCR, r, lane); continue; }
                    r -= N_E1;
                    if (r < N_E1) { transpose_item(INP(I_MW3) + (size_t)e * DM * DFE, DM, DFE, (bf16*)(ws + WS_MW13) + (size_t)e * 2 * DFE * DM, 3, D_SCR, r, lane); continue; }
                    r -= N_E1;
                    transpose_item(INP(I_MW2) + (size_t)e * DFE * DM, DFE, DM, (bf16*)(ws + WS_MW2) + (size_t)e * DM * DFE, 0, D_SCR, r, lane); }
            }
            GRID_BAR();
            {
                PH_BEGIN
                PS_LOAD
                bf16* const HS = (bf16*)(ws + WS_HS);
                for (int it = gw; it < 2 * MLAT; it += NGW) { const int t = it >> 1, k = it & 1; const int2 ee = D_ME[t], pp = D_MP[t]; const int e = k ? ee.y : ee.x, p = k ? pp.y : pp.x;
                    int pe = 0;
#pragma unroll
                    for (int q = 1; q < 8; ++q) pe = (e == q) ? ps[q] : pe;
                    const GAS v4u* src = (const GAS v4u*)(D_H + (size_t)t * DM); GAS v4u* dst = (GAS v4u*)(HS + ((size_t)pe * 256 + p) * DM);
                    dst[lane] = src[lane]; dst[lane + 64] = src[lane + 64]; }
            }
            GRID_BAR();
for (int rep_ = 0; rep_ < REP_GEMM; ++rep_) {
            {
                PH_BEGIN
                PS_LOAD
                pg8::Gemm g{(const pg8::bf16_t*)(ws + WS_HS), (const pg8::bf16_t*)(ws + WS_MW13), DM, DM, (size_t)2 * DFE * DM * 2};
                pg8::MoeOrder S{ps[8], 2 * DFE / 256, ps[8] * (2 * DFE / 256), G, bx, ps[1], ps[2], ps[3], ps[4], ps[5], ps[6], ps[7]};
                pg8::EpiSwiGLU E{(pg8::bf16_t*)(ws + WS_U2), DFE};
                pg8::gemm_phase<pg8::EpiSwiGLU, pg8::MoeOrder, true, true>(LDSP + RING_OFF, g, S, E);
            }
            GRID_BAR();
        }
for (int rep_ = 0; rep_ < REP_GEMM; ++rep_) {
            {
                PH_BEGIN
                PS_LOAD
                pg8::Gemm g{(const pg8::bf16_t*)(ws + WS_U2), (const pg8::bf16_t*)(ws + WS_MW2), DFE, DFE, (size_t)DM * DFE * 2};
                pg8::MoeOrder S{ps[8], 4, ps[8] * 4, G, bx, ps[1], ps[2], ps[3], ps[4], ps[5], ps[6], ps[7]};
                pg8::EpiPlain E{(pg8::bf16_t*)(ws + WS_HS), DM};
                pg8::gemm_phase<pg8::EpiPlain, pg8::MoeOrder, true, true>(LDSP + RING_OFF, g, S, E);
            }
            GRID_BAR();
        }
            {
                PH_BEGIN
                PS_LOAD
                const bf16* const Y = (const bf16*)(ws + WS_HS); const float* fg = INP(I_FNG);
                for (int t = gw; t < MLAT; t += NGW) { const int b = t / SEQ; const int2 ee = D_ME[t], pp = D_MP[t]; const float2 ww = D_MW[t];
                    int pe0 = 0, pe1 = 0;
#pragma unroll
                    for (int q = 1; q < 8; ++q) { pe0 = (ee.x == q) ? ps[q] : pe0; pe1 = (ee.y == q) ? ps[q] : pe1; }
                    const GAS unsigned long long* y0 = (const GAS unsigned long long*)(Y + ((size_t)pe0 * 256 + pp.x) * DM) + lane; const GAS unsigned long long* y1 = (const GAS unsigned long long*)(Y + ((size_t)pe1 * 256 + pp.y) * DM) + lane;
                    GAS f32x4* xr = (GAS f32x4*)(D_X + (size_t)t * DM) + lane; const GAS f32x4* gt = (const GAS f32x4*)(D_MODL + b * 6144 + 5 * DM) + lane;
                    f32x4 v[4]; float ss = 0.f;
#pragma unroll
                    for (int j = 0; j < 4; ++j) { const unsigned long long a = y0[64 * j], c = y1[64 * j]; const unsigned a0 = (unsigned)a, a1 = (unsigned)(a >> 32), c0 = (unsigned)c, c1 = (unsigned)(c >> 32);
                        const f32x4 ya = {__builtin_bit_cast(float, a0 << 16), __builtin_bit_cast(float, a0 & 0xffff0000u), __builtin_bit_cast(float, a1 << 16), __builtin_bit_cast(float, a1 & 0xffff0000u)};
                        const f32x4 yc = {__builtin_bit_cast(float, c0 << 16), __builtin_bit_cast(float, c0 & 0xffff0000u), __builtin_bit_cast(float, c1 << 16), __builtin_bit_cast(float, c1 & 0xffff0000u)};
                        v[j] = xr[64 * j] + gt[64 * j] * (ya * ww.x + yc * ww.y);
                        ss += (v[j].x * v[j].x + v[j].y * v[j].y) + (v[j].z * v[j].z + v[j].w * v[j].w); }
                    const float rs = 1.f / sqrtf(wave_sum(ss) * (1.f / DM) + EPS);
#pragma unroll
                    for (int j = 0; j < 4; ++j) xr[64 * j] = v[j] * rs * ((const GAS f32x4*)fg)[lane + 64 * j]; }
            }
        }
    }
#undef GRID_BAR
}

extern "C" void kernel_launch(void* const* d_in, const int* in_sizes, int n_in, void* d_out, int out_size, void* d_ws, size_t ws_size, hipStream_t stream) {
    static int grid = 0;
    if (grid == 0) {
        if (n_in != 24 || out_size != MLAT * DM || ws_size < WS_END) { fprintf(stderr, "kernel_launch: built for 24 inputs, %d outputs, >= %zu bytes of workspace; got n_in %d, out %d, ws %zu; nothing launched\n", MLAT * DM, (size_t)WS_END, n_in, out_size, ws_size); grid = -1; return; }
        int dev = 0, cus = 0, per_cu = 0;
        if (hipGetDevice(&dev) != hipSuccess || hipDeviceGetAttribute(&cus, hipDeviceAttributeMultiprocessorCount, dev) != hipSuccess) { fprintf(stderr, "kernel_launch: device query failed\n"); grid = -1; return; }
        if (hipFuncSetAttribute((const void*)fwd_kernel, hipFuncAttributeMaxDynamicSharedMemorySize, LDS_BYTES) != hipSuccess) { fprintf(stderr, "kernel_launch: hipFuncSetAttribute failed\n"); grid = -1; return; }
        if (hipOccupancyMaxActiveBlocksPerMultiprocessor(&per_cu, (const void*)fwd_kernel, NWAVES * 64, LDS_BYTES) != hipSuccess || per_cu < 1) { fprintf(stderr, "kernel_launch: occupancy query reports %d workgroups per CU\n", per_cu); }
        (void)hipGetLastError();
        grid = cus;
    }
    if (grid < 0) return;
    if (hipMemsetAsync((char*)d_ws + WS_CTL, 0, CTL_ZERO_BYTES, stream) != hipSuccess) { fprintf(stderr, "kernel_launch: hipMemsetAsync failed\n"); return; }
    Args a{};
    for (int i = 0; i < 24; ++i) a.in[i] = (const float*)d_in[i];
    a.out = (float*)d_out; a.ws = (unsigned char*)d_ws;
    hipLaunchKernelGGL(fwd_kernel, dim3(grid), dim3(NWAVES * 64), LDS_BYTES, stream, a);
    const hipError_t le = hipPeekAtLastError();
    if (le != hipSuccess) fprintf(stderr, "kernel_launch: launch failed: %s\n", hipGetErrorName(le));
}
```

```cpp
#include <hip/hip_runtime.h>
#include <hip/hip_bf16.h>
#include <cstdio>
#include <cstdint>
#include <cmath>

constexpr int DM = 1024, NB = 4, SEQ = 4096, CTXL = 256, EXT = SEQ + CTXL, MEXT = NB * EXT, MLAT = NB * SEQ, MCTX = NB * CTXL;
constexpr int PANB = EXT / 256  , NPAN = NB * PANB  ;
constexpr int INW = 6656;
constexpr int PC_QD = 0, PC_QG = 1024, PC_KD = 2048, PC_VD = 3072, PC_KG = 4096, PC_VG = 4352, PC_G1 = 4608, PC_G2 = 5632;
constexpr int OAW = 3072;
constexpr int DFF = 2816, NEXP = 8, DFE = 3584;
constexpr int MOE_ROWS = 2 * MLAT + NEXP * 256;
constexpr float EPS = 1e-6f;
constexpr int NHU = 48;
namespace pg8 {
#define PG8_LAS __attribute__((address_space(3)))
typedef unsigned short bf16_t;
typedef short bf16x8 __attribute__((ext_vector_type(8)));
typedef float f32x4 __attribute__((ext_vector_type(4)));
typedef unsigned u32x4 __attribute__((ext_vector_type(4)));
constexpr int BM = 256, BK = 64, HALF = 128, HTB = HALF * BK * 2  , STAGE_BYTES = 8 * HTB, NXCD = 8, WGM = 8;

__host__ __device__ __forceinline__ int lds_byte(int r, int c) { const int st = (r >> 4) * 2 + (c >> 5), rr = r & 15, cc = c & 31, ob = rr * 64 + cc * 2; return st * 1024 + (ob ^ (((ob >> 9) & 1) << 5)); }
__host__ __device__ __forceinline__ void stage_rc(int b, int& R, int& C) { const int st = b / 1024, sb = b % 1024, swz = sb ^ (((sb >> 9) & 1) << 5); R = (st >> 1) * 16 + swz / 64; C = (st & 1) * 32 + (swz % 64) / 2; }
__host__ __device__ __forceinline__ int perm32(int rho) { const int n = rho >> 4, i = rho & 15; return 8 * (i >> 2) + 4 * n + (i & 3); }

struct Unit { int pm, pn, e, koff, sl; };
struct Gemm { const bf16_t* A; const bf16_t* Bt; int K, lda, ldb; size_t bstride; };
__device__ __forceinline__ void rect_map(int wgid, int nM, int nN, int& pm, int& pn) {
    const int nwg = nM * nN; { const int q = nwg / NXCD, r = nwg % NXCD, xcd = wgid % NXCD, off = wgid / NXCD; wgid = (xcd < r ? xcd * (q + 1) : r * (q + 1) + (xcd - r) * q) + off; }
    const int nig = WGM * nN, gid = wgid / nig, fm = gid * WGM, gsz = (nM - fm) < WGM ? (nM - fm) : WGM;
    pm = fm + ((wgid % nig) % gsz); pn = (wgid % nig) / gsz;
}
struct RectOrder {
    int nMq, nN, nrect, G, c, latmode, exlo, exn, nextra;
    __device__ __forceinline__ void init(int nMq_, int nN_, int G_, int c_, int latmode_, int exlo_, int exn_) { nMq = nMq_; nN = nN_; nrect = nMq_ * nN_; G = G_; c = c_; latmode = latmode_; exlo = exlo_; exn = exn_; nextra = 4 * exn_; }
    __device__ __forceinline__ bool next(int i, Unit& u) const {
        int L = i * G + c; u.e = 0; u.koff = 0; u.sl = 0;
        if (L < nrect) { int q, pn; rect_map(L, nMq, nN, q, pn); u.pm = latmode ? (q >> 4) * 17 + (q & 15) : q; u.pn = pn; return true; }
        L -= nrect; if (L >= nextra) return false;
        const int b = L / exn; u.pm = b * 17 + 16; u.pn = exlo + (L - b * exn); return true;
    }
    __device__ __forceinline__ void a_ready(const Unit&) const {}
    __device__ __forceinline__ void done(const Unit&) const {}
};
struct CtxSliceOrder {
    int ns, kslice, G, c;
    __device__ __forceinline__ bool next(int i, Unit& u) const {
        const int L = i * G + c; if (L >= 16 * ns) return false;
        const int t = L / ns; u.pm = (t >> 2) * 17 + 16; u.pn = t & 3; u.e = 0; u.koff = (L - t * ns) * kslice; u.sl = L; return true;
    }
    __device__ __forceinline__ void a_ready(const Unit&) const {}
    __device__ __forceinline__ void done(const Unit&) const {}
};
struct MoeOrder {
    int P, nN, lim, G, c, p1, p2, p3, p4, p5, p6, p7, ns, first, kslice;
    __device__ __forceinline__ bool next(int i, Unit& u) const {
        int L = i * G + c; if (L >= lim) return false;
        u.koff = 0; u.sl = 0;
        if (ns > 1) { const int t = L / ns; u.koff = (L - t * ns) * kslice; u.sl = L; L = first + t; }
        int pm, pn; rect_map(L, P, nN, pm, pn); u.pm = pm; u.pn = pn;
        u.e = (pm >= p1) + (pm >= p2) + (pm >= p3) + (pm >= p4) + (pm >= p5) + (pm >= p6) + (pm >= p7); return true;
    }
    __device__ __forceinline__ void a_ready(const Unit&) const {}
    __device__ __forceinline__ void done(const Unit&) const {}
};

__device__ __forceinline__ unsigned cvt_pk_bf16(float lo, float hi) { unsigned r; asm volatile("v_cvt_pk_bf16_f32 %0, %1, %2" : "=v"(r) : "v"(lo), "v"(hi)); return r; }
__device__ __forceinline__ u32x4 pack8(const f32x4& a, const f32x4& b) { u32x4 w; w.x = cvt_pk_bf16(a[0], a[1]); w.y = cvt_pk_bf16(a[2], a[3]); w.z = cvt_pk_bf16(b[0], b[1]); w.w = cvt_pk_bf16(b[2], b[3]); return w; }
__device__ __forceinline__ void unpack8(const u32x4& w, f32x4& a, f32x4& b) {
    a[0] = __builtin_bit_cast(float, w.x << 16); a[1] = __builtin_bit_cast(float, w.x & 0xffff0000u); a[2] = __builtin_bit_cast(float, w.y << 16); a[3] = __builtin_bit_cast(float, w.y & 0xffff0000u);
    b[0] = __builtin_bit_cast(float, w.z << 16); b[1] = __builtin_bit_cast(float, w.z & 0xffff0000u); b[2] = __builtin_bit_cast(float, w.w << 16); b[3] = __builtin_bit_cast(float, w.w & 0xffff0000u); }
__device__ __forceinline__ float sigmoidf_(float v) { return __builtin_amdgcn_rcpf(1.f + __expf(-v)); }

struct EpiInProj {
    static constexpr bool PERM = true, AFTER_DRAIN = false;
    bf16_t* P; const float* qg; const float* kg; const float* tab; float c2;
    __device__ __forceinline__ void operator()(const f32x4 (&acc)[2][2][4][2], const Unit& u, int wr, int wc, int fr, int fq) const {
        { int t_ = threadIdx.x; asm volatile("" : "+v"(t_)); fr = t_ & 15; fq = (t_ >> 4) & 3; }
        const int pn = u.pn, seg = u.pm % 17; const bool lat = seg < 16;
        bf16_t* base = P + (size_t)(u.pm * 256 + wr * 64 + fr) * INW + 256 * pn + 64 * wc + 8 * fq;
        if (pn >= 18) {
#pragma unroll
            for (int ai = 0; ai < 2; ++ai)
#pragma unroll
                for (int m = 0; m < 4; ++m)
#pragma unroll
                    for (int bj = 0; bj < 2; ++bj) { f32x4 v0 = acc[ai][bj][m][0], v1 = acc[ai][bj][m][1];
#pragma unroll
                        for (int e = 0; e < 4; ++e) { v0[e] = sigmoidf_(v0[e]); v1[e] = sigmoidf_(v1[e]); }
                        *(u32x4*)(base + (size_t)(ai * 128 + m * 16) * INW + 32 * bj) = pack8(v0, v1); }
            return;
        }
        const bool donorm = (pn >= 4 && pn < 8) || pn == 16, dorope = lat && (pn < 12 || pn == 16);
        const float osc = pn < 8 ? c2 : 1.f;
        f32x4 gv[2][2];
#pragma unroll
        for (int bj = 0; bj < 2; ++bj)
#pragma unroll
            for (int n = 0; n < 2; ++n) gv[bj][n] = donorm ? *(const f32x4*)((pn == 16 ? kg : qg) + 32 * bj + 8 * fq + 4 * n) : (f32x4){1.f, 1.f, 1.f, 1.f};
        f32x4 tr[2][2], tc[4][2];
#pragma unroll
        for (int n = 0; n < 2; ++n) {
#pragma unroll
            for (int ai = 0; ai < 2; ++ai) tr[ai][n] = dorope ? *(const f32x4*)(tab + ((4 * seg + 2 * ai + wr) * 16 + 4 * fq + 2 * n) * 2) : (f32x4){1.f, 0.f, 1.f, 0.f};
#pragma unroll
            for (int m = 0; m < 4; ++m) tc[m][n] = dorope ? *(const f32x4*)(tab + ((16 * m + fr) * 16 + 4 * fq + 2 * n) * 2) : (f32x4){1.f, 0.f, 1.f, 0.f};
        }
#pragma unroll
        for (int ai = 0; ai < 2; ++ai)
#pragma unroll
            for (int m = 0; m < 4; ++m) {
                f32x4 v[2][2];
#pragma unroll
                for (int bj = 0; bj < 2; ++bj)
#pragma unroll
                    for (int n = 0; n < 2; ++n) v[bj][n] = acc[ai][bj][m][n];
                if (donorm) {
                    float ss = 0.f;
#pragma unroll
                    for (int bj = 0; bj < 2; ++bj)
#pragma unroll
                        for (int n = 0; n < 2; ++n) ss += (v[bj][n][0] * v[bj][n][0] + v[bj][n][1] * v[bj][n][1]) + (v[bj][n][2] * v[bj][n][2] + v[bj][n][3] * v[bj][n][3]);
                    { const int ln = fq * 16 + fr; ss += __builtin_bit_cast(float, __builtin_amdgcn_ds_bpermute((ln ^ 16) << 2, __builtin_bit_cast(int, ss))); ss += __builtin_bit_cast(float, __builtin_amdgcn_ds_bpermute((ln ^ 32) << 2, __builtin_bit_cast(int, ss))); }
                    const float rs = 1.f / sqrtf(ss * (1.f / 64.f) + EPS);
#pragma unroll
                    for (int bj = 0; bj < 2; ++bj)
#pragma unroll
                        for (int n = 0; n < 2; ++n) v[bj][n] = v[bj][n] * rs * gv[bj][n];
                }
#pragma unroll
                for (int bj = 0; bj < 2; ++bj) {
#pragma unroll
                    for (int n = 0; n < 2; ++n) { const f32x4 t = bj == 0 ? tr[ai][n] : tc[m][n]; const f32x4 x = v[bj][n];
                        v[bj][n] = (f32x4){(x[0] * t[0] - x[1] * t[1]) * osc, (x[0] * t[1] + x[1] * t[0]) * osc, (x[2] * t[2] - x[3] * t[3]) * osc, (x[2] * t[3] + x[3] * t[2]) * osc}; }
                    *(u32x4*)(base + (size_t)(ai * 128 + m * 16) * INW + 32 * bj) = pack8(v[bj][0], v[bj][1]);
                }
            }
    }
};
struct EpiGate {
    static constexpr bool PERM = true, AFTER_DRAIN = false;
    bf16_t* Mx; const bf16_t* G; int accum;
    __device__ __forceinline__ void operator()(const f32x4 (&acc)[2][2][4][2], const Unit& u, int wr, int wc, int fr, int fq) const {
        { int t_ = threadIdx.x; asm volatile("" : "+v"(t_)); fr = t_ & 15; fq = (t_ >> 4) & 3; }
        const int row0 = u.pm * 256 + wr * 64 + fr, col0 = u.pn * 256 + wc * 32 + 8 * fq;
#pragma unroll
        for (int ai = 0; ai < 2; ++ai)
#pragma unroll
            for (int m = 0; m < 4; ++m) { const size_t row = (size_t)(row0 + ai * 128 + m * 16);
#pragma unroll
                for (int bj = 0; bj < 2; ++bj) { const int col = col0 + 128 * bj;
                    f32x4 g0, g1; unpack8(*(const u32x4*)(G + row * INW + col), g0, g1);
                    f32x4 v0 = acc[ai][bj][m][0] * g0, v1 = acc[ai][bj][m][1] * g1;
                    if (accum) { f32x4 o0, o1; unpack8(*(const u32x4*)(Mx + row * DM + col), o0, o1); v0 = v0 + o0; v1 = v1 + o1; }
                    *(u32x4*)(Mx + row * DM + col) = pack8(v0, v1); } }
    }
};
struct EpiResid {
    static constexpr bool PERM = true, AFTER_DRAIN = false;
    const float* XoL; const float* XoC; float* XnL; float* XnC; const float* mod;
    __device__ __forceinline__ void operator()(const f32x4 (&acc)[2][2][4][2], const Unit& u, int wr, int wc, int fr, int fq) const {
        { int t_ = threadIdx.x; asm volatile("" : "+v"(t_)); fr = t_ & 15; fq = (t_ >> 4) & 3; }
        const int b = u.pm / 17, seg = u.pm - b * 17; const bool lat = seg < 16;
        const size_t rb = (lat ? (size_t)(b * SEQ + seg * 256) : (size_t)(b * CTXL)) + wr * 64 + fr;
        const float* xo = lat ? XoL : XoC; float* xn = lat ? XnL : XnC;
        const int col0 = u.pn * 256 + wc * 32 + 8 * fq; const float* gp = mod + (lat ? b : 4) * 6144 + col0;
        f32x4 gt[2][2];
#pragma unroll
        for (int bj = 0; bj < 2; ++bj)
#pragma unroll
            for (int n = 0; n < 2; ++n) gt[bj][n] = *(const f32x4*)(gp + 128 * bj + 4 * n);
#pragma unroll
        for (int ai = 0; ai < 2; ++ai)
#pragma unroll
            for (int m = 0; m < 4; ++m) { const size_t ro = (rb + ai * 128 + m * 16) * DM + col0;
#pragma unroll
                for (int bj = 0; bj < 2; ++bj)
#pragma unroll
                    for (int n = 0; n < 2; ++n) { const f32x4 o = *(const f32x4*)(xo + ro + 128 * bj + 4 * n); *(f32x4*)(xn + ro + 128 * bj + 4 * n) = o + gt[bj][n] * acc[ai][bj][m][n]; } }
    }
};
struct EpiSwiGLU {
    static constexpr bool PERM = true, AFTER_DRAIN = false;
    bf16_t* U; int ldu;
    __device__ __forceinline__ void operator()(const f32x4 (&acc)[2][2][4][2], const Unit& u, int wr, int wc, int fr, int fq) const {
        { int t_ = threadIdx.x; asm volatile("" : "+v"(t_)); fr = t_ & 15; fq = (t_ >> 4) & 3; }
        bf16_t* base = U + (size_t)(u.pm * 256 + wr * 64 + fr) * ldu + u.pn * 128 + wc * 32 + 8 * fq;
#pragma unroll
        for (int ai = 0; ai < 2; ++ai)
#pragma unroll
            for (int m = 0; m < 4; ++m) { f32x4 r[2];
#pragma unroll
                for (int n = 0; n < 2; ++n) { const f32x4 a = acc[ai][0][m][n], b = acc[ai][1][m][n];
#pragma unroll
                    for (int e = 0; e < 4; ++e) r[n][e] = a[e] * sigmoidf_(a[e]) * b[e]; }
                *(u32x4*)(base + (size_t)(ai * 128 + m * 16) * ldu) = pack8(r[0], r[1]); }
    }
};
struct EpiPlain {
    static constexpr bool PERM = true, AFTER_DRAIN = false;
    bf16_t* Y; int ldy;
    __device__ __forceinline__ void operator()(const f32x4 (&acc)[2][2][4][2], const Unit& u, int wr, int wc, int fr, int fq) const {
        { int t_ = threadIdx.x; asm volatile("" : "+v"(t_)); fr = t_ & 15; fq = (t_ >> 4) & 3; }
        bf16_t* base = Y + (size_t)(u.pm * 256 + wr * 64 + fr) * ldy + u.pn * 256 + wc * 32 + 8 * fq;
#pragma unroll
        for (int ai = 0; ai < 2; ++ai)
#pragma unroll
            for (int m = 0; m < 4; ++m)
#pragma unroll
                for (int bj = 0; bj < 2; ++bj) *(u32x4*)(base + (size_t)(ai * 128 + m * 16) * ldy + 128 * bj) = pack8(acc[ai][bj][m][0], acc[ai][bj][m][1]);
    }
};

struct EpiSlab {
    static constexpr bool PERM = true, AFTER_DRAIN = false;
    float* slab;
    __device__ __forceinline__ void operator()(const f32x4 (&acc)[2][2][4][2], const Unit& u, int wr, int wc, int fr, int fq) const {
        { int t_ = threadIdx.x; asm volatile("" : "+v"(t_)); fr = t_ & 15; fq = (t_ >> 4) & 3; }
        float* base = slab + (size_t)u.sl * 65536 + (wr * 64 + fr) * 256 + wc * 32 + 8 * fq;
#pragma unroll
        for (int ai = 0; ai < 2; ++ai)
#pragma unroll
            for (int m = 0; m < 4; ++m)
#pragma unroll
                for (int bj = 0; bj < 2; ++bj)
#pragma unroll
                    for (int n = 0; n < 2; ++n) *(f32x4*)(base + (ai * 128 + m * 16) * 256 + 128 * bj + 4 * n) = acc[ai][bj][m][n];
    }
};

template <class Epi, class Sched, bool ALIGN_EPI = false, bool SP2 = false>
__device__ __forceinline__ void gemm_phase(PG8_LAS unsigned char* lds, const Gemm g, const Sched& S, const Epi& E) {
    int tid_ = threadIdx.x; asm volatile("" : "+v"(tid_));
    const int tid = tid_, wid = __builtin_amdgcn_readfirstlane(tid >> 6), lane = tid & 63, wr = wid >> 2, wc = wid & 3, fr = lane & 15, fq = lane >> 4;
    const int K = g.K, nt = K / BK, lda = g.lda, ldb = g.ldb;
    unsigned voffA[2], voffB[2];
#pragma unroll
    for (int i = 0; i < 2; ++i) { int R, C; stage_rc(tid * 16 + i * 8192, R, C); const int Rb = Epi::PERM ? ((R & ~31) + perm32(R & 31)) : R;
        voffA[i] = (unsigned)(R * lda + C) * 2u; voffB[i] = (unsigned)(Rb * ldb + C) * 2u; }
    const size_t kstep = (size_t)(BK * 2);
    const size_t hstepA = (size_t)HALF * lda * 2, hstepB = (size_t)HALF * ldb * 2;
    const size_t tstepA = 2 * hstepA, tstepB = 2 * hstepB;
    const unsigned ldsw = (unsigned)wid * 1024u;
    const int aoff = lds_byte(wr * 64 + fr, fq * 8), boff = lds_byte(wc * 32 + fr, fq * 8);
#define PG8_SA(b, h) (((b) * 2 + (h)) * HTB)
#define PG8_SB(b, h) ((4 + (b) * 2 + (h)) * HTB)
#define PG8_STAGE(bufoff, gbase, voff) do { _Pragma("unroll") for (int _i = 0; _i < 2; ++_i) \
        __builtin_amdgcn_global_load_lds((const unsigned*)((const char*)(gbase) + (voff)[_i]), (PG8_LAS unsigned*)(lds + (bufoff) + ldsw + _i * 8192), 16, 0, 0); } while (0)
#define PG8_LDA(dst, b, h) do { _Pragma("unroll") for (int m = 0; m < 4; ++m) _Pragma("unroll") for (int k = 0; k < 2; ++k) dst[m][k] = *(const PG8_LAS bf16x8*)(lds + PG8_SA(b, h) + aoff + m * 2048 + k * 1024); } while (0)
#define PG8_LDB(dst, b, h) do { _Pragma("unroll") for (int n = 0; n < 2; ++n) _Pragma("unroll") for (int k = 0; k < 2; ++k) dst[n][k] = *(const PG8_LAS bf16x8*)(lds + PG8_SB(b, h) + boff + n * 2048 + k * 1024); } while (0)
#define PG8_MMA(ai, bj, At, Bt) do { __builtin_amdgcn_s_setprio(1); _Pragma("unroll") for (int m = 0; m < 4; ++m) _Pragma("unroll") for (int n = 0; n < 2; ++n) _Pragma("unroll") for (int k = 0; k < 2; ++k) \
        acc[ai][bj][m][n] = __builtin_amdgcn_mfma_f32_16x16x32_bf16(Bt[n][k], At[m][k], acc[ai][bj][m][n], 0, 0, 0); __builtin_amdgcn_s_setprio(0); } while (0)
#define PG8_WAIT_V(n) asm volatile("s_waitcnt vmcnt(" #n ")" ::: "memory")
#define PG8_WAIT_L(n) asm volatile("s_waitcnt lgkmcnt(" #n ")" ::: "memory")
#define PG8_BAR __builtin_amdgcn_s_barrier()
#define PG8_SCHED __builtin_amdgcn_sched_barrier(0)
    Unit cur, nxt; int ui = 0;
    if (!S.next(0, cur)) return;
    f32x4 acc[2][2][4][2];
#pragma unroll
    for (int a = 0; a < 2; ++a)
#pragma unroll
        for (int b = 0; b < 2; ++b)
#pragma unroll
            for (int m = 0; m < 4; ++m)
#pragma unroll
                for (int n = 0; n < 2; ++n) acc[a][b][m][n] = (f32x4){0.f, 0.f, 0.f, 0.f};
    bf16x8 At[4][2], B0[2][2], B1[2][2];
    const char* cA = (const char*)g.A + (size_t)cur.pm * tstepA + (size_t)cur.koff * 2; const char* cB = (const char*)g.Bt + (size_t)cur.e * g.bstride + (size_t)cur.pn * tstepB + (size_t)cur.koff * 2;
    S.a_ready(cur);
    if constexpr (SP2) {
        PG8_STAGE(PG8_SB(0, 0), cB, voffB); PG8_STAGE(PG8_SB(0, 1), cB + hstepB, voffB); PG8_STAGE(PG8_SA(0, 0), cA, voffA); PG8_STAGE(PG8_SA(0, 1), cA + hstepA, voffA);
        if (wr == 1) PG8_BAR;
        PG8_WAIT_V(2); PG8_BAR;
        PG8_STAGE(PG8_SB(1, 0), cB + kstep, voffB); PG8_STAGE(PG8_SA(1, 0), cA + kstep, voffA); PG8_STAGE(PG8_SB(1, 1), cB + hstepB + kstep, voffB);
        PG8_WAIT_V(6); PG8_BAR;
    } else {
        PG8_STAGE(PG8_SB(0, 0), cB, voffB); PG8_STAGE(PG8_SA(0, 0), cA, voffA); PG8_STAGE(PG8_SB(0, 1), cB + hstepB, voffB); PG8_STAGE(PG8_SA(0, 1), cA + hstepA, voffA);
        if (wr == 1) PG8_BAR;
        PG8_WAIT_V(4); PG8_BAR;
        PG8_STAGE(PG8_SB(1, 0), cB + kstep, voffB); PG8_STAGE(PG8_SA(1, 0), cA + kstep, voffA); PG8_STAGE(PG8_SB(1, 1), cB + hstepB + kstep, voffB);
        PG8_WAIT_V(6); PG8_BAR;
    }
    for (;;) {
        const bool has_next = S.next(ui + 1, nxt);
        const char* nA = has_next ? (const char*)g.A + (size_t)nxt.pm * tstepA + (size_t)nxt.koff * 2 : cA; const char* nB = has_next ? (const char*)g.Bt + (size_t)nxt.e * g.bstride + (size_t)nxt.pn * tstepB + (size_t)nxt.koff * 2 : cB;
        for (int t = 0; t < nt; t += 2) {
            const bool last = (t == nt - 2);
            const char* a1 = cA + (size_t)(t + 1) * kstep;
            const char* a2 = last ? nA : cA + (size_t)(t + 2) * kstep; const char* b2 = last ? nB : cB + (size_t)(t + 2) * kstep;
            const char* a3 = a2 + kstep; const char* b3 = b2 + kstep;
            if (last && has_next) S.a_ready(nxt);
            if constexpr (SP2) {
            PG8_LDB(B0, 0, 0); PG8_LDB(B1, 0, 1); PG8_SCHED; PG8_LDA(At, 0, 0); PG8_STAGE(PG8_SA(1, 1), a1 + hstepA, voffA);
            PG8_WAIT_V(8); PG8_WAIT_L(0); PG8_BAR; PG8_MMA(0, 0, At, B0); PG8_MMA(0, 1, At, B1); PG8_BAR; PG8_SCHED;
            PG8_LDA(At, 0, 1); PG8_STAGE(PG8_SB(0, 0), b2, voffB); PG8_STAGE(PG8_SB(0, 1), b2 + hstepB, voffB); PG8_STAGE(PG8_SA(0, 0), a2, voffA);
            PG8_WAIT_V(8); PG8_WAIT_L(0); PG8_BAR; PG8_MMA(1, 0, At, B0); PG8_MMA(1, 1, At, B1); PG8_BAR; PG8_SCHED;
            PG8_LDB(B0, 1, 0); PG8_LDB(B1, 1, 1); PG8_SCHED; PG8_LDA(At, 1, 0); PG8_STAGE(PG8_SA(0, 1), a2 + hstepA, voffA);
            PG8_WAIT_V(8); PG8_WAIT_L(0); PG8_BAR; PG8_MMA(0, 0, At, B0); PG8_MMA(0, 1, At, B1); PG8_BAR; PG8_SCHED;
            PG8_LDA(At, 1, 1); PG8_STAGE(PG8_SB(1, 0), b3, voffB); PG8_STAGE(PG8_SB(1, 1), b3 + hstepB, voffB); PG8_STAGE(PG8_SA(1, 0), a3, voffA);
            PG8_WAIT_V(8); PG8_WAIT_L(0); PG8_BAR; PG8_MMA(1, 0, At, B0); PG8_MMA(1, 1, At, B1); PG8_BAR; PG8_SCHED;
            } else {
            PG8_LDB(B0, 0, 0); PG8_SCHED; PG8_LDA(At, 0, 0); PG8_STAGE(PG8_SA(1, 1), a1 + hstepA, voffA);
            PG8_WAIT_L(8); PG8_BAR; PG8_WAIT_L(0); PG8_MMA(0, 0, At, B0); PG8_BAR; PG8_SCHED;
            PG8_LDB(B1, 0, 1); PG8_STAGE(PG8_SB(0, 0), b2, voffB);
            PG8_BAR; PG8_WAIT_L(0); PG8_MMA(0, 1, At, B1); PG8_BAR;
            PG8_LDA(At, 0, 1); PG8_STAGE(PG8_SA(0, 0), a2, voffA);
            PG8_BAR; PG8_WAIT_L(0); PG8_MMA(1, 0, At, B0); PG8_BAR; PG8_SCHED;
            PG8_STAGE(PG8_SB(0, 1), b2 + hstepB, voffB);
            PG8_WAIT_V(6); PG8_BAR; PG8_MMA(1, 1, At, B1); PG8_BAR;
            PG8_LDB(B0, 1, 0); PG8_SCHED; PG8_LDA(At, 1, 0); PG8_STAGE(PG8_SA(0, 1), a2 + hstepA, voffA);
            PG8_WAIT_L(8); PG8_BAR; PG8_WAIT_L(0); PG8_MMA(0, 0, At, B0); PG8_BAR; PG8_SCHED;
            PG8_LDB(B1, 1, 1); PG8_STAGE(PG8_SB(1, 0), b3, voffB);
            PG8_BAR; PG8_WAIT_L(0); PG8_MMA(0, 1, At, B1); PG8_BAR;
            PG8_LDA(At, 1, 1); PG8_STAGE(PG8_SA(1, 0), a3, voffA);
            PG8_BAR; PG8_WAIT_L(0); PG8_MMA(1, 0, At, B0); PG8_BAR; PG8_SCHED;
            PG8_STAGE(PG8_SB(1, 1), b3 + hstepB, voffB);
            PG8_WAIT_V(6); PG8_BAR; PG8_MMA(1, 1, At, B1); PG8_BAR;
            }
        }
        if constexpr (ALIGN_EPI) { if (wr == 0) PG8_BAR; }
        if constexpr (!Epi::AFTER_DRAIN) { E(acc, cur, wr, wc, fr, fq); S.done(cur); }
        if (!has_next) break;
#pragma unroll
        for (int a = 0; a < 2; ++a)
#pragma unroll
            for (int b = 0; b < 2; ++b)
#pragma unroll
                for (int m = 0; m < 4; ++m)
#pragma unroll
                    for (int n = 0; n < 2; ++n) acc[a][b][m][n] = (f32x4){0.f, 0.f, 0.f, 0.f};
        cur = nxt; cA = nA; cB = nB; ++ui;
        if constexpr (ALIGN_EPI) { if (wr == 1) PG8_BAR; }
    }
    PG8_WAIT_V(0);
    if constexpr (!ALIGN_EPI) { if (wr == 0) PG8_BAR; }
    PG8_BAR;
    if constexpr (Epi::AFTER_DRAIN) { E.fused(acc, cur, wr, wc, fr, fq, lds, wid, lane); S.done(cur); }
#undef PG8_SA
#undef PG8_SB
#undef PG8_STAGE
#undef PG8_LDA
#undef PG8_LDB
#undef PG8_MMA
#undef PG8_WAIT_V
#undef PG8_WAIT_L
#undef PG8_BAR
#undef PG8_SCHED
}
}

#include <hip/hip_bf16.h>
#include <cmath>
namespace attn_body {
using bf16=__hip_bfloat16;
using bf16x8=__attribute__((ext_vector_type(8)))short;
using s16x4=__attribute__((ext_vector_type(4)))short;
using f32x16=__attribute__((ext_vector_type(16)))float;
using u32x4=__attribute__((ext_vector_type(4)))unsigned;
constexpr int D=64;
constexpr int NW=8,QBLK=32,QB=QBLK*NW,KVBLK=64;
__device__ __forceinline__ int crow(int r,int hi){return (r&3)+8*(r>>2)+4*hi;}
#define SBAR() __builtin_amdgcn_sched_barrier(0)
constexpr int NSLOT=3, SLOTB=8192;
constexpr int LDS_K=0, LDS_V=NSLOT*SLOTB, LDS_WS=2*NSLOT*SLOTB, LDS_OST=LDS_WS+NW*64*4, LDS_BYTES=LDS_OST+NW*4096;
constexpr int VSLOTB=16384, LDS_V2=NSLOT*SLOTB, LDS_WS2=LDS_V2+NSLOT*VSLOTB, LDS_OST2=LDS_WS2+NW*64*4, LDS_BYTES2=LDS_OST2+NW*4096;
constexpr float C2=0.125f*1.4426950408889634f;
__device__ __forceinline__ void glds16(const void*gsrc,unsigned lds_dst){unsigned keep;
  asm volatile("s_mov_b32 %0, m0\n\ts_mov_b32 m0, %2\n\ts_nop 0\n\tglobal_load_lds_dwordx4 %1, off\n\ts_mov_b32 m0, %0":"=&s"(keep):"v"(gsrc),"s"(lds_dst):"memory");}
__device__ __forceinline__ float max3f(float a,float b,float c){float r;asm("v_max3_f32 %0, %1, %2, %3":"=v"(r):"v"(a),"v"(b),"v"(c));return r;}
__device__ __forceinline__ float max2f(float a,float b){float r;asm("v_max_f32_e32 %0, %1, %2":"=v"(r):"v"(a),"v"(b));return r;}
__device__ __forceinline__ float fadd_s(float a,float b){float r;asm("v_add_f32_e32 %0, %1, %2":"=v"(r):"v"(a),"v"(b));return r;}
__device__ __forceinline__ float fsub_s(float a,float b){float r;asm("v_sub_f32_e32 %0, %1, %2":"=v"(r):"v"(a),"v"(b));return r;}
typedef float f32x2_t __attribute__((ext_vector_type(2))); typedef __bf16 bf16x2_t __attribute__((ext_vector_type(2)));
__device__ __forceinline__ unsigned cvtpk_s(float lo,float hi){f32x2_t v={lo,hi};bf16x2_t b=__builtin_convertvector(v,bf16x2_t);return __builtin_bit_cast(unsigned,b);}
#define WAIT_BAR(N) asm volatile("s_waitcnt vmcnt(" #N ") lgkmcnt(0)\n\ts_barrier":::"memory")

__device__ __forceinline__ void qkt(f32x16&p0,f32x16&p1,const char*Kslot,const bf16x8*qr,const f32x16&negm,int r32,int hi){
  const char*kb=Kslot+hi*1024+r32*16;
  #pragma unroll
  for(int d0=0;d0<4;++d0){
    const bf16x8 b0=*reinterpret_cast<const bf16x8*>(kb+d0*2048);
    const bf16x8 b1=*reinterpret_cast<const bf16x8*>(kb+d0*2048+512);
    if(d0==0){p0=__builtin_amdgcn_mfma_f32_32x32x16_bf16(b0,qr[0],negm,0,0,0);p1=__builtin_amdgcn_mfma_f32_32x32x16_bf16(b1,qr[0],negm,0,0,0);}
    else{p0=__builtin_amdgcn_mfma_f32_32x32x16_bf16(b0,qr[d0],p0,0,0,0);p1=__builtin_amdgcn_mfma_f32_32x32x16_bf16(b1,qr[d0],p1,0,0,0);}}
}
typedef __attribute__((address_space(3))) const char* lds_cptr;
typedef short v4i16_t __attribute__((ext_vector_type(4)));
__device__ __forceinline__ void kload8(bf16x8*kf,lds_cptr kp){
  kf[0]=*(const __attribute__((address_space(3))) bf16x8*)(kp);      kf[1]=*(const __attribute__((address_space(3))) bf16x8*)(kp+512);
  kf[2]=*(const __attribute__((address_space(3))) bf16x8*)(kp+2048); kf[3]=*(const __attribute__((address_space(3))) bf16x8*)(kp+2560);
  kf[4]=*(const __attribute__((address_space(3))) bf16x8*)(kp+4096); kf[5]=*(const __attribute__((address_space(3))) bf16x8*)(kp+4608);
  kf[6]=*(const __attribute__((address_space(3))) bf16x8*)(kp+6144); kf[7]=*(const __attribute__((address_space(3))) bf16x8*)(kp+6656);
}
__device__ __forceinline__ void kload2(bf16x8*kf,lds_cptr kp,int j){ kf[2*j]=*(const __attribute__((address_space(3))) bf16x8*)(kp+j*2048); kf[2*j+1]=*(const __attribute__((address_space(3))) bf16x8*)(kp+j*2048+512); }
__device__ __forceinline__ s16x4 vtr(lds_cptr p){ return __builtin_bit_cast(s16x4,__builtin_amdgcn_ds_read_tr16_b64_v4i16((__attribute__((address_space(3))) v4i16_t*)p)); }
__device__ __forceinline__ float rowmax(const f32x16&p0,const f32x16&p1){
  float a=max3f(p0[0],p0[1],p1[0]),b=max3f(p0[2],p0[3],p1[1]);a=max3f(a,p1[2],p1[3]);
  #pragma unroll
  for(int r=4;r<16;r+=4){a=max3f(a,p0[r],p0[r+1]);b=max3f(b,p0[r+2],p0[r+3]);a=max3f(a,p1[r],p1[r+1]);b=max3f(b,p1[r+2],p1[r+3]);}
  const float m=max2f(a,b);
  auto rr=__builtin_amdgcn_permlane32_swap(__float_as_uint(m),__float_as_uint(m),false,false);
  return max2f(__uint_as_float(rr[0]),__uint_as_float(rr[1]));
}
__device__ __forceinline__ void pv(f32x16*o,int vb,bf16x8 pa0,bf16x8 pa1,bf16x8 pa2,bf16x8 pa3){
  #pragma unroll
  for(int d0=0;d0<2;++d0){s16x4 lo[4],hi[4];
    #pragma unroll
    for(int ks=0;ks<4;++ks){
      asm volatile("ds_read_b64_tr_b16 %0,%1 offset:%c2":"=&v"(lo[ks]):"v"(vb),"i"(d0*4096+ks*1024):"memory");
      asm volatile("ds_read_b64_tr_b16 %0,%1 offset:%c2":"=&v"(hi[ks]):"v"(vb),"i"(d0*4096+ks*1024+512):"memory");}
    asm volatile("s_waitcnt lgkmcnt(0)":::"memory");SBAR();
    #define PK(k) (bf16x8){lo[k][0],lo[k][1],lo[k][2],lo[k][3],hi[k][0],hi[k][1],hi[k][2],hi[k][3]}
    o[d0]=__builtin_amdgcn_mfma_f32_32x32x16_bf16(pa0,PK(0),o[d0],0,0,0);
    o[d0]=__builtin_amdgcn_mfma_f32_32x32x16_bf16(pa1,PK(1),o[d0],0,0,0);
    o[d0]=__builtin_amdgcn_mfma_f32_32x32x16_bf16(pa2,PK(2),o[d0],0,0,0);
    o[d0]=__builtin_amdgcn_mfma_f32_32x32x16_bf16(pa3,PK(3),o[d0],0,0,0);
    #undef PK
  }
}

__device__ __forceinline__ void pv4(f32x16*o,int vb,bf16x8 pa0,bf16x8 pa1,bf16x8 pa2,bf16x8 pa3){
  #pragma unroll
  for(int d0=0;d0<4;++d0){s16x4 lo[4],hi[4];
    #pragma unroll
    for(int ks=0;ks<4;++ks){
      asm volatile("ds_read_b64_tr_b16 %0,%1 offset:%c2":"=&v"(lo[ks]):"v"(vb),"i"(d0*4096+ks*1024):"memory");
      asm volatile("ds_read_b64_tr_b16 %0,%1 offset:%c2":"=&v"(hi[ks]):"v"(vb),"i"(d0*4096+ks*1024+512):"memory");}
    asm volatile("s_waitcnt lgkmcnt(0)":::"memory");SBAR();
    #define PK(k) (bf16x8){lo[k][0],lo[k][1],lo[k][2],lo[k][3],hi[k][0],hi[k][1],hi[k][2],hi[k][3]}
    o[d0]=__builtin_amdgcn_mfma_f32_32x32x16_bf16(pa0,PK(0),o[d0],0,0,0);
    o[d0]=__builtin_amdgcn_mfma_f32_32x32x16_bf16(pa1,PK(1),o[d0],0,0,0);
    o[d0]=__builtin_amdgcn_mfma_f32_32x32x16_bf16(pa2,PK(2),o[d0],0,0,0);
    o[d0]=__builtin_amdgcn_mfma_f32_32x32x16_bf16(pa3,PK(3),o[d0],0,0,0);
    #undef PK
  }
}

#ifndef ATTN_STORE16
#define ATTN_STORE16(p,v) (*(u32x4*)(p)=(v))
#endif
template<int THRL> __device__ __forceinline__ void attn_unit(const bf16*Q0,int qp,const bf16*__restrict__ K0,int kp,const bf16*__restrict__ V0,int vp,bf16*O0,int op,const int NT,char*shm){
  int tid_=threadIdx.x; asm volatile("":"+v"(tid_)); const int tid=tid_,lane=tid&63,r32=lane&31,hi=lane>>5; const int wid=__builtin_amdgcn_readfirstlane(tid>>6);
  const bf16*Qw=Q0+(long)(wid*QBLK)*qp;
  const bf16*Kh=K0,*Vh=V0;
  const unsigned lds0=(unsigned)(uintptr_t)shm;
  float*wsf=(float*)(shm+LDS_WS)+wid*64;
  const bf16*ksrc=Kh+(long)lane*kp+wid*8;
  const bf16*vsrc=Vh+(long)(16*(wid&3)+(lane>>2))*vp+(wid>>2)*32+(lane&3)*8;
  const unsigned kdst=lds0+LDS_K+wid*1024, vdst=lds0+LDS_V+wid*1024;
  #define DMA_K(t,slot) glds16(ksrc+(long)(t)*KVBLK*kp,(unsigned)__builtin_amdgcn_readfirstlane(kdst+(slot)))
  #define DMA_V(t,slot) glds16(vsrc+(long)(t)*KVBLK*vp,(unsigned)__builtin_amdgcn_readfirstlane(vdst+(slot)))
  const int vb0=(int)(lds0+LDS_V)+((lane>>4)&1)*32+(lane&3)*8+(4*hi+((lane&15)>>2))*64;
  const char*Kbase=shm+LDS_K; bf16x8 kf[8];
  const lds_cptr shm3=(lds_cptr)shm; const lds_cptr kp0=shm3+LDS_K+hi*1024+r32*16; const lds_cptr vp0=shm3+LDS_V+((lane>>4)&1)*32+(lane&3)*8+(4*hi+((lane&15)>>2))*64;
  DMA_K(0,0);DMA_V(0,0);DMA_K(1,SLOTB);
  bf16x8 qr[4];
  #pragma unroll
  for(int d0=0;d0<4;++d0)qr[d0]=*reinterpret_cast<const bf16x8*>(&Qw[(long)r32*qp+d0*16+hi*8]);
  float mhat=0.f,l_reg=0.f;f32x16 o[2];o[0]=f32x16{};o[1]=f32x16{};f32x16 negm=f32x16{};asm volatile("":"+v"(negm));
  #define CMASK(P0,P1,t) do{}while(0)
  bool resc=false;
  #define START(P0,P1) do{ const float rm=rowmax(P0,P1); resc=false; \
    { const float dl=rm; mhat=fadd_s(mhat,dl); \
      _Pragma("unroll") for(int r=0;r<16;++r){P0[r]=fsub_s(P0[r],dl);P1[r]=fsub_s(P1[r],dl);} \
      _Pragma("unroll") for(int r=0;r<16;++r)negm[r]=-mhat; asm volatile("":"+v"(negm)); } \
    _Pragma("unroll") for(int r=0;r<16;++r)P0[r]=__builtin_amdgcn_exp2f(P0[r]); }while(0)
  #define RESC() do{ if(resc){ asm volatile("s_waitcnt lgkmcnt(0)":::"memory"); \
      _Pragma("unroll") for(int d_=0;d_<2;++d_) _Pragma("unroll") for(int r=0;r<16;++r)o[d_][r]*=wsf[crow(r,hi)]; } }while(0)
  f32x16 pA0,pA1,pB0,pB1;
  int sl_prev=0,sl_cur=0,sl_next=SLOTB;
  #define ROT() do{sl_prev=sl_cur;sl_cur=sl_next;sl_next=(sl_next==(NSLOT-1)*SLOTB)?0:sl_next+SLOTB;}while(0)
  DMA_K(2,2*SLOTB);
  WAIT_BAR(3);
  qkt(pA0,pA1,Kbase,qr,negm,r32,hi);asm volatile("s_nop 15\n\ts_nop 7":"+v"(pA0),"+v"(pA1));CMASK(pA0,pA1,0);
  START(pA0,pA1);
  _Pragma("unroll") for(int r=0;r<16;++r)pA1[r]=__builtin_amdgcn_exp2f(pA1[r]);
  WAIT_BAR(0);
  DMA_K(3,0);DMA_V(1,SLOTB);
  ROT();
  kload8(kf,kp0+sl_cur);
  WAIT_BAR(2);
  s16x4 vlo[8],vhi[8]; u32x4 pw0,pw1,pw2,pw3;
  #define PKW(P,B) cvtpk_s(P[B],P[B+1])
  #define PAF(k) __builtin_bit_cast(bf16x8,pw##k)
  #define VFR(i) (bf16x8){vlo[i][0],vlo[i][1],vlo[i][2],vlo[i][3],vhi[i][0],vhi[i][1],vhi[i][2],vhi[i][3]}
  #define PIN(x) asm volatile("":"+v"(x))
  #define MX3(a,b,c) __builtin_fmaxf(__builtin_fmaxf((a),(b)),(c))
  #define GAPA(MF,A0,A1,A2,A3,W0,W1,PW) do{ MF; sacc+=A0; sacc+=A1; sacc+=A2; sacc+=A3; PIN(sacc); W0; W1; PIN(PW); SBAR(); }while(0)
  #define EX(v) __builtin_amdgcn_exp2f(v)
  #define GAPB(MF,X,B) do{ MF; X[B]=EX(X[B]); X[B+1]=EX(X[B+1]); X[B+2]=EX(X[B+2]); X[B+3]=EX(X[B+3]); PIN(X); SBAR(); }while(0)
  #define VRD(i) do{ vlo[i]=vtr(vp_+(((i)>>2)*4096+((i)&3)*1024)); vhi[i]=vtr(vp_+(((i)>>2)*4096+((i)&3)*1024+512)); }while(0)
  #define KRD(G,j) do{ if(G){ kload2(kf,kp0+sl_next,j); SBAR(); } }while(0)
  #define STEP(C0,C1,P0,P1,t,GK,GV,GL) do{ SBAR(); \
    const lds_cptr vp_=vp0+sl_prev; \
    VRD(0); SBAR(); float sacc=(P0[0]+P0[1]); \
    GAPA(C0=__builtin_amdgcn_mfma_f32_32x32x16_bf16(kf[0],qr[0],negm,0,0,0), P0[2],P0[3],P0[4],P0[5],     pw0[0]=PKW(P0,0), pw0[1]=PKW(P0,2), pw0); \
    VRD(4); SBAR(); GAPA(C1=__builtin_amdgcn_mfma_f32_32x32x16_bf16(kf[1],qr[0],negm,0,0,0), P0[6],P0[7],P0[8],P0[9],     pw0[2]=PKW(P0,4), pw0[3]=PKW(P0,6), pw0); \
    VRD(1); SBAR(); GAPA(C0=__builtin_amdgcn_mfma_f32_32x32x16_bf16(kf[2],qr[1],C0,0,0,0),   P0[10],P0[11],P0[12],P0[13], pw1[0]=PKW(P0,8), pw1[1]=PKW(P0,10), pw1); \
    VRD(5); SBAR(); GAPA(C1=__builtin_amdgcn_mfma_f32_32x32x16_bf16(kf[3],qr[1],C1,0,0,0),   P0[14],P0[15],P1[0],P1[1],   pw1[2]=PKW(P0,12),pw1[3]=PKW(P0,14), pw1); \
    VRD(2); SBAR(); GAPA(C0=__builtin_amdgcn_mfma_f32_32x32x16_bf16(kf[4],qr[2],C0,0,0,0),   P1[2],P1[3],P1[4],P1[5],     pw2[0]=PKW(P1,0), pw2[1]=PKW(P1,2), pw2); \
    VRD(6); SBAR(); GAPA(C1=__builtin_amdgcn_mfma_f32_32x32x16_bf16(kf[5],qr[2],C1,0,0,0),   P1[6],P1[7],P1[8],P1[9],     pw2[2]=PKW(P1,4), pw2[3]=PKW(P1,6), pw2); \
    VRD(3); SBAR(); GAPA(C0=__builtin_amdgcn_mfma_f32_32x32x16_bf16(kf[6],qr[3],C0,0,0,0),   P1[10],P1[11],P1[12],P1[13], pw3[0]=PKW(P1,8), pw3[1]=PKW(P1,10), pw3); \
    VRD(7); SBAR(); GAPA(C1=__builtin_amdgcn_mfma_f32_32x32x16_bf16(kf[7],qr[3],C1,0,0,0),   P1[14],P1[15],0.f,0.f,       pw3[2]=PKW(P1,12),pw3[3]=PKW(P1,14), pw3); \
    l_reg+=sacc; \
    if(GK){DMA_K((t)+3,sl_cur);} if(GV){DMA_V((t)+1,sl_next);} \
    CMASK(C0,C1,t); \
    { float a=MX3(C0[0],C0[1],C1[0]),b=MX3(C0[2],C0[3],C1[1]); a=MX3(a,C1[2],C1[3]); \
      _Pragma("unroll") for(int r=4;r<16;r+=4){a=MX3(a,C0[r],C0[r+1]);b=MX3(b,C0[r+2],C0[r+3]);a=MX3(a,C1[r],C1[r+1]);b=MX3(b,C1[r+2],C1[r+3]);} \
      float rm=__builtin_fmaxf(a,b); { auto rr=__builtin_amdgcn_permlane32_swap(__float_as_uint(rm),__float_as_uint(rm),false,false); rm=__builtin_fmaxf(__uint_as_float(rr[0]),__uint_as_float(rr[1])); } \
      resc=false; \
      if(__builtin_expect(__any(rm>(float)THRL),0)){ const float dl=__builtin_fmaxf(rm,0.f); mhat+=dl; \
        _Pragma("unroll") for(int r=0;r<16;++r){C0[r]-=dl;C1[r]-=dl;} \
        _Pragma("unroll") for(int r=0;r<16;++r)negm[r]=-mhat; asm volatile("":"+v"(negm)); \
        const float f=__builtin_amdgcn_exp2f(-dl); l_reg*=f; if(hi==0)wsf[r32]=f; resc=true; } } \
    SBAR(); \
    GAPB(o[0]=__builtin_amdgcn_mfma_f32_32x32x16_bf16(PAF(0),VFR(0),o[0],0,0,0), C0,0); \
    GAPB(o[1]=__builtin_amdgcn_mfma_f32_32x32x16_bf16(PAF(0),VFR(4),o[1],0,0,0), C0,4); \
    KRD(GL,0); GAPB(o[0]=__builtin_amdgcn_mfma_f32_32x32x16_bf16(PAF(1),VFR(1),o[0],0,0,0), C0,8); \
    KRD(GL,1); GAPB(o[1]=__builtin_amdgcn_mfma_f32_32x32x16_bf16(PAF(1),VFR(5),o[1],0,0,0), C0,12); \
    KRD(GL,2); GAPB(o[0]=__builtin_amdgcn_mfma_f32_32x32x16_bf16(PAF(2),VFR(2),o[0],0,0,0), C1,0); \
    KRD(GL,3); GAPB(o[1]=__builtin_amdgcn_mfma_f32_32x32x16_bf16(PAF(2),VFR(6),o[1],0,0,0), C1,4); \
    GAPB(o[0]=__builtin_amdgcn_mfma_f32_32x32x16_bf16(PAF(3),VFR(3),o[0],0,0,0), C1,8); \
    GAPB(o[1]=__builtin_amdgcn_mfma_f32_32x32x16_bf16(PAF(3),VFR(7),o[1],0,0,0), C1,12); \
    }while(0)
  int t=1;
  #undef CMASK
  #define CMASK(P0,P1,t) do{}while(0)
  for(;t+5<NT;t+=2){
    STEP(pB0,pB1,pA0,pA1,t,true,true,true);     WAIT_BAR(2); RESC(); ROT();
    STEP(pA0,pA1,pB0,pB1,t+1,true,true,true);   WAIT_BAR(2); RESC(); ROT();
  }
  #undef CMASK
  #define CMASK(P0,P1,t) do{}while(0)
  #define ENDW(tt) do{ if((tt)+3<NT){WAIT_BAR(2);} else if((tt)+2<NT){WAIT_BAR(1);} else {WAIT_BAR(0);} }while(0)
  for(;t+1<NT;t+=2){
    STEP(pB0,pB1,pA0,pA1,t,(t+3<NT),(t+1<NT),(t+1<NT));       ENDW(t);   RESC(); ROT();
    STEP(pA0,pA1,pB0,pB1,t+1,(t+4<NT),(t+2<NT),(t+2<NT));     ENDW(t+1); RESC(); ROT();
  }
  STEP(pB0,pB1,pA0,pA1,NT-1,false,false,false); RESC();
  { float sacc=pB0[0]+pB0[1]; _Pragma("unroll") for(int r=2;r<16;++r)sacc+=pB0[r]; _Pragma("unroll") for(int r=0;r<16;++r)sacc+=pB1[r]; l_reg+=sacc;
    pw0=(u32x4){PKW(pB0,0),PKW(pB0,2),PKW(pB0,4),PKW(pB0,6)};pw1=(u32x4){PKW(pB0,8),PKW(pB0,10),PKW(pB0,12),PKW(pB0,14)};pw2=(u32x4){PKW(pB1,0),PKW(pB1,2),PKW(pB1,4),PKW(pB1,6)};pw3=(u32x4){PKW(pB1,8),PKW(pB1,10),PKW(pB1,12),PKW(pB1,14)};
    SBAR(); pv(o,vb0+sl_cur,PAF(0),PAF(1),PAF(2),PAF(3)); }
  #undef PKW
  #undef PAF
  #undef VFR
  #undef PIN
  #undef MX3
  #undef GAPA
  #undef GAPB
  #undef EX
  #undef VRD
  #undef KRD
  #undef STEP
  #undef ENDW
  {auto rr=__builtin_amdgcn_permlane32_swap(__float_as_uint(l_reg),__float_as_uint(l_reg),false,false);l_reg=__uint_as_float(rr[0])+__uint_as_float(rr[1]);}
  if(hi==0)wsf[32+r32]=l_reg;asm volatile("s_waitcnt lgkmcnt(0)":::"memory");
  float rli[16];
  #pragma unroll
  for(int r=0;r<16;++r)rli[r]=__builtin_amdgcn_rcpf(wsf[32+crow(r,hi)]);
  bf16*Ow=O0+(long)(wid*QBLK)*op;
  { bf16*stg=(bf16*)(shm+LDS_OST)+wid*2048;
    #pragma unroll
    for(int r=0;r<16;++r){const int orow=crow(r,hi);
      #pragma unroll
      for(int d0=0;d0<2;++d0)stg[orow*64+d0*32+r32]=__float2bfloat16(o[d0][r]*rli[r]);}
    asm volatile("s_waitcnt lgkmcnt(0)":::"memory");
    #pragma unroll
    for(int i=0;i<4;++i){const int row=i*8+(lane>>3),ch=lane&7; const u32x4 v=*(const u32x4*)(stg+row*64+ch*8); ATTN_STORE16(Ow+(long)row*op+ch*8,v);} }
  asm volatile("s_waitcnt lgkmcnt(0)\n\ts_barrier":::"memory");
  #undef DMA_K
  #undef DMA_V
  #undef CMASK
  #undef START
  #undef RESC
  #undef ROT
}
template<int THRL> __device__ __forceinline__ void attn_unit_dv(const bf16*Q0,int qp,const bf16*__restrict__ K0,int kp,const bf16*__restrict__ V0,int vp,bf16*O0,int op,const int NT,char*shm){
  int tid_=threadIdx.x; asm volatile("":"+v"(tid_)); const int tid=tid_,lane=tid&63,r32=lane&31,hi=lane>>5; const int wid=__builtin_amdgcn_readfirstlane(tid>>6);
  const bf16*Qw=Q0+(long)(wid*QBLK)*qp;
  const bf16*Kh=K0,*Vh=V0;
  const unsigned lds0=(unsigned)(uintptr_t)shm;
  float*wsf=(float*)(shm+LDS_WS2)+wid*64;
  const bf16*ksrc=Kh+(long)lane*kp+wid*8;
  const bf16*vsrc=Vh+(long)(16*(wid&3)+(lane>>2))*vp+(wid>>2)*32+(lane&3)*8;
  const unsigned kdst=lds0+LDS_K+wid*1024, vdst=lds0+LDS_V2+wid*1024;
  #define DMA_K(t,slot) glds16(ksrc+(long)(t)*KVBLK*kp,(unsigned)__builtin_amdgcn_readfirstlane(kdst+(slot)))
  #define DMA_V(t,slot) do{ glds16(vsrc+(long)(t)*KVBLK*vp,(unsigned)__builtin_amdgcn_readfirstlane(vdst+2*(slot))); glds16(vsrc+(long)(t)*KVBLK*vp+64,(unsigned)__builtin_amdgcn_readfirstlane(vdst+2*(slot)+8192)); }while(0)
  const int vb0=(int)(lds0+LDS_V2)+((lane>>4)&1)*32+(lane&3)*8+(4*hi+((lane&15)>>2))*64;
  const char*Kbase=shm+LDS_K; bf16x8 kf[8];
  const lds_cptr shm3=(lds_cptr)shm; const lds_cptr kp0=shm3+LDS_K+hi*1024+r32*16; const lds_cptr vp0=shm3+LDS_V2+((lane>>4)&1)*32+(lane&3)*8+(4*hi+((lane&15)>>2))*64;
  DMA_K(0,0);DMA_V(0,0);DMA_K(1,SLOTB);
  bf16x8 qr[4];
  #pragma unroll
  for(int d0=0;d0<4;++d0)qr[d0]=*reinterpret_cast<const bf16x8*>(&Qw[(long)r32*qp+d0*16+hi*8]);
  float mhat=0.f,l_reg=0.f;f32x16 o[4];o[0]=f32x16{};o[1]=f32x16{};o[2]=f32x16{};o[3]=f32x16{};f32x16 negm=f32x16{};asm volatile("":"+v"(negm));
  #define CMASK(P0,P1,t) do{}while(0)
  bool resc=false;
  #define START(P0,P1) do{ const float rm=rowmax(P0,P1); resc=false; \
    { const float dl=rm; mhat=fadd_s(mhat,dl); \
      _Pragma("unroll") for(int r=0;r<16;++r){P0[r]=fsub_s(P0[r],dl);P1[r]=fsub_s(P1[r],dl);} \
      _Pragma("unroll") for(int r=0;r<16;++r)negm[r]=-mhat; asm volatile("":"+v"(negm)); } \
    _Pragma("unroll") for(int r=0;r<16;++r)P0[r]=__builtin_amdgcn_exp2f(P0[r]); }while(0)
  #define RESC() do{ if(resc){ asm volatile("s_waitcnt lgkmcnt(0)":::"memory"); \
      _Pragma("unroll") for(int d_=0;d_<4;++d_) _Pragma("unroll") for(int r=0;r<16;++r)o[d_][r]*=wsf[crow(r,hi)]; } }while(0)
  f32x16 pA0,pA1,pB0,pB1;
  int sl_prev=0,sl_cur=0,sl_next=SLOTB;
  #define ROT() do{sl_prev=sl_cur;sl_cur=sl_next;sl_next=(sl_next==(NSLOT-1)*SLOTB)?0:sl_next+SLOTB;}while(0)
  DMA_K(2,2*SLOTB);
  WAIT_BAR(4);
  qkt(pA0,pA1,Kbase,qr,negm,r32,hi);asm volatile("s_nop 15\n\ts_nop 7":"+v"(pA0),"+v"(pA1));CMASK(pA0,pA1,0);
  START(pA0,pA1);
  _Pragma("unroll") for(int r=0;r<16;++r)pA1[r]=__builtin_amdgcn_exp2f(pA1[r]);
  WAIT_BAR(0);
  DMA_K(3,0);DMA_V(1,SLOTB);
  ROT();
  kload8(kf,kp0+sl_cur);
  WAIT_BAR(3);
  s16x4 vlo[16],vhi[16]; u32x4 pw0,pw1,pw2,pw3;
  #define PKW(P,B) cvtpk_s(P[B],P[B+1])
  #define PAF(k) __builtin_bit_cast(bf16x8,pw##k)
  #define VFR(i) (bf16x8){vlo[i][0],vlo[i][1],vlo[i][2],vlo[i][3],vhi[i][0],vhi[i][1],vhi[i][2],vhi[i][3]}
  #define PIN(x) asm volatile("":"+v"(x))
  #define MX3(a,b,c) __builtin_fmaxf(__builtin_fmaxf((a),(b)),(c))
  #define GAPA(MF,A0,A1,A2,A3,W0,W1,PW) do{ MF; sacc+=A0; sacc+=A1; sacc+=A2; sacc+=A3; PIN(sacc); W0; W1; PIN(PW); SBAR(); }while(0)
  #define EX(v) __builtin_amdgcn_exp2f(v)
  #define GAPB(MF,X,B) do{ MF; X[B]=EX(X[B]); X[B+1]=EX(X[B+1]); PIN(X); SBAR(); }while(0)
  #define VRD(i) do{ vlo[i]=vtr(vp_+(((i)>>2)*4096+((i)&3)*1024)); vhi[i]=vtr(vp_+(((i)>>2)*4096+((i)&3)*1024+512)); }while(0)
  #define KRD(G,j) do{ if(G){ kload2(kf,kp0+sl_next,j); SBAR(); } }while(0)
  #define STEP(C0,C1,P0,P1,t,GK,GV,GL) do{ SBAR(); \
    const lds_cptr vp_=vp0+2*sl_prev; \
    float sacc=(P0[0]+P0[1]); \
    GAPA(C0=__builtin_amdgcn_mfma_f32_32x32x16_bf16(kf[0],qr[0],negm,0,0,0), P0[2],P0[3],P0[4],P0[5],     pw0[0]=PKW(P0,0), pw0[1]=PKW(P0,2), pw0); \
    GAPA(C1=__builtin_amdgcn_mfma_f32_32x32x16_bf16(kf[1],qr[0],negm,0,0,0), P0[6],P0[7],P0[8],P0[9],     pw0[2]=PKW(P0,4), pw0[3]=PKW(P0,6), pw0); \
    GAPA(C0=__builtin_amdgcn_mfma_f32_32x32x16_bf16(kf[2],qr[1],C0,0,0,0),   P0[10],P0[11],P0[12],P0[13], pw1[0]=PKW(P0,8), pw1[1]=PKW(P0,10), pw1); \
    GAPA(C1=__builtin_amdgcn_mfma_f32_32x32x16_bf16(kf[3],qr[1],C1,0,0,0),   P0[14],P0[15],P1[0],P1[1],   pw1[2]=PKW(P0,12),pw1[3]=PKW(P0,14), pw1); \
    VRD(0); SBAR(); GAPA(C0=__builtin_amdgcn_mfma_f32_32x32x16_bf16(kf[4],qr[2],C0,0,0,0),   P1[2],P1[3],P1[4],P1[5],     pw2[0]=PKW(P1,0), pw2[1]=PKW(P1,2), pw2); \
    VRD(4); SBAR(); GAPA(C1=__builtin_amdgcn_mfma_f32_32x32x16_bf16(kf[5],qr[2],C1,0,0,0),   P1[6],P1[7],P1[8],P1[9],     pw2[2]=PKW(P1,4), pw2[3]=PKW(P1,6), pw2); \
    VRD(1); SBAR(); GAPA(C0=__builtin_amdgcn_mfma_f32_32x32x16_bf16(kf[6],qr[3],C0,0,0,0),   P1[10],P1[11],P1[12],P1[13], pw3[0]=PKW(P1,8), pw3[1]=PKW(P1,10), pw3); \
    VRD(5); SBAR(); GAPA(C1=__builtin_amdgcn_mfma_f32_32x32x16_bf16(kf[7],qr[3],C1,0,0,0),   P1[14],P1[15],0.f,0.f,       pw3[2]=PKW(P1,12),pw3[3]=PKW(P1,14), pw3); \
    l_reg+=sacc; \
    if(GK){DMA_K((t)+3,sl_cur);} if(GV){DMA_V((t)+1,sl_next);} \
    CMASK(C0,C1,t); \
    { float a=MX3(C0[0],C0[1],C1[0]),b=MX3(C0[2],C0[3],C1[1]); a=MX3(a,C1[2],C1[3]); \
      _Pragma("unroll") for(int r=4;r<16;r+=4){a=MX3(a,C0[r],C0[r+1]);b=MX3(b,C0[r+2],C0[r+3]);a=MX3(a,C1[r],C1[r+1]);b=MX3(b,C1[r+2],C1[r+3]);} \
      float rm=__builtin_fmaxf(a,b); { auto rr=__builtin_amdgcn_permlane32_swap(__float_as_uint(rm),__float_as_uint(rm),false,false); rm=__builtin_fmaxf(__uint_as_float(rr[0]),__uint_as_float(rr[1])); } \
      resc=false; \
      if(__builtin_expect(__any(rm>(float)THRL),0)){ const float dl=__builtin_fmaxf(rm,0.f); mhat+=dl; \
        _Pragma("unroll") for(int r=0;r<16;++r){C0[r]-=dl;C1[r]-=dl;} \
        _Pragma("unroll") for(int r=0;r<16;++r)negm[r]=-mhat; asm volatile("":"+v"(negm)); \
        const float f=__builtin_amdgcn_exp2f(-dl); l_reg*=f; if(hi==0)wsf[r32]=f; resc=true; } } \
    SBAR(); \
    VRD(2); SBAR(); GAPB(o[0]=__builtin_amdgcn_mfma_f32_32x32x16_bf16(PAF(0),VFR(0),o[0],0,0,0), C0,0); \
    VRD(6); SBAR(); GAPB(o[1]=__builtin_amdgcn_mfma_f32_32x32x16_bf16(PAF(0),VFR(4),o[1],0,0,0), C0,2); \
    VRD(3); SBAR(); GAPB(o[0]=__builtin_amdgcn_mfma_f32_32x32x16_bf16(PAF(1),VFR(1),o[0],0,0,0), C0,4); \
    VRD(7); SBAR(); GAPB(o[1]=__builtin_amdgcn_mfma_f32_32x32x16_bf16(PAF(1),VFR(5),o[1],0,0,0), C0,6); \
    VRD(8); SBAR(); GAPB(o[0]=__builtin_amdgcn_mfma_f32_32x32x16_bf16(PAF(2),VFR(2),o[0],0,0,0), C0,8); \
    VRD(12); SBAR(); GAPB(o[1]=__builtin_amdgcn_mfma_f32_32x32x16_bf16(PAF(2),VFR(6),o[1],0,0,0), C0,10); \
    VRD(9); SBAR(); GAPB(o[0]=__builtin_amdgcn_mfma_f32_32x32x16_bf16(PAF(3),VFR(3),o[0],0,0,0), C0,12); \
    VRD(13); SBAR(); GAPB(o[1]=__builtin_amdgcn_mfma_f32_32x32x16_bf16(PAF(3),VFR(7),o[1],0,0,0), C0,14); \
    VRD(10); SBAR(); GAPB(o[2]=__builtin_amdgcn_mfma_f32_32x32x16_bf16(PAF(0),VFR(8),o[2],0,0,0), C1,0); \
    VRD(14); SBAR(); GAPB(o[3]=__builtin_amdgcn_mfma_f32_32x32x16_bf16(PAF(0),VFR(12),o[3],0,0,0), C1,2); \
    VRD(11); SBAR(); GAPB(o[2]=__builtin_amdgcn_mfma_f32_32x32x16_bf16(PAF(1),VFR(9),o[2],0,0,0), C1,4); \
    VRD(15); SBAR(); GAPB(o[3]=__builtin_amdgcn_mfma_f32_32x32x16_bf16(PAF(1),VFR(13),o[3],0,0,0), C1,6); \
    KRD(GL,0); GAPB(o[2]=__builtin_amdgcn_mfma_f32_32x32x16_bf16(PAF(2),VFR(10),o[2],0,0,0), C1,8); \
    KRD(GL,1); GAPB(o[3]=__builtin_amdgcn_mfma_f32_32x32x16_bf16(PAF(2),VFR(14),o[3],0,0,0), C1,10); \
    KRD(GL,2); GAPB(o[2]=__builtin_amdgcn_mfma_f32_32x32x16_bf16(PAF(3),VFR(11),o[2],0,0,0), C1,12); \
    KRD(GL,3); GAPB(o[3]=__builtin_amdgcn_mfma_f32_32x32x16_bf16(PAF(3),VFR(15),o[3],0,0,0), C1,14); \
    }while(0)
  int t=1;
  #undef CMASK
  #define CMASK(P0,P1,t) do{}while(0)
  for(;t+5<NT;t+=2){
    STEP(pB0,pB1,pA0,pA1,t,true,true,true);     WAIT_BAR(3); RESC(); ROT();
    STEP(pA0,pA1,pB0,pB1,t+1,true,true,true);   WAIT_BAR(3); RESC(); ROT();
  }
  #undef CMASK
  #define CMASK(P0,P1,t) do{}while(0)
  #define ENDW(tt) do{ if((tt)+3<NT){WAIT_BAR(3);} else if((tt)+2<NT){WAIT_BAR(2);} else {WAIT_BAR(0);} }while(0)
  for(;t+1<NT;t+=2){
    STEP(pB0,pB1,pA0,pA1,t,(t+3<NT),(t+1<NT),(t+1<NT));       ENDW(t);   RESC(); ROT();
    STEP(pA0,pA1,pB0,pB1,t+1,(t+4<NT),(t+2<NT),(t+2<NT));     ENDW(t+1); RESC(); ROT();
  }
  STEP(pB0,pB1,pA0,pA1,NT-1,false,false,false); RESC();
  { float sacc=pB0[0]+pB0[1]; _Pragma("unroll") for(int r=2;r<16;++r)sacc+=pB0[r]; _Pragma("unroll") for(int r=0;r<16;++r)sacc+=pB1[r]; l_reg+=sacc;
    pw0=(u32x4){PKW(pB0,0),PKW(pB0,2),PKW(pB0,4),PKW(pB0,6)};pw1=(u32x4){PKW(pB0,8),PKW(pB0,10),PKW(pB0,12),PKW(pB0,14)};pw2=(u32x4){PKW(pB1,0),PKW(pB1,2),PKW(pB1,4),PKW(pB1,6)};pw3=(u32x4){PKW(pB1,8),PKW(pB1,10),PKW(pB1,12),PKW(pB1,14)};
    SBAR(); pv4(o,vb0+2*sl_cur,PAF(0),PAF(1),PAF(2),PAF(3)); }
  #undef PKW
  #undef PAF
  #undef VFR
  #undef PIN
  #undef MX3
  #undef GAPA
  #undef GAPB
  #undef EX
  #undef VRD
  #undef KRD
  #undef STEP
  #undef ENDW
  {auto rr=__builtin_amdgcn_permlane32_swap(__float_as_uint(l_reg),__float_as_uint(l_reg),false,false);l_reg=__uint_as_float(rr[0])+__uint_as_float(rr[1]);}
  if(hi==0)wsf[32+r32]=l_reg;asm volatile("s_waitcnt lgkmcnt(0)":::"memory");
  float rli[16];
  #pragma unroll
  for(int r=0;r<16;++r)rli[r]=__builtin_amdgcn_rcpf(wsf[32+crow(r,hi)]);
  bf16*Ow=O0+(long)(wid*QBLK)*op;
  { bf16*stg=(bf16*)(shm+LDS_OST2)+wid*2048;
    #pragma unroll
    for(int hh=0;hh<2;++hh){
      #pragma unroll
      for(int r=0;r<16;++r){const int orow=crow(r,hi);
        #pragma unroll
        for(int d0=0;d0<2;++d0)stg[orow*64+d0*32+r32]=__float2bfloat16(o[2*hh+d0][r]*rli[r]);}
      asm volatile("s_waitcnt lgkmcnt(0)":::"memory");
      #pragma unroll
      for(int i=0;i<4;++i){const int row=i*8+(lane>>3),ch=lane&7; const u32x4 v=*(const u32x4*)(stg+row*64+ch*8); ATTN_STORE16(Ow+(long)row*op+hh*64+ch*8,v);}
      asm volatile("s_waitcnt lgkmcnt(0)":::"memory"); } }
  asm volatile("s_waitcnt lgkmcnt(0)\n\ts_barrier":::"memory");
  #undef DMA_K
  #undef DMA_V
  #undef CMASK
  #undef START
  #undef RESC
  #undef ROT
}
#undef SBAR
#undef WAIT_BAR
}

constexpr size_t MiB = 1u << 20;
constexpr size_t WS_CTL = 0, CTL_ZERO_BYTES = 1 * MiB;
constexpr size_t WS_MOD = 1 * MiB;
constexpr size_t WS_TAB = 1 * MiB + 256 * 1024;
constexpr size_t WS_LAM = 1 * MiB + 272 * 1024;
constexpr size_t WS_ME = 2 * MiB, WS_MP = 2 * MiB + 128 * 1024, WS_MW = 2 * MiB + 256 * 1024;
constexpr size_t WS_WIN = 4 * MiB;
constexpr size_t WS_WPRJ = 30 * MiB;
constexpr size_t WS_W13 = 42 * MiB;
constexpr size_t WS_W2F = 53 * MiB;
constexpr size_t WS_XC = 60 * MiB;
constexpr size_t WS_H = 64 * MiB;
constexpr size_t WS_P = 98 * MiB;
constexpr size_t WS_OA = 319 * MiB;
constexpr size_t WS_MX = 421 * MiB;
constexpr size_t WS_U = 98 * MiB;
constexpr size_t WS_MW2 = 4 * MiB;
constexpr size_t WS_HS = 98 * MiB;
constexpr size_t WS_U2 = 166 * MiB;
constexpr size_t WS_MW13 = 404 * MiB;
constexpr size_t WS_SLABJ = 192 * MiB;
constexpr size_t WS_SLABM = 64 * MiB;
constexpr size_t WS_END = 516 * MiB;
static_assert(WS_P + (size_t)MEXT * INW * 2 <= WS_OA && WS_OA + (size_t)MEXT * OAW * 2 <= WS_MX && WS_MX + (size_t)MEXT * DM * 2 <= WS_END, "attention-phase map");
static_assert(WS_HS + (size_t)MOE_ROWS * DM * 2 <= WS_U2 && WS_U2 + (size_t)MOE_ROWS * DFE * 2 <= WS_MW13 && WS_MW13 + (size_t)NEXP * 2 * DFE * DM * 2 <= WS_END && WS_MW2 + (size_t)NEXP * DFE * DM * 2 <= WS_XC, "MoE-phase map");
static_assert(WS_SLABJ >= WS_U + (size_t)MEXT * DFF * 2 && WS_SLABJ + (size_t)176 * 65536 * 4 <= WS_OA && WS_SLABM + (size_t)128 * 65536 * 4 <= WS_HS, "slab map");
static_assert(WS_W2F + (size_t)DM * DFF * 2 <= WS_XC && WS_U + (size_t)MEXT * DFF * 2 <= WS_OA && WS_H + (size_t)MEXT * DM * 2 <= WS_P, "dense map");
constexpr int CW_BAR = 4096;
constexpr int CW_MOE = 8192;

constexpr int NWAVES = 8;
constexpr int RING_OFF = 0, RING_BYTES = 131072;
constexpr int LDSCTL_OFF = RING_BYTES, MISC_OFF = LDSCTL_OFF + 320;
constexpr int LDS_BYTES = 147456;
static_assert(MISC_OFF + 128 <= LDS_BYTES, "LDS map");

#define GAS __attribute__((address_space(1)))
#define LAS __attribute__((address_space(3)))
typedef unsigned short bf16;
typedef unsigned v4u __attribute__((ext_vector_type(4)));
typedef float f32x4 __attribute__((ext_vector_type(4)));
typedef short bf16x8 __attribute__((ext_vector_type(8)));
typedef GAS unsigned gu32;
typedef GAS unsigned long long gu64;
#define RLX_AGENT __ATOMIC_RELAXED, __HIP_MEMORY_SCOPE_AGENT
#define LDS_WAIT() asm volatile("s_waitcnt lgkmcnt(0)" ::: "memory")
#define VM_WAIT() asm volatile("s_waitcnt vmcnt(0)" ::: "memory")
__device__ __forceinline__ unsigned long long rt() { return __builtin_amdgcn_s_memrealtime(); }
__device__ __forceinline__ unsigned f2bf(float f) { unsigned u = __builtin_bit_cast(unsigned, f); return (u + 0x7fffu + ((u >> 16) & 1u)) >> 16; }
__device__ __forceinline__ unsigned pk2(float lo, float hi) { return f2bf(lo) | (f2bf(hi) << 16); }

#define XB_TMO      128
#define XB_XCNT(j)  (256  + 64 * (j))
#define XB_XSUB(j)  (1280 + 64 * (j))
#define XB_XGEN(j)  (2304 + 64 * (j))
#define XB_TOP      3328
#define XB_TOPGEN   3392
#define XCD_BAR_WORDS 3456
#define XB_SPIN_CAP (1u << 22)

__device__ __forceinline__ unsigned xb_ld(unsigned* p)              { return __hip_atomic_load(p, __ATOMIC_RELAXED, __HIP_MEMORY_SCOPE_AGENT); }
__device__ __forceinline__ unsigned xb_add(unsigned* p, unsigned v) { return __hip_atomic_fetch_add(p, v, __ATOMIC_RELAXED, __HIP_MEMORY_SCOPE_AGENT); }
__device__ __forceinline__ unsigned xb_xcc_id() { return (unsigned)__builtin_amdgcn_s_getreg((3 << 11) | 20) & 0xFu; }
#define XB_SPIN(cond, bar) do { unsigned _sp = 0; while (cond) { __builtin_amdgcn_s_sleep(1); \
    if ((++_sp & 255u) == 0u) { if (xb_ld(&(bar)[XB_TMO])) break; if (_sp > XB_SPIN_CAP) { atomicAdd(&(bar)[XB_TMO], 1u); break; } } } } while (0)

struct XcdBarrier {
    unsigned* bar; unsigned x;
    volatile LAS unsigned* st;
};

__device__ __forceinline__ XcdBarrier xcd_barrier_post(unsigned* bar, volatile LAS unsigned* st) {
    XcdBarrier b; b.bar = bar; b.x = xb_xcc_id(); b.st = st;
    if (threadIdx.x == 0) (void)xb_add(&bar[XB_XCNT(b.x)], 1u);
    return b;
}
__device__ __forceinline__ void xcd_barrier_complete(unsigned* bar, unsigned x, unsigned& nloc, unsigned& nx) {
    const unsigned G = gridDim.x * gridDim.y * gridDim.z;
    unsigned sum, cnt, mine, sp = 0u;
    for (;;) {
        sum = 0u; cnt = 0u; mine = 0u;
#pragma unroll
        for (unsigned j = 0; j < 16; ++j) { const unsigned c = xb_ld(&bar[XB_XCNT(j)]); sum += c; cnt += (c > 0u) ? 1u : 0u; mine = (j == x) ? c : mine; }
        if (sum == G) break;
        __builtin_amdgcn_s_sleep(1);
        if ((++sp & 255u) == 0u) { if (xb_ld(&bar[XB_TMO])) break; if (sp > XB_SPIN_CAP) { atomicAdd(&bar[XB_TMO], 1u); break; } }
    }
    nloc = mine > 0u ? mine : 1u; nx = cnt > 0u ? cnt : 1u;
}

__device__ __forceinline__ void xcd_barrier(const XcdBarrier& b) {
    asm volatile("s_waitcnt vmcnt(0)" ::: "memory");
    __syncthreads();
    if (threadIdx.x == 0) {
        unsigned* bar = b.bar;
        __builtin_amdgcn_s_waitcnt(0);
        unsigned nloc = b.st[0], nx = b.st[1];
        if (nloc == 0u) { xcd_barrier_complete(bar, b.x, nloc, nx); b.st[0] = nloc; b.st[1] = nx; }
        const unsigned old = xb_add(&bar[XB_XSUB(b.x)], 1u);
        const unsigned gen = old / nloc;
        if (old + 1u == (gen + 1u) * nloc) {
            __builtin_amdgcn_fence(__ATOMIC_RELEASE, "agent");
            asm volatile("s_waitcnt vmcnt(0)" ::: "memory");
            const unsigned og = xb_add(&bar[XB_TOP], 1u);
            const unsigned tg = og / nx;
            if (og + 1u == (tg + 1u) * nx) xb_add(&bar[XB_TOPGEN], 1u);
            else XB_SPIN(xb_ld(&bar[XB_TOPGEN]) == tg, bar);
            __builtin_amdgcn_fence(__ATOMIC_ACQUIRE, "agent");
            xb_add(&bar[XB_XGEN(b.x)], 1u);
            asm volatile("s_waitcnt vmcnt(0)" ::: "memory");
        } else {
            XB_SPIN(xb_ld(&bar[XB_XGEN(b.x)]) == gen, bar);
            __builtin_amdgcn_fence(__ATOMIC_ACQUIRE, "agent");
            asm volatile("s_waitcnt vmcnt(0)" ::: "memory");
        }
    }
    __syncthreads();
}

__device__ __forceinline__ float shx(float v, int mask, int lane) { return __builtin_bit_cast(float, __builtin_amdgcn_ds_bpermute((lane ^ mask) << 2, __builtin_bit_cast(int, v))); }
__device__ __forceinline__ float wave_sum(float v, int lane) {
#pragma unroll
    for (int o = 1; o < 64; o <<= 1) v += shx(v, o, lane);
    return v;
}
__device__ __forceinline__ unsigned pkbf(float lo, float hi) { return pg8::cvt_pk_bf16(lo, hi); }
__device__ __forceinline__ int dst_row0(int mode, int n0) {
    if (mode == 0) return n0;
    if (mode == 1) { const int t = n0 >> 8, blk = (n0 & 255) >> 5, wc = blk >> 1, bj = blk & 1; return (t << 8) + 32 * (4 * bj + wc); }
    const int r = ((n0 >> 7) << 8) + (n0 & 127); return mode == 2 ? r : r + 128;
}
__device__ __forceinline__ void transpose_item(const float* W, int K, int N, bf16* WT, int mode, LAS float* scr, int item, int lane) {
    const int nblk = N / 32, kb = item / nblk, nb = item % nblk, k0 = 64 * kb, n0 = 32 * nb, d0 = dst_row0(mode, n0);
    float tv[32];
#pragma unroll
    for (int i = 0; i < 32; ++i) { const int kk = 2 * i + (lane >> 5); tv[i] = W[(size_t)(k0 + kk) * N + n0 + (lane & 31)]; }
#pragma unroll
    for (int i = 0; i < 32; ++i) { const int kk = 2 * i + (lane >> 5); scr[kk * 33 + (lane & 31)] = tv[i]; }
    LDS_WAIT(); asm volatile("" ::: "memory");
    const int c = lane & 7;
#pragma unroll
    for (int j = 0; j < 4; ++j) { const int n = (lane >> 3) + 8 * j; const LAS float* s = scr + (8 * c) * 33 + n;
        v4u o; o.x = pkbf(s[0 * 33], s[1 * 33]); o.y = pkbf(s[2 * 33], s[3 * 33]); o.z = pkbf(s[4 * 33], s[5 * 33]); o.w = pkbf(s[6 * 33], s[7 * 33]);
        *(GAS v4u*)(WT + (size_t)(d0 + n) * K + k0 + 8 * c) = o; }
    LDS_WAIT(); asm volatile("" ::: "memory");
}
__device__ __forceinline__ void row_load(const float* xrow, int lane, f32x4 (&h)[4]) {
    const GAS f32x4* xr = (const GAS f32x4*)xrow + lane;
#pragma unroll
    for (int j = 0; j < 4; ++j) h[j] = xr[64 * j];
}
__device__ __forceinline__ void norm_mod_apply(f32x4 (&h)[4], const float* g, const float* sh, const float* sc, bf16* orow, int lane) {
    float ss = 0.f;
#pragma unroll
    for (int j = 0; j < 4; ++j) ss += (h[j].x * h[j].x + h[j].y * h[j].y) + (h[j].z * h[j].z + h[j].w * h[j].w);
    const float rs = 1.f / sqrtf(wave_sum(ss, lane) * (1.f / DM) + EPS);
    GAS unsigned long long* o8 = (GAS unsigned long long*)orow + lane;
#pragma unroll
    for (int j = 0; j < 4; ++j) { const f32x4 g4 = ((const GAS f32x4*)g)[lane + 64 * j], s4 = ((const GAS f32x4*)sc)[lane + 64 * j], b4 = ((const GAS f32x4*)sh)[lane + 64 * j];
        h[j] = h[j] * rs * g4 * (s4 + 1.f) + b4;
        o8[64 * j] = (unsigned long long)pkbf(h[j].x, h[j].y) | ((unsigned long long)pkbf(h[j].z, h[j].w) << 32); }
}
struct Args { const float* in[24]; float* out; unsigned char* ws; };
enum { I_X = 0, I_C, I_CTX, I_CCTX, I_ADAW, I_ADAB, I_NAG, I_NFG, I_WIN, I_QNG, I_KNG, I_DLAM, I_SUBG, I_WPD, I_WPG, I_WO, I_FW1, I_FW3, I_FW2, I_ROUTER, I_MW1, I_MW3, I_MW2, I_FNG };

#ifndef REP_ATT
#define REP_ATT 1
#endif
#ifndef REP_GEMM
#define REP_GEMM 1
#endif
#define CAS __attribute__((address_space(4)))
#define PH_BEGIN \
    const CAS Args* ap = (const CAS Args*)__builtin_amdgcn_kernarg_segment_ptr(); asm volatile("" : "+s"(ap)); \
    unsigned char* const ws = (unsigned char*)(GAS unsigned char*)ap->ws; \
    int tid = threadIdx.x; asm volatile("" : "+v"(tid)); \
    const int lane = tid & 63, wave = __builtin_amdgcn_readfirstlane(tid >> 6); \
    const int G = gridDim.x, bx = blockIdx.x, vcu = (G % 8 == 0) ? (bx % 8) * (G / 8) + bx / 8 : bx, gw = vcu * NWAVES + wave, NGW = G * NWAVES; \
    (void)lane; (void)gw; (void)NGW; (void)bx; (void)ws;
#define INP(i) ((const float*)(const GAS float*)ap->in[i])
#define WSP(T, off) ((T*)(ws + (off)))
#define LDSP ((LAS unsigned char*)lds)

__global__ void __launch_bounds__(NWAVES * 64, 2) fwd_kernel(Args args) {
    extern __shared__ __attribute__((aligned(16))) unsigned char lds[];
    for (int u = threadIdx.x; u < (LDS_BYTES - LDSCTL_OFF) / 4; u += NWAVES * 64) ((LAS unsigned*)(LDSP + LDSCTL_OFF))[u] = 0u;
    __syncthreads();
    const XcdBarrier bar = xcd_barrier_post((unsigned*)(args.ws + WS_CTL) + CW_BAR, (volatile LAS unsigned*)(LDSP + MISC_OFF) + 8);
#define GRID_BAR() do { XcdBarrier b_ = bar; asm volatile("" : "+s"(b_.bar), "+s"(b_.x)); b_.bar = (unsigned*)(GAS unsigned*)b_.bar; xcd_barrier(b_); } while (0)

#define D_MOD WSP(float, WS_MOD)
#define D_TAB WSP(float, WS_TAB)
#define D_LAM WSP(float, WS_LAM)
#define D_H WSP(bf16, WS_H)
#define D_P WSP(bf16, WS_P)
#define D_OA WSP(bf16, WS_OA)
#define D_MX WSP(bf16, WS_MX)
#define D_XC WSP(float, WS_XC)
#define D_X ((float*)(GAS float*)ap->out)
#define D_SCR ((LAS float*)(LDSP + RING_OFF + wave * 8448))
#define D_MODL (D_MOD + (size_t)l * 5 * 6144)
#define MOE2_SPLIT const int nU = ps[8] * 4, nfull = (nU / G) * G, nlo = nU - nfull, ns = (nlo == 0 || nlo > 64) ? 1 : nlo <= 18 ? 7 : nlo <= 32 ? 4 : 2;
#define D_CNT ((gu32*)(GAS unsigned*)(ws + WS_CTL) + CW_MOE)
#define D_ME WSP(int2, WS_ME)
#define D_MP WSP(int2, WS_MP)
#define D_MW WSP(float2, WS_MW)
#define PS_LOAD int ps[9]; ps[0] = 0; _Pragma("unroll") for (int e_ = 0; e_ < 8; ++e_) { const int n_ = (int)__builtin_amdgcn_readfirstlane(__hip_atomic_load(D_CNT + 64 * e_, RLX_AGENT)); ps[e_ + 1] = ps[e_] + ((n_ + 255) >> 8); }
    {
        PH_BEGIN
        LAS float* const st = (LAS float*)(LDSP + RING_OFF + 69632);
        for (int i = tid; i < 5 * DM; i += NWAVES * 64) { const float x = i < 4 * DM ? INP(I_C)[i] : INP(I_CCTX)[i - 4 * DM]; st[i] = x / (1.f + __expf(-x)); }
        __syncthreads();
        constexpr int N_MOD = 2 * 384, N_ROPE = 16, N_LAM = 1, N_WIN = 16 * (INW / 32), N_PRJ = 16 * 32, N_W1 = 16 * (DFF / 32), N_W2 = (DFF / 64) * 32;
        constexpr int NITEMS = N_MOD + N_ROPE + N_LAM + 2 * N_WIN + 6 * N_PRJ + 2 * N_W1 + N_W2;
        for (int it = gw; it < NITEMS; it += NGW) {
            int r = it;
            if (r < N_MOD) {
                const int l = r / 384, cb = r - l * 384, cl = lane & 15, kg = lane >> 4, col = 16 * cb + cl;
                const float* w = INP(I_ADAW) + (size_t)l * DM * 6144 + col; float a0 = 0.f, a1 = 0.f, a2 = 0.f, a3 = 0.f, a4 = 0.f;
#pragma unroll 16
                for (int k = kg; k < DM; k += 4) { const float wv = w[(size_t)k * 6144]; a0 += st[k] * wv; a1 += st[DM + k] * wv; a2 += st[2 * DM + k] * wv; a3 += st[3 * DM + k] * wv; a4 += st[4 * DM + k] * wv; }
                a0 += shx(a0, 16, lane); a0 += shx(a0, 32, lane); a1 += shx(a1, 16, lane); a1 += shx(a1, 32, lane); a2 += shx(a2, 16, lane); a2 += shx(a2, 32, lane);
                a3 += shx(a3, 16, lane); a3 += shx(a3, 32, lane); a4 += shx(a4, 16, lane); a4 += shx(a4, 32, lane);
                if (kg == 0) { const float bb = INP(I_ADAB)[l * 6144 + col]; float* m = D_MOD + (size_t)l * 5 * 6144 + col;
                    m[0] = a0 + bb; m[6144] = a1 + bb; m[2 * 6144] = a2 + bb; m[3 * 6144] = a3 + bb; m[4 * 6144] = a4 + bb; }
                continue; }
            r -= N_MOD;
            if (r < N_ROPE) { const int idx = r * 64 + lane, pos = idx >> 4, f = idx & 15; const float invf = powf(10000.f, -(float)f / 16.f), ang = (float)pos * invf;
                D_TAB[2 * idx] = cosf(ang); D_TAB[2 * idx + 1] = sinf(ang); continue; }
            r -= N_ROPE;
            if (r < N_LAM) {
                for (int l = 0; l < 2; ++l) { const float* dl = INP(I_DLAM) + l * 256; const float s1 = wave_sum(dl[lane] * dl[64 + lane], lane), s2 = wave_sum(dl[128 + lane] * dl[192 + lane], lane);
                    if (lane == 0) D_LAM[l] = expf(s1) - expf(s2) + (0.8f - 0.6f * expf(-0.3f * (float)l)); }
                continue; }
            r -= N_LAM;
            if (r < 2 * N_WIN) { const int l = r / N_WIN; transpose_item(INP(I_WIN) + (size_t)l * DM * INW, DM, INW, (bf16*)(ws + WS_WIN) + (size_t)l * INW * DM, 1, D_SCR, r - l * N_WIN, lane); continue; }
            r -= 2 * N_WIN;
            if (r < 6 * N_PRJ) { const int j = r / N_PRJ, l = j / 3, w = j - 3 * l;
                const float* src = (w == 0 ? INP(I_WPD) : w == 1 ? INP(I_WPG) : INP(I_WO)) + (size_t)l * DM * DM;
                transpose_item(src, DM, DM, (bf16*)(ws + WS_WPRJ) + (size_t)j * DM * DM, 0, D_SCR, r - j * N_PRJ, lane); continue; }
            r -= 6 * N_PRJ;
            if (r < N_W1) { transpose_item(INP(I_FW1), DM, DFF, (bf16*)(ws + WS_W13), 2, D_SCR, r, lane); continue; }
            r -= N_W1;
            if (r < N_W1) { transpose_item(INP(I_FW3), DM, DFF, (bf16*)(ws + WS_W13), 3, D_SCR, r, lane); continue; }
            r -= N_W1;
            transpose_item(INP(I_FW2), DFF, DM, (bf16*)(ws + WS_W2F), 0, D_SCR, r, lane);
        }
    }
    GRID_BAR();

    for (int l = 0; l < 2; ++l) {
        {
            PH_BEGIN
            const float* xl = l == 0 ? INP(I_X) : D_X; const float* xc = l == 0 ? INP(I_CTX) : D_XC; f32x4 hv[4], hn[4];
#define XROW(e_) ((e_) % EXT < SEQ ? xl + (size_t)((e_) / EXT * SEQ + (e_) % EXT) * DM : xc + (size_t)((e_) / EXT * CTXL + (e_) % EXT - SEQ) * DM)
            row_load(XROW(gw), lane, hv);
            for (int e = gw; e < MEXT; e += NGW) { const int b = e / EXT, s = e - b * EXT; const bool lat = s < SEQ;
                const int en = e + NGW < MEXT ? e + NGW : e; row_load(XROW(en), lane, hn);
                const float* mv = D_MODL + (lat ? b : 4) * 6144;
                if (l == 1 && !lat) {
                    const float* sl = WSP(float, WS_SLABJ) + (size_t)(s - SEQ) * 256 + 4 * lane; const float* gtc = D_MOD + 4 * 6144 + 5 * DM;
#pragma unroll
                    for (int j = 0; j < 4; ++j) { f32x4 a = {0.f, 0.f, 0.f, 0.f};
                        for (int q = 0; q < DFF / 256; ++q) a = a + *(const GAS f32x4*)(sl + (size_t)((b * 4 + j) * (DFF / 256) + q) * 65536);
                        hv[j] = hv[j] + ((const GAS f32x4*)gtc)[lane + 64 * j] * a; } }
                norm_mod_apply(hv, INP(I_NAG) + l * DM, mv, mv + DM, D_H + (size_t)e * DM, lane);
#pragma unroll
                for (int j = 0; j < 4; ++j) hv[j] = hn[j]; }
#undef XROW
        }
        GRID_BAR();
for (int rep_ = 0; rep_ < REP_GEMM; ++rep_) {
        {
            PH_BEGIN
            pg8::Gemm g{(const pg8::bf16_t*)D_H, (const pg8::bf16_t*)(ws + WS_WIN) + (size_t)l * INW * DM, DM, DM, DM, 0};
            pg8::RectOrder S; if (l == 0) S.init(NPAN, INW / 256, G, bx, 0, 0, 0); else S.init(64, INW / 256, G, bx, 1, 8, 10);
            pg8::EpiInProj E{(pg8::bf16_t*)D_P, INP(I_QNG) + l * 64, INP(I_KNG) + l * 64, D_TAB, attn_body::C2};
            pg8::gemm_phase<pg8::EpiInProj, pg8::RectOrder, true, true>(LDSP + RING_OFF, g, S, E);
        }
        GRID_BAR();
        }
for (int rep_ = 0; rep_ < REP_ATT; ++rep_) {
        {
            PH_BEGIN
            const int nun = l == 0 ? 2048 + 128 : 2048;
            for (int i = 0;; ++i) {
                const int Lu = i * G + vcu; if (Lu >= nun) break;
                int b, k, qb; bool diff;
                if (Lu < 2048) { const int pr = Lu >> 4, rnd = pr >> 4, idx = (rnd >> 1) * 16 + (pr & 15); qb = Lu & 15; diff = (rnd & 1) == 0; b = idx >> 4; k = idx & 15; }
                else { const int x = Lu - 2048; b = x >> 5; const int kk = x & 31; diff = kk < 16; k = kk & 15; qb = 16; }
                const size_t qrow = (size_t)b * EXT + qb * 256, krow = (size_t)b * EXT + (qb < 16 ? 0 : SEQ); const int NT = qb < 16 ? EXT / 64 : CTXL / 64;
                const attn_body::bf16* Pq = (const attn_body::bf16*)D_P + qrow * INW; const attn_body::bf16* Pk = (const attn_body::bf16*)D_P + krow * INW; attn_body::bf16* Oq = (attn_body::bf16*)D_OA + qrow * OAW;
                if (diff) { const int h = k >> 1, c = k & 1;
                    attn_body::attn_unit_dv<8>(Pq + PC_QD + h * 128 + c * 64, INW, Pk + PC_KD + h * 128 + c * 64, INW, Pk + PC_VD + h * 128, INW, Oq + c * 1024 + h * 128, OAW, NT, (char*)lds + RING_OFF); }
                else { const int gk = k >> 2;
                    attn_body::attn_unit<8>(Pq + PC_QG + k * 64, INW, Pk + PC_KG + gk * 64, INW, Pk + PC_VG + gk * 64, INW, Oq + 2048 + k * 64, OAW, NT, (char*)lds + RING_OFF); }
            }
        }
        GRID_BAR();
        }
        {
            PH_BEGIN
            const float lam = D_LAM[l], li = 1.f - (0.8f - 0.6f * expf(-0.3f * (float)l)); const float* sg = INP(I_SUBG) + l * 128 + 16 * (lane & 7);
            f32x4 g4[4];
#pragma unroll
            for (int j = 0; j < 4; ++j) g4[j] = ((const GAS f32x4*)sg)[j];
            for (int e = gw; e < MEXT; e += NGW) { bf16* row = D_OA + (size_t)e * OAW + 16 * lane;
                const v4u ra0 = *(const GAS v4u*)row, ra1 = *(const GAS v4u*)(row + 8), rc0 = *(const GAS v4u*)(row + 1024), rc1 = *(const GAS v4u*)(row + 1032);
                f32x4 a[4], c[4]; pg8::unpack8(ra0, a[0], a[1]); pg8::unpack8(ra1, a[2], a[3]); pg8::unpack8(rc0, c[0], c[1]); pg8::unpack8(rc1, c[2], c[3]);
                float ss = 0.f;
#pragma unroll
                for (int j = 0; j < 4; ++j) { a[j] = a[j] - c[j] * lam; ss += (a[j].x * a[j].x + a[j].y * a[j].y) + (a[j].z * a[j].z + a[j].w * a[j].w); }
                ss += shx(ss, 1, lane); ss += shx(ss, 2, lane); ss += shx(ss, 4, lane);
                const float rs = li / sqrtf(ss * (1.f / 128.f) + EPS);
#pragma unroll
                for (int j = 0; j < 4; ++j) a[j] = a[j] * rs * g4[j];
                *(GAS v4u*)row = pg8::pack8(a[0], a[1]); *(GAS v4u*)(row + 8) = pg8::pack8(a[2], a[3]); }
        }
        GRID_BAR();
        {
            PH_BEGIN
            pg8::Gemm g{(const pg8::bf16_t*)D_OA, (const pg8::bf16_t*)(ws + WS_WPRJ) + (size_t)(l * 3 + 0) * DM * DM, DM, OAW, DM, 0};
            pg8::RectOrder S; if (l == 0) S.init(NPAN, 4, G, bx, 0, 0, 0); else S.init(64, 4, G, bx, 1, 0, 0);
            pg8::EpiGate E{(pg8::bf16_t*)D_MX, (const pg8::bf16_t*)D_P + PC_G1, 0};
            pg8::gemm_phase<pg8::EpiGate, pg8::RectOrder, true, true>(LDSP + RING_OFF, g, S, E);
        }
        GRID_BAR();
        {
            PH_BEGIN
            pg8::Gemm g{(const pg8::bf16_t*)D_OA + 2048, (const pg8::bf16_t*)(ws + WS_WPRJ) + (size_t)(l * 3 + 1) * DM * DM, DM, OAW, DM, 0};
            pg8::RectOrder S; if (l == 0) S.init(NPAN, 4, G, bx, 0, 0, 0); else S.init(64, 4, G, bx, 1, 0, 0);
            pg8::EpiGate E{(pg8::bf16_t*)D_MX, (const pg8::bf16_t*)D_P + PC_G2, 1};
            pg8::gemm_phase<pg8::EpiGate, pg8::RectOrder, true, true>(LDSP + RING_OFF, g, S, E);
        }
        GRID_BAR();
        {
            PH_BEGIN
            pg8::Gemm g{(const pg8::bf16_t*)D_MX, (const pg8::bf16_t*)(ws + WS_WPRJ) + (size_t)(l * 3 + 2) * DM * DM, DM, DM, DM, 0};
            pg8::RectOrder S; if (l == 0) S.init(NPAN, 4, G, bx, 0, 0, 0); else S.init(64, 4, G, bx, 1, 0, 0);
            pg8::EpiResid E{l == 0 ? INP(I_X) : D_X, l == 0 ? INP(I_CTX) : D_XC, D_X, D_XC, D_MODL + 2 * DM};
            pg8::gemm_phase<pg8::EpiResid, pg8::RectOrder, true, true>(LDSP + RING_OFF, g, S, E);
        }
        GRID_BAR();
        if (l == 0) {
            { PH_BEGIN
              f32x4 hv[4], hn[4]; const float* xl = D_X; const float* xc = D_XC;
#define XROW(e_) ((e_) % EXT < SEQ ? xl + (size_t)((e_) / EXT * SEQ + (e_) % EXT) * DM : xc + (size_t)((e_) / EXT * CTXL + (e_) % EXT - SEQ) * DM)
              row_load(XROW(gw), lane, hv);
              for (int e = gw; e < MEXT; e += NGW) { const int b = e / EXT, s = e - b * EXT; const bool lat = s < SEQ;
                  const int en = e + NGW < MEXT ? e + NGW : e; row_load(XROW(en), lane, hn);
                  const float* mv = D_MODL + (lat ? b : 4) * 6144;
                  norm_mod_apply(hv, INP(I_NFG) + l * DM, mv + 3 * DM, mv + 4 * DM, D_H + (size_t)e * DM, lane);
#pragma unroll
                  for (int j = 0; j < 4; ++j) hv[j] = hn[j]; } }
#undef XROW
            GRID_BAR();
for (int rep_ = 0; rep_ < REP_GEMM; ++rep_) {
            {
                PH_BEGIN
                pg8::Gemm g{(const pg8::bf16_t*)D_H, (const pg8::bf16_t*)(ws + WS_W13), DM, DM, DM, 0};
                pg8::RectOrder S; S.init(NPAN, 2 * DFF / 256, G, bx, 0, 0, 0);
                pg8::EpiSwiGLU E{(pg8::bf16_t*)(ws + WS_U), DFF};
                pg8::gemm_phase<pg8::EpiSwiGLU, pg8::RectOrder, true, true>(LDSP + RING_OFF, g, S, E);
            }
            GRID_BAR();
        }
            {
                PH_BEGIN
                pg8::Gemm g{(const pg8::bf16_t*)(ws + WS_U), (const pg8::bf16_t*)(ws + WS_W2F), DFF, DFF, DFF, 0};
                pg8::RectOrder S; S.init(64, 4, G, bx, 1, 0, 0);
                pg8::EpiResid E{D_X, D_XC, D_X, D_XC, D_MODL + 5 * DM};
                pg8::gemm_phase<pg8::EpiResid, pg8::RectOrder, true, true>(LDSP + RING_OFF, g, S, E);
                pg8::Gemm g2{(const pg8::bf16_t*)(ws + WS_U), (const pg8::bf16_t*)(ws + WS_W2F), 256, DFF, DFF, 0};
                pg8::CtxSliceOrder S2{DFF / 256, 256, G, bx};
                pg8::EpiSlab E2{WSP(float, WS_SLABJ)};
                pg8::gemm_phase<pg8::EpiSlab, pg8::CtxSliceOrder, true, true>(LDSP + RING_OFF, g2, S2, E2);
            }
            GRID_BAR();
        } else {
            { PH_BEGIN
              f32x4 hv[4], hn[4]; const float* router = INP(I_ROUTER);
              row_load(D_X + (size_t)gw * DM, lane, hn);
              for (int t = gw; t < MLAT; t += NGW) { const int b = t / SEQ; const float* mv = D_MODL + b * 6144;
#pragma unroll
                  for (int j = 0; j < 4; ++j) hv[j] = hn[j];
                  row_load(D_X + (size_t)(t + NGW < MLAT ? t + NGW : t) * DM, lane, hn);
                  norm_mod_apply(hv, INP(I_NFG) + l * DM, mv + 3 * DM, mv + 4 * DM, D_H + (size_t)t * DM, lane);
                  float lg[8];
#pragma unroll
                  for (int e = 0; e < 8; ++e) lg[e] = 0.f;
#pragma unroll
                  for (int j = 0; j < 4; ++j)
#pragma unroll
                      for (int i = 0; i < 4; ++i) { const GAS f32x4* rp = (const GAS f32x4*)(router + (size_t)(4 * lane + 256 * j + i) * 8); const f32x4 r0 = rp[0], r1 = rp[1]; const float hx = hv[j][i];
                          lg[0] += hx * r0.x; lg[1] += hx * r0.y; lg[2] += hx * r0.z; lg[3] += hx * r0.w; lg[4] += hx * r1.x; lg[5] += hx * r1.y; lg[6] += hx * r1.z; lg[7] += hx * r1.w; }
#pragma unroll
                  for (int e = 0; e < 8; ++e) lg[e] = wave_sum(lg[e], lane);
                  int i0 = 0; float v0 = lg[0];
#pragma unroll
                  for (int e = 1; e < 8; ++e) if (lg[e] > v0) { v0 = lg[e]; i0 = e; }
                  int i1 = -1; float v1 = -INFINITY;
#pragma unroll
                  for (int e = 0; e < 8; ++e) if (e != i0 && lg[e] > v1) { v1 = lg[e]; i1 = e; }
                  if (lane == 0) { const float w0 = 1.f / (1.f + expf(v1 - v0));
                      const int p0 = (int)__hip_atomic_fetch_add(D_CNT + 64 * i0, 1u, RLX_AGENT), p1 = (int)__hip_atomic_fetch_add(D_CNT + 64 * i1, 1u, RLX_AGENT);
                      D_ME[t] = make_int2(i0, i1); D_MP[t] = make_int2(p0, p1); D_MW[t] = make_float2(w0, 1.f - w0); } } }
            {
                PH_BEGIN
                constexpr int N_E1 = 16 * (DFE / 32), N_E2 = (DFE / 64) * 32;
                for (int it = gw; it < NEXP * (2 * N_E1 + N_E2); it += NGW) { const int e = it / (2 * N_E1 + N_E2); int r = it - e * (2 * N_E1 + N_E2);
                    if (r < N_E1) { transpose_item(INP(I_MW1) + (size_t)e * DM * DFE, DM, DFE, (bf16*)(ws + WS_MW13) + (size_t)e * 2 * DFE * DM, 2, D_SCR, r, lane); continue; }
                    r -= N_E1;
                    if (r < N_E1) { transpose_item(INP(I_MW3) + (size_t)e * DM * DFE, DM, DFE, (bf16*)(ws + WS_MW13) + (size_t)e * 2 * DFE * DM, 3, D_SCR, r, lane); continue; }
                    r -= N_E1;
                    transpose_item(INP(I_MW2) + (size_t)e * DFE * DM, DFE, DM, (bf16*)(ws + WS_MW2) + (size_t)e * DM * DFE, 0, D_SCR, r, lane); }
            }
            GRID_BAR();
            {
                PH_BEGIN
                PS_LOAD
                bf16* const HS = (bf16*)(ws + WS_HS);
                for (int it = gw; it < 2 * MLAT; it += NGW) { const int t = it >> 1, k = it & 1; const int2 ee = D_ME[t], pp = D_MP[t]; const int e = k ? ee.y : ee.x, p = k ? pp.y : pp.x;
                    int pe = 0;
#pragma unroll
                    for (int q = 1; q < 8; ++q) pe = (e == q) ? ps[q] : pe;
                    const GAS v4u* src = (const GAS v4u*)(D_H + (size_t)t * DM); GAS v4u* dst = (GAS v4u*)(HS + ((size_t)pe * 256 + p) * DM);
                    dst[lane] = src[lane]; dst[lane + 64] = src[lane + 64]; }
            }
            GRID_BAR();
for (int rep_ = 0; rep_ < REP_GEMM; ++rep_) {
            {
                PH_BEGIN
                PS_LOAD
                pg8::Gemm g{(const pg8::bf16_t*)(ws + WS_HS), (const pg8::bf16_t*)(ws + WS_MW13), DM, DM, DM, (size_t)2 * DFE * DM * 2};
                pg8::MoeOrder S{ps[8], 2 * DFE / 256, ps[8] * (2 * DFE / 256), G, bx, ps[1], ps[2], ps[3], ps[4], ps[5], ps[6], ps[7], 1, 0, 0};
                pg8::EpiSwiGLU E{(pg8::bf16_t*)(ws + WS_U2), DFE};
                pg8::gemm_phase<pg8::EpiSwiGLU, pg8::MoeOrder, true, true>(LDSP + RING_OFF, g, S, E);
            }
            GRID_BAR();
        }
for (int rep_ = 0; rep_ < REP_GEMM; ++rep_) {
            {
                PH_BEGIN
                PS_LOAD
                MOE2_SPLIT
                pg8::Gemm g{(const pg8::bf16_t*)(ws + WS_U2), (const pg8::bf16_t*)(ws + WS_MW2), DFE, DFE, DFE, (size_t)DM * DFE * 2};
                pg8::MoeOrder S{ps[8], 4, ns > 1 ? nfull : nU, G, bx, ps[1], ps[2], ps[3], ps[4], ps[5], ps[6], ps[7], 1, 0, 0};
                pg8::EpiPlain E{(pg8::bf16_t*)(ws + WS_HS), DM};
                pg8::gemm_phase<pg8::EpiPlain, pg8::MoeOrder, true, true>(LDSP + RING_OFF, g, S, E);
                if (ns > 1) {
                    pg8::Gemm g2{(const pg8::bf16_t*)(ws + WS_U2), (const pg8::bf16_t*)(ws + WS_MW2), DFE / ns, DFE, DFE, (size_t)DM * DFE * 2};
                    pg8::MoeOrder S2{ps[8], 4, nlo * ns, G, bx, ps[1], ps[2], ps[3], ps[4], ps[5], ps[6], ps[7], ns, nfull, DFE / ns};
                    pg8::EpiSlab E2{WSP(float, WS_SLABM)};
                    pg8::gemm_phase<pg8::EpiSlab, pg8::MoeOrder, true, true>(LDSP + RING_OFF, g2, S2, E2);
                }
            }
            GRID_BAR();
            {
                PH_BEGIN
                PS_LOAD
                MOE2_SPLIT
                if (ns > 1) { bf16* const Y = (bf16*)(ws + WS_HS);
                    for (int it = gw; it < nlo * 256; it += NGW) { const int t = it >> 8, r = it & 255; int pm, pn; pg8::rect_map(nfull + t, ps[8], 4, pm, pn);
                        const float* sl = WSP(float, WS_SLABM) + (size_t)t * ns * 65536 + r * 256 + 4 * lane; f32x4 a = {0.f, 0.f, 0.f, 0.f};
                        for (int q = 0; q < ns; ++q) a = a + *(const GAS f32x4*)(sl + (size_t)q * 65536);
                        *(GAS unsigned long long*)(Y + ((size_t)pm * 256 + r) * DM + pn * 256 + 4 * lane) = (unsigned long long)pkbf(a.x, a.y) | ((unsigned long long)pkbf(a.z, a.w) << 32); } }
            }
            GRID_BAR();
        }
            {
                PH_BEGIN
                PS_LOAD
                const bf16* const Y = (const bf16*)(ws + WS_HS); const float* fg = INP(I_FNG);
                for (int t = gw; t < MLAT; t += NGW) { const int b = t / SEQ; const int2 ee = D_ME[t], pp = D_MP[t]; const float2 ww = D_MW[t];
                    int pe0 = 0, pe1 = 0;
#pragma unroll
                    for (int q = 1; q < 8; ++q) { pe0 = (ee.x == q) ? ps[q] : pe0; pe1 = (ee.y == q) ? ps[q] : pe1; }
                    const GAS unsigned long long* y0 = (const GAS unsigned long long*)(Y + ((size_t)pe0 * 256 + pp.x) * DM) + lane; const GAS unsigned long long* y1 = (const GAS unsigned long long*)(Y + ((size_t)pe1 * 256 + pp.y) * DM) + lane;
                    GAS f32x4* xr = (GAS f32x4*)(D_X + (size_t)t * DM) + lane; const GAS f32x4* gt = (const GAS f32x4*)(D_MODL + b * 6144 + 5 * DM) + lane;
                    f32x4 v[4]; float ss = 0.f;
#pragma unroll
                    for (int j = 0; j < 4; ++j) { const unsigned long long a = y0[64 * j], c = y1[64 * j]; const unsigned a0 = (unsigned)a, a1 = (unsigned)(a >> 32), c0 = (unsigned)c, c1 = (unsigned)(c >> 32);
                        const f32x4 ya = {__builtin_bit_cast(float, a0 << 16), __builtin_bit_cast(float, a0 & 0xffff0000u), __builtin_bit_cast(float, a1 << 16), __builtin_bit_cast(float, a1 & 0xffff0000u)};
                        const f32x4 yc = {__builtin_bit_cast(float, c0 << 16), __builtin_bit_cast(float, c0 & 0xffff0000u), __builtin_bit_cast(float, c1 << 16), __builtin_bit_cast(float, c1 & 0xffff0000u)};
                        v[j] = xr[64 * j] + gt[64 * j] * (ya * ww.x + yc * ww.y);
                        ss += (v[j].x * v[j].x + v[j].y * v[j].y) + (v[j].z * v[j].z + v[j].w * v[j].w); }
                    const float rs = 1.f / sqrtf(wave_sum(ss, lane) * (1.f / DM) + EPS);
#pragma unroll
                    for (int j = 0; j < 4; ++j) xr[64 * j] = v[j] * rs * ((const GAS f32x4*)fg)[lane + 64 * j]; }
            }
        }
    }
#undef GRID_BAR
}

extern "C" void kernel_launch(void* const* d_in, const int* in_sizes, int n_in, void* d_out, int out_size, void* d_ws, size_t ws_size, hipStream_t stream) {
    static int grid = 0;
    if (grid == 0) {
        if (n_in != 24 || out_size != MLAT * DM || ws_size < WS_END) { fprintf(stderr, "kernel_launch: built for 24 inputs, %d outputs, >= %zu bytes of workspace; got n_in %d, out %d, ws %zu; nothing launched\n", MLAT * DM, (size_t)WS_END, n_in, out_size, ws_size); grid = -1; return; }
        int dev = 0, cus = 0, per_cu = 0;
        if (hipGetDevice(&dev) != hipSuccess || hipDeviceGetAttribute(&cus, hipDeviceAttributeMultiprocessorCount, dev) != hipSuccess) { fprintf(stderr, "kernel_launch: device query failed\n"); grid = -1; return; }
        if (hipFuncSetAttribute((const void*)fwd_kernel, hipFuncAttributeMaxDynamicSharedMemorySize, LDS_BYTES) != hipSuccess) { fprintf(stderr, "kernel_launch: hipFuncSetAttribute failed\n"); grid = -1; return; }
        if (hipOccupancyMaxActiveBlocksPerMultiprocessor(&per_cu, (const void*)fwd_kernel, NWAVES * 64, LDS_BYTES) != hipSuccess || per_cu < 1) { fprintf(stderr, "kernel_launch: occupancy query reports %d workgroups per CU\n", per_cu); }
        (void)hipGetLastError();
        grid = cus;
    }
    if (grid < 0) return;
    if (hipMemsetAsync((char*)d_ws + WS_CTL, 0, CTL_ZERO_BYTES, stream) != hipSuccess) { fprintf(stderr, "kernel_launch: hipMemsetAsync failed\n"); return; }
    Args a{};
    for (int i = 0; i < 24; ++i) a.in[i] = (const float*)d_in[i];
    a.out = (float*)d_out; a.ws = (unsigned char*)d_ws;
    hipLaunchKernelGGL(fwd_kernel, dim3(grid), dim3(NWAVES * 64), LDS_BYTES, stream, a);
    const hipError_t le = hipPeekAtLastError();
    if (le != hipSuccess) fprintf(stderr, "kernel_launch: launch failed: %s\n", hipGetErrorName(le));
}
```

```cpp
#include <hip/hip_runtime.h>
#include <hip/hip_bf16.h>
#include <cstdio>
#include <cstdint>
#include <cmath>

constexpr int DM = 1024, NB = 4, SEQ = 4096, CTXL = 256, EXT = SEQ + CTXL, MEXT = NB * EXT, MLAT = NB * SEQ, MCTX = NB * CTXL;
constexpr int PANB = EXT / 256  , NPAN = NB * PANB  ;
constexpr int INW = 6656;
constexpr int PC_QD = 0, PC_QG = 1024, PC_KD = 2048, PC_VD = 3072, PC_KG = 4096, PC_VG = 4352, PC_G1 = 4608, PC_G2 = 5632;
constexpr int OAW = 3072;
constexpr int DFF = 2816, NEXP = 8, DFE = 3584;
constexpr int MOE_ROWS = 2 * MLAT + NEXP * 256;
constexpr float EPS = 1e-6f;
constexpr int NHU = 48;
__device__ __forceinline__ int lane_id_() { int l; asm volatile("v_mbcnt_lo_u32_b32 %0, -1, 0\n\tv_mbcnt_hi_u32_b32 %0, -1, %0" : "=v"(l)); return l; }
namespace pg8 {
#define PG8_LAS __attribute__((address_space(3)))
typedef unsigned short bf16_t;
typedef short bf16x8 __attribute__((ext_vector_type(8)));
typedef float f32x4 __attribute__((ext_vector_type(4)));
typedef unsigned u32x4 __attribute__((ext_vector_type(4)));
constexpr int BM = 256, BK = 64, HALF = 128, HTB = HALF * BK * 2  , STAGE_BYTES = 8 * HTB, NXCD = 8, WGM = 8;

__host__ __device__ __forceinline__ int lds_byte(int r, int c) { const int st = (r >> 4) * 2 + (c >> 5), rr = r & 15, cc = c & 31, ob = rr * 64 + cc * 2; return st * 1024 + (ob ^ (((ob >> 9) & 1) << 5)); }
__host__ __device__ __forceinline__ void stage_rc(int b, int& R, int& C) { const int st = b / 1024, sb = b % 1024, swz = sb ^ (((sb >> 9) & 1) << 5); R = (st >> 1) * 16 + swz / 64; C = (st & 1) * 32 + (swz % 64) / 2; }
__host__ __device__ __forceinline__ int perm32(int rho) { const int n = rho >> 4, i = rho & 15; return 8 * (i >> 2) + 4 * n + (i & 3); }

struct Unit { int pm, pn, e, koff, sl, aoff; };
struct Gemm { const bf16_t* A; const bf16_t* Bt; int K, lda, ldb; size_t bstride; };
__device__ __forceinline__ void rect_map(int wgid, int nM, int nN, int& pm, int& pn) {
    const int nwg = nM * nN; { const int q = nwg / NXCD, r = nwg % NXCD, xcd = wgid % NXCD, off = wgid / NXCD; wgid = (xcd < r ? xcd * (q + 1) : r * (q + 1) + (xcd - r) * q) + off; }
    const int nig = WGM * nN, gid = wgid / nig, fm = gid * WGM, gsz = (nM - fm) < WGM ? (nM - fm) : WGM;
    pm = fm + ((wgid % nig) % gsz); pn = (wgid % nig) / gsz;
}
struct RectOrder {
    int nMq, nN, nrect, G, c, latmode, exlo, exn, nextra;
    __device__ __forceinline__ void init(int nMq_, int nN_, int G_, int c_, int latmode_, int exlo_, int exn_) { nMq = nMq_; nN = nN_; nrect = nMq_ * nN_; G = G_; c = c_; latmode = latmode_; exlo = exlo_; exn = exn_; nextra = 4 * exn_; }
    __device__ __forceinline__ bool next(int i, Unit& u) const {
        int L = i * G + c; u.e = 0; u.koff = 0; u.sl = 0; u.aoff = 0;
        if (L < nrect) { int q, pn; rect_map(L, nMq, nN, q, pn); u.pm = latmode ? (q >> 4) * 17 + (q & 15) : q; u.pn = pn; return true; }
        L -= nrect; if (L >= nextra) return false;
        const int b = L / exn; u.pm = b * 17 + 16; u.pn = exlo + (L - b * exn); return true;
    }
    __device__ __forceinline__ void a_ready(const Unit&) const {}
    __device__ __forceinline__ void done(const Unit&) const {}
};
struct CtxSliceOrder {
    int ns, kslice, G, c;
    __device__ __forceinline__ bool next(int i, Unit& u) const {
        const int L = i * G + c; if (L >= 16 * ns) return false;
        const int t = L / ns; u.pm = (t >> 2) * 17 + 16; u.pn = t & 3; u.e = 0; u.koff = (L - t * ns) * kslice; u.sl = L; u.aoff = 0; return true;
    }
    __device__ __forceinline__ void a_ready(const Unit&) const {}
    __device__ __forceinline__ void done(const Unit&) const {}
};
struct MixOrder {
    int G, c, aoff1;
    __device__ __forceinline__ bool next(int i, Unit& u) const {
        const int L = (i >> 1) * G + c; if (L >= 256) return false;
        int q, pn; rect_map(L, 64, 4, q, pn); u.pm = (q >> 4) * 17 + (q & 15); u.pn = pn; u.e = i & 1; u.koff = 0; u.sl = 0; u.aoff = (i & 1) * aoff1; return true;
    }
    __device__ __forceinline__ void a_ready(const Unit&) const {}
    __device__ __forceinline__ void done(const Unit&) const {}
};
struct MixCtxOrder {
    int G, c, aoff1;
    __device__ __forceinline__ bool next(int i, Unit& u) const {
        const int L = i * G + c; if (L >= 128) return false;
        const int t = L >> 3, p = (L >> 2) & 1; u.pm = (t >> 2) * 17 + 16; u.pn = t & 3; u.e = p; u.koff = (L & 3) * 256; u.sl = L; u.aoff = p * aoff1; return true;
    }
    __device__ __forceinline__ void a_ready(const Unit&) const {}
    __device__ __forceinline__ void done(const Unit&) const {}
};
struct MoeOrder {
    int P, nN, lim, G, c, p1, p2, p3, p4, p5, p6, p7, ns, first, kslice;
    __device__ __forceinline__ bool next(int i, Unit& u) const {
        int L = i * G + c; if (L >= lim) return false;
        u.koff = 0; u.sl = 0; u.aoff = 0;
        if (ns > 1) { const int t = L / ns; u.koff = (L - t * ns) * kslice; u.sl = L; L = first + t; }
        int pm, pn; rect_map(L, P, nN, pm, pn); u.pm = pm; u.pn = pn;
        u.e = (pm >= p1) + (pm >= p2) + (pm >= p3) + (pm >= p4) + (pm >= p5) + (pm >= p6) + (pm >= p7); return true;
    }
    __device__ __forceinline__ void a_ready(const Unit&) const {}
    __device__ __forceinline__ void done(const Unit&) const {}
};

__device__ __forceinline__ unsigned cvt_pk_bf16(float lo, float hi) { unsigned r; asm volatile("v_cvt_pk_bf16_f32 %0, %1, %2" : "=v"(r) : "v"(lo), "v"(hi)); return r; }
__device__ __forceinline__ u32x4 pack8(const f32x4& a, const f32x4& b) { u32x4 w; w.x = cvt_pk_bf16(a[0], a[1]); w.y = cvt_pk_bf16(a[2], a[3]); w.z = cvt_pk_bf16(b[0], b[1]); w.w = cvt_pk_bf16(b[2], b[3]); return w; }
__device__ __forceinline__ void unpack8(const u32x4& w, f32x4& a, f32x4& b) {
    a[0] = __builtin_bit_cast(float, w.x << 16); a[1] = __builtin_bit_cast(float, w.x & 0xffff0000u); a[2] = __builtin_bit_cast(float, w.y << 16); a[3] = __builtin_bit_cast(float, w.y & 0xffff0000u);
    b[0] = __builtin_bit_cast(float, w.z << 16); b[1] = __builtin_bit_cast(float, w.z & 0xffff0000u); b[2] = __builtin_bit_cast(float, w.w << 16); b[3] = __builtin_bit_cast(float, w.w & 0xffff0000u); }
__device__ __forceinline__ float sigmoidf_(float v) { return __builtin_amdgcn_rcpf(1.f + __expf(-v)); }

struct EpiInProj {
    static constexpr bool PERM = true, AFTER_DRAIN = false;
    bf16_t* P; const float* qg; const float* kg; const float* tab; float c2;
    __device__ __forceinline__ void operator()(const f32x4 (&acc)[2][2][4][2], const Unit& u, int wr, int wc, int fr, int fq) const {
        { int t_ = lane_id_(); asm volatile("" : "+v"(t_)); fr = t_ & 15; fq = (t_ >> 4) & 3; }
        const int pn = u.pn, seg = u.pm % 17; const bool lat = seg < 16;
        bf16_t* base = P + (size_t)(u.pm * 256 + wr * 64 + fr) * INW + 256 * pn + 64 * wc + 8 * fq;
        if (pn >= 18) {
#pragma unroll
            for (int ai = 0; ai < 2; ++ai)
#pragma unroll
                for (int m = 0; m < 4; ++m)
#pragma unroll
                    for (int bj = 0; bj < 2; ++bj) { f32x4 v0 = acc[ai][bj][m][0], v1 = acc[ai][bj][m][1];
#pragma unroll
                        for (int e = 0; e < 4; ++e) { v0[e] = sigmoidf_(v0[e]); v1[e] = sigmoidf_(v1[e]); }
                        *(u32x4*)(base + (size_t)(ai * 128 + m * 16) * INW + 32 * bj) = pack8(v0, v1); }
            return;
        }
        const bool donorm = (pn >= 4 && pn < 8) || pn == 16, dorope = lat && (pn < 12 || pn == 16);
        const float osc = pn < 8 ? c2 : 1.f;
        f32x4 gv[2][2];
#pragma unroll
        for (int bj = 0; bj < 2; ++bj)
#pragma unroll
            for (int n = 0; n < 2; ++n) gv[bj][n] = donorm ? *(const f32x4*)((pn == 16 ? kg : qg) + 32 * bj + 8 * fq + 4 * n) : (f32x4){1.f, 1.f, 1.f, 1.f};
        f32x4 tr[2][2], tc[4][2];
#pragma unroll
        for (int n = 0; n < 2; ++n) {
#pragma unroll
            for (int ai = 0; ai < 2; ++ai) tr[ai][n] = dorope ? *(const f32x4*)(tab + ((4 * seg + 2 * ai + wr) * 16 + 4 * fq + 2 * n) * 2) : (f32x4){1.f, 0.f, 1.f, 0.f};
#pragma unroll
            for (int m = 0; m < 4; ++m) tc[m][n] = dorope ? *(const f32x4*)(tab + ((16 * m + fr) * 16 + 4 * fq + 2 * n) * 2) : (f32x4){1.f, 0.f, 1.f, 0.f};
        }
#pragma unroll
        for (int ai = 0; ai < 2; ++ai)
#pragma unroll
            for (int m = 0; m < 4; ++m) {
                f32x4 v[2][2];
#pragma unroll
                for (int bj = 0; bj < 2; ++bj)
#pragma unroll
                    for (int n = 0; n < 2; ++n) v[bj][n] = acc[ai][bj][m][n];
                if (donorm) {
                    float ss = 0.f;
#pragma unroll
                    for (int bj = 0; bj < 2; ++bj)
#pragma unroll
                        for (int n = 0; n < 2; ++n) ss += (v[bj][n][0] * v[bj][n][0] + v[bj][n][1] * v[bj][n][1]) + (v[bj][n][2] * v[bj][n][2] + v[bj][n][3] * v[bj][n][3]);
                    { const int ln = fq * 16 + fr; ss += __builtin_bit_cast(float, __builtin_amdgcn_ds_bpermute((ln ^ 16) << 2, __builtin_bit_cast(int, ss))); ss += __builtin_bit_cast(float, __builtin_amdgcn_ds_bpermute((ln ^ 32) << 2, __builtin_bit_cast(int, ss))); }
                    const float rs = 1.f / sqrtf(ss * (1.f / 64.f) + EPS);
#pragma unroll
                    for (int bj = 0; bj < 2; ++bj)
#pragma unroll
                        for (int n = 0; n < 2; ++n) v[bj][n] = v[bj][n] * rs * gv[bj][n];
                }
#pragma unroll
                for (int bj = 0; bj < 2; ++bj) {
#pragma unroll
                    for (int n = 0; n < 2; ++n) { const f32x4 t = bj == 0 ? tr[ai][n] : tc[m][n]; const f32x4 x = v[bj][n];
                        v[bj][n] = (f32x4){(x[0] * t[0] - x[1] * t[1]) * osc, (x[0] * t[1] + x[1] * t[0]) * osc, (x[2] * t[2] - x[3] * t[3]) * osc, (x[2] * t[3] + x[3] * t[2]) * osc}; }
                    *(u32x4*)(base + (size_t)(ai * 128 + m * 16) * INW + 32 * bj) = pack8(v[bj][0], v[bj][1]);
                }
            }
    }
};
struct EpiGate {
    static constexpr bool PERM = true, AFTER_DRAIN = false;
    bf16_t* Mx; const bf16_t* G0;
    __device__ __forceinline__ void operator()(const f32x4 (&acc)[2][2][4][2], const Unit& u, int wr, int wc, int fr, int fq) const {
        { int t_ = lane_id_(); asm volatile("" : "+v"(t_)); fr = t_ & 15; fq = (t_ >> 4) & 3; }
        const int row0 = u.pm * 256 + wr * 64 + fr, col0 = u.pn * 256 + wc * 32 + 8 * fq; const bf16_t* G = G0 + 1024 * u.e; const int accum = u.e;
#pragma unroll
        for (int ai = 0; ai < 2; ++ai)
#pragma unroll
            for (int m = 0; m < 4; ++m) { const size_t row = (size_t)(row0 + ai * 128 + m * 16);
#pragma unroll
                for (int bj = 0; bj < 2; ++bj) { const int col = col0 + 128 * bj;
                    f32x4 g0, g1; unpack8(*(const u32x4*)(G + row * INW + col), g0, g1);
                    f32x4 v0 = acc[ai][bj][m][0] * g0, v1 = acc[ai][bj][m][1] * g1;
                    if (accum) { f32x4 o0, o1; unpack8(*(const u32x4*)(Mx + row * DM + col), o0, o1); v0 = v0 + o0; v1 = v1 + o1; }
                    *(u32x4*)(Mx + row * DM + col) = pack8(v0, v1); } }
    }
};
struct EpiResid {
    static constexpr bool PERM = true, AFTER_DRAIN = false;
    const float* XoL; const float* XoC; float* XnL; float* XnC; const float* mod;
    __device__ __forceinline__ void operator()(const f32x4 (&acc)[2][2][4][2], const Unit& u, int wr, int wc, int fr, int fq) const {
        { int t_ = lane_id_(); asm volatile("" : "+v"(t_)); fr = t_ & 15; fq = (t_ >> 4) & 3; }
        const int b = u.pm / 17, seg = u.pm - b * 17; const bool lat = seg < 16;
        const size_t rb = (lat ? (size_t)(b * SEQ + seg * 256) : (size_t)(b * CTXL)) + wr * 64 + fr;
        const float* xo = lat ? XoL : XoC; float* xn = lat ? XnL : XnC;
        const int col0 = u.pn * 256 + wc * 32 + 8 * fq; const float* gp = mod + (lat ? b : 4) * 6144 + col0;
        f32x4 gt[2][2];
#pragma unroll
        for (int bj = 0; bj < 2; ++bj)
#pragma unroll
            for (int n = 0; n < 2; ++n) gt[bj][n] = *(const f32x4*)(gp + 128 * bj + 4 * n);
#pragma unroll
        for (int ai = 0; ai < 2; ++ai)
#pragma unroll
            for (int m = 0; m < 4; ++m) { const size_t ro = (rb + ai * 128 + m * 16) * DM + col0;
#pragma unroll
                for (int bj = 0; bj < 2; ++bj)
#pragma unroll
                    for (int n = 0; n < 2; ++n) { const f32x4 o = *(const f32x4*)(xo + ro + 128 * bj + 4 * n); *(f32x4*)(xn + ro + 128 * bj + 4 * n) = o + gt[bj][n] * acc[ai][bj][m][n]; } }
    }
};
struct EpiSwiGLU {
    static constexpr bool PERM = true, AFTER_DRAIN = false;
    bf16_t* U; int ldu;
    __device__ __forceinline__ void operator()(const f32x4 (&acc)[2][2][4][2], const Unit& u, int wr, int wc, int fr, int fq) const {
        { int t_ = lane_id_(); asm volatile("" : "+v"(t_)); fr = t_ & 15; fq = (t_ >> 4) & 3; }
        bf16_t* base = U + (size_t)(u.pm * 256 + wr * 64 + fr) * ldu + u.pn * 128 + wc * 32 + 8 * fq;
#pragma unroll
        for (int ai = 0; ai < 2; ++ai)
#pragma unroll
            for (int m = 0; m < 4; ++m) { f32x4 r[2];
#pragma unroll
                for (int n = 0; n < 2; ++n) { const f32x4 a = acc[ai][0][m][n], b = acc[ai][1][m][n];
#pragma unroll
                    for (int e = 0; e < 4; ++e) r[n][e] = a[e] * sigmoidf_(a[e]) * b[e]; }
                *(u32x4*)(base + (size_t)(ai * 128 + m * 16) * ldu) = pack8(r[0], r[1]); }
    }
};
struct EpiPlain {
    static constexpr bool PERM = true, AFTER_DRAIN = false;
    bf16_t* Y; int ldy;
    __device__ __forceinline__ void operator()(const f32x4 (&acc)[2][2][4][2], const Unit& u, int wr, int wc, int fr, int fq) const {
        { int t_ = lane_id_(); asm volatile("" : "+v"(t_)); fr = t_ & 15; fq = (t_ >> 4) & 3; }
        bf16_t* base = Y + (size_t)(u.pm * 256 + wr * 64 + fr) * ldy + u.pn * 256 + wc * 32 + 8 * fq;
#pragma unroll
        for (int ai = 0; ai < 2; ++ai)
#pragma unroll
            for (int m = 0; m < 4; ++m)
#pragma unroll
                for (int bj = 0; bj < 2; ++bj) *(u32x4*)(base + (size_t)(ai * 128 + m * 16) * ldy + 128 * bj) = pack8(acc[ai][bj][m][0], acc[ai][bj][m][1]);
    }
};

struct EpiSlab {
    static constexpr bool PERM = true, AFTER_DRAIN = false;
    float* slab;
    __device__ __forceinline__ void operator()(const f32x4 (&acc)[2][2][4][2], const Unit& u, int wr, int wc, int fr, int fq) const {
        { int t_ = lane_id_(); asm volatile("" : "+v"(t_)); fr = t_ & 15; fq = (t_ >> 4) & 3; }
        float* base = slab + (size_t)u.sl * 65536 + (wr * 64 + fr) * 256 + wc * 32 + 8 * fq;
#pragma unroll
        for (int ai = 0; ai < 2; ++ai)
#pragma unroll
            for (int m = 0; m < 4; ++m)
#pragma unroll
                for (int bj = 0; bj < 2; ++bj)
#pragma unroll
                    for (int n = 0; n < 2; ++n) *(f32x4*)(base + (ai * 128 + m * 16) * 256 + 128 * bj + 4 * n) = acc[ai][bj][m][n];
    }
};

struct EpiSlabGate {
    static constexpr bool PERM = true, AFTER_DRAIN = false;
    float* slab; const bf16_t* G0;
    __device__ __forceinline__ void operator()(const f32x4 (&acc)[2][2][4][2], const Unit& u, int wr, int wc, int fr, int fq) const {
        { int t_ = lane_id_(); asm volatile("" : "+v"(t_)); fr = t_ & 15; fq = (t_ >> 4) & 3; }
        float* base = slab + (size_t)u.sl * 65536 + (wr * 64 + fr) * 256 + wc * 32 + 8 * fq;
        const bf16_t* G = G0 + 1024 * u.e + (size_t)(u.pm * 256 + wr * 64 + fr) * INW + u.pn * 256 + wc * 32 + 8 * fq;
#pragma unroll
        for (int ai = 0; ai < 2; ++ai)
#pragma unroll
            for (int m = 0; m < 4; ++m)
#pragma unroll
                for (int bj = 0; bj < 2; ++bj) { f32x4 g0, g1; unpack8(*(const u32x4*)(G + (size_t)(ai * 128 + m * 16) * INW + 128 * bj), g0, g1);
                    *(f32x4*)(base + (ai * 128 + m * 16) * 256 + 128 * bj) = acc[ai][bj][m][0] * g0; *(f32x4*)(base + (ai * 128 + m * 16) * 256 + 128 * bj + 4) = acc[ai][bj][m][1] * g1; }
    }
};

template <class Epi, class Sched, bool ALIGN_EPI = false, bool SP2 = false>
__device__ __forceinline__ void gemm_phase(PG8_LAS unsigned char* lds, const Gemm g, const Sched& S, const Epi& E, const int wave0) {
    int tid_ = wave0 * 64 + lane_id_(); asm volatile("" : "+v"(tid_));
    const int tid = tid_, wid = __builtin_amdgcn_readfirstlane(tid >> 6), lane = tid & 63, wr = wid >> 2, wc = wid & 3, fr = lane & 15, fq = lane >> 4;
    const int K = g.K, nt = K / BK, lda = g.lda, ldb = g.ldb;
    unsigned voffA[2], voffB[2];
#pragma unroll
    for (int i = 0; i < 2; ++i) { int R, C; stage_rc(tid * 16 + i * 8192, R, C); const int Rb = Epi::PERM ? ((R & ~31) + perm32(R & 31)) : R;
        voffA[i] = (unsigned)(R * lda + C) * 2u; voffB[i] = (unsigned)(Rb * ldb + C) * 2u; }
    const size_t kstep = (size_t)(BK * 2);
    const size_t hstepA = (size_t)HALF * lda * 2, hstepB = (size_t)HALF * ldb * 2;
    const size_t tstepA = 2 * hstepA, tstepB = 2 * hstepB;
    const unsigned ldsw = (unsigned)wid * 1024u;
    const int aoff = lds_byte(wr * 64 + fr, fq * 8), boff = lds_byte(wc * 32 + fr, fq * 8);
#define PG8_SA(b, h) (((b) * 2 + (h)) * HTB)
#define PG8_SB(b, h) ((4 + (b) * 2 + (h)) * HTB)
#define PG8_STAGE(bufoff, gbase, voff) do { _Pragma("unroll") for (int _i = 0; _i < 2; ++_i) \
        __builtin_amdgcn_global_load_lds((const unsigned*)((const char*)(gbase) + (voff)[_i]), (PG8_LAS unsigned*)(lds + (bufoff) + ldsw + _i * 8192), 16, 0, 0); } while (0)
#define PG8_LDA(dst, b, h) do { _Pragma("unroll") for (int m = 0; m < 4; ++m) _Pragma("unroll") for (int k = 0; k < 2; ++k) dst[m][k] = *(const PG8_LAS bf16x8*)(lds + PG8_SA(b, h) + aoff + m * 2048 + k * 1024); } while (0)
#define PG8_LDB(dst, b, h) do { _Pragma("unroll") for (int n = 0; n < 2; ++n) _Pragma("unroll") for (int k = 0; k < 2; ++k) dst[n][k] = *(const PG8_LAS bf16x8*)(lds + PG8_SB(b, h) + boff + n * 2048 + k * 1024); } while (0)
#define PG8_MMA(ai, bj, At, Bt) do { __builtin_amdgcn_s_setprio(1); _Pragma("unroll") for (int m = 0; m < 4; ++m) _Pragma("unroll") for (int n = 0; n < 2; ++n) _Pragma("unroll") for (int k = 0; k < 2; ++k) \
        acc[ai][bj][m][n] = __builtin_amdgcn_mfma_f32_16x16x32_bf16(Bt[n][k], At[m][k], acc[ai][bj][m][n], 0, 0, 0); __builtin_amdgcn_s_setprio(0); } while (0)
#define PG8_WAIT_V(n) asm volatile("s_waitcnt vmcnt(" #n ")" ::: "memory")
#define PG8_WAIT_L(n) asm volatile("s_waitcnt lgkmcnt(" #n ")" ::: "memory")
#define PG8_BAR __builtin_amdgcn_s_barrier()
#define PG8_SCHED __builtin_amdgcn_sched_barrier(0)
    Unit cur, nxt; int ui = 0;
    if (!S.next(0, cur)) return;
    f32x4 acc[2][2][4][2];
#pragma unroll
    for (int a = 0; a < 2; ++a)
#pragma unroll
        for (int b = 0; b < 2; ++b)
#pragma unroll
            for (int m = 0; m < 4; ++m)
#pragma unroll
                for (int n = 0; n < 2; ++n) acc[a][b][m][n] = (f32x4){0.f, 0.f, 0.f, 0.f};
    bf16x8 At[4][2], B0[2][2], B1[2][2];
    const char* cA = (const char*)g.A + (size_t)cur.pm * tstepA + (size_t)(cur.koff + cur.aoff) * 2; const char* cB = (const char*)g.Bt + (size_t)cur.e * g.bstride + (size_t)cur.pn * tstepB + (size_t)cur.koff * 2;
    S.a_ready(cur);
    if constexpr (SP2) {
        PG8_STAGE(PG8_SB(0, 0), cB, voffB); PG8_STAGE(PG8_SB(0, 1), cB + hstepB, voffB); PG8_STAGE(PG8_SA(0, 0), cA, voffA); PG8_STAGE(PG8_SA(0, 1), cA + hstepA, voffA);
        if (wr == 1) PG8_BAR;
        PG8_WAIT_V(2); PG8_BAR;
        PG8_STAGE(PG8_SB(1, 0), cB + kstep, voffB); PG8_STAGE(PG8_SA(1, 0), cA + kstep, voffA); PG8_STAGE(PG8_SB(1, 1), cB + hstepB + kstep, voffB);
        PG8_WAIT_V(6); PG8_BAR;
    } else {
        PG8_STAGE(PG8_SB(0, 0), cB, voffB); PG8_STAGE(PG8_SA(0, 0), cA, voffA); PG8_STAGE(PG8_SB(0, 1), cB + hstepB, voffB); PG8_STAGE(PG8_SA(0, 1), cA + hstepA, voffA);
        if (wr == 1) PG8_BAR;
        PG8_WAIT_V(4); PG8_BAR;
        PG8_STAGE(PG8_SB(1, 0), cB + kstep, voffB); PG8_STAGE(PG8_SA(1, 0), cA + kstep, voffA); PG8_STAGE(PG8_SB(1, 1), cB + hstepB + kstep, voffB);
        PG8_WAIT_V(6); PG8_BAR;
    }
    for (;;) {
        const bool has_next = S.next(ui + 1, nxt);
        const char* nA = has_next ? (const char*)g.A + (size_t)nxt.pm * tstepA + (size_t)(nxt.koff + nxt.aoff) * 2 : cA; const char* nB = has_next ? (const char*)g.Bt + (size_t)nxt.e * g.bstride + (size_t)nxt.pn * tstepB + (size_t)nxt.koff * 2 : cB;
        for (int t = 0; t < nt; t += 2) {
            const bool last = (t == nt - 2);
            const char* a1 = cA + (size_t)(t + 1) * kstep;
            const char* a2 = last ? nA : cA + (size_t)(t + 2) * kstep; const char* b2 = last ? nB : cB + (size_t)(t + 2) * kstep;
            const char* a3 = a2 + kstep; const char* b3 = b2 + kstep;
            if (last && has_next) S.a_ready(nxt);
            if constexpr (SP2) {
            PG8_LDB(B0, 0, 0); PG8_LDB(B1, 0, 1); PG8_SCHED; PG8_LDA(At, 0, 0); PG8_STAGE(PG8_SA(1, 1), a1 + hstepA, voffA);
            PG8_WAIT_V(8); PG8_WAIT_L(0); PG8_BAR; PG8_MMA(0, 0, At, B0); PG8_MMA(0, 1, At, B1); PG8_BAR; PG8_SCHED;
            PG8_LDA(At, 0, 1); PG8_STAGE(PG8_SB(0, 0), b2, voffB); PG8_STAGE(PG8_SB(0, 1), b2 + hstepB, voffB); PG8_STAGE(PG8_SA(0, 0), a2, voffA);
            PG8_WAIT_V(8); PG8_WAIT_L(0); PG8_BAR; PG8_MMA(1, 0, At, B0); PG8_MMA(1, 1, At, B1); PG8_BAR; PG8_SCHED;
            PG8_LDB(B0, 1, 0); PG8_LDB(B1, 1, 1); PG8_SCHED; PG8_LDA(At, 1, 0); PG8_STAGE(PG8_SA(0, 1), a2 + hstepA, voffA);
            PG8_WAIT_V(8); PG8_WAIT_L(0); PG8_BAR; PG8_MMA(0, 0, At, B0); PG8_MMA(0, 1, At, B1); PG8_BAR; PG8_SCHED;
            PG8_LDA(At, 1, 1); PG8_STAGE(PG8_SB(1, 0), b3, voffB); PG8_STAGE(PG8_SB(1, 1), b3 + hstepB, voffB); PG8_STAGE(PG8_SA(1, 0), a3, voffA);
            PG8_WAIT_V(8); PG8_WAIT_L(0); PG8_BAR; PG8_MMA(1, 0, At, B0); PG8_MMA(1, 1, At, B1); PG8_BAR; PG8_SCHED;
            } else {
            PG8_LDB(B0, 0, 0); PG8_SCHED; PG8_LDA(At, 0, 0); PG8_STAGE(PG8_SA(1, 1), a1 + hstepA, voffA);
            PG8_WAIT_L(8); PG8_BAR; PG8_WAIT_L(0); PG8_MMA(0, 0, At, B0); PG8_BAR; PG8_SCHED;
            PG8_LDB(B1, 0, 1); PG8_STAGE(PG8_SB(0, 0), b2, voffB);
            PG8_BAR; PG8_WAIT_L(0); PG8_MMA(0, 1, At, B1); PG8_BAR;
            PG8_LDA(At, 0, 1); PG8_STAGE(PG8_SA(0, 0), a2, voffA);
            PG8_BAR; PG8_WAIT_L(0); PG8_MMA(1, 0, At, B0); PG8_BAR; PG8_SCHED;
            PG8_STAGE(PG8_SB(0, 1), b2 + hstepB, voffB);
            PG8_WAIT_V(6); PG8_BAR; PG8_MMA(1, 1, At, B1); PG8_BAR;
            PG8_LDB(B0, 1, 0); PG8_SCHED; PG8_LDA(At, 1, 0); PG8_STAGE(PG8_SA(0, 1), a2 + hstepA, voffA);
            PG8_WAIT_L(8); PG8_BAR; PG8_WAIT_L(0); PG8_MMA(0, 0, At, B0); PG8_BAR; PG8_SCHED;
            PG8_LDB(B1, 1, 1); PG8_STAGE(PG8_SB(1, 0), b3, voffB);
            PG8_BAR; PG8_WAIT_L(0); PG8_MMA(0, 1, At, B1); PG8_BAR;
            PG8_LDA(At, 1, 1); PG8_STAGE(PG8_SA(1, 0), a3, voffA);
            PG8_BAR; PG8_WAIT_L(0); PG8_MMA(1, 0, At, B0); PG8_BAR; PG8_SCHED;
            PG8_STAGE(PG8_SB(1, 1), b3 + hstepB, voffB);
            PG8_WAIT_V(6); PG8_BAR; PG8_MMA(1, 1, At, B1); PG8_BAR;
            }
        }
        if constexpr (ALIGN_EPI) { if (wr == 0) PG8_BAR; }
        if constexpr (!Epi::AFTER_DRAIN) { E(acc, cur, wr, wc, fr, fq); S.done(cur); }
        if (!has_next) break;
#pragma unroll
        for (int a = 0; a < 2; ++a)
#pragma unroll
            for (int b = 0; b < 2; ++b)
#pragma unroll
                for (int m = 0; m < 4; ++m)
#pragma unroll
                    for (int n = 0; n < 2; ++n) acc[a][b][m][n] = (f32x4){0.f, 0.f, 0.f, 0.f};
        cur = nxt; cA = nA; cB = nB; ++ui;
        if constexpr (ALIGN_EPI) { if (wr == 1) PG8_BAR; }
    }
    PG8_WAIT_V(0);
    if constexpr (!ALIGN_EPI) { if (wr == 0) PG8_BAR; }
    PG8_BAR;
    if constexpr (Epi::AFTER_DRAIN) { E.fused(acc, cur, wr, wc, fr, fq, lds, wid, lane); S.done(cur); }
#undef PG8_SA
#undef PG8_SB
#undef PG8_STAGE
#undef PG8_LDA
#undef PG8_LDB
#undef PG8_MMA
#undef PG8_WAIT_V
#undef PG8_WAIT_L
#undef PG8_BAR
#undef PG8_SCHED
}
}

#include <hip/hip_bf16.h>
#include <cmath>
namespace attn_body {
using bf16=__hip_bfloat16;
using bf16x8=__attribute__((ext_vector_type(8)))short;
using s16x4=__attribute__((ext_vector_type(4)))short;
using f32x16=__attribute__((ext_vector_type(16)))float;
using u32x4=__attribute__((ext_vector_type(4)))unsigned;
constexpr int D=64;
constexpr int NW=8,QBLK=32,QB=QBLK*NW,KVBLK=64;
__device__ __forceinline__ int crow(int r,int hi){return (r&3)+8*(r>>2)+4*hi;}
#define SBAR() __builtin_amdgcn_sched_barrier(0)
constexpr int NSLOT=3, SLOTB=8192;
constexpr int LDS_K=0, LDS_V=NSLOT*SLOTB, LDS_WS=2*NSLOT*SLOTB, LDS_OST=LDS_WS+NW*64*4, LDS_BYTES=LDS_OST+NW*4096;
constexpr int VSLOTB=16384, LDS_V2=NSLOT*SLOTB, LDS_WS2=LDS_V2+NSLOT*VSLOTB, LDS_OST2=LDS_WS2+NW*64*4, LDS_BYTES2=LDS_OST2+NW*4096;
constexpr float C2=0.125f*1.4426950408889634f;
__device__ __forceinline__ void glds16(const void*gsrc,unsigned lds_dst){unsigned keep;
  asm volatile("s_mov_b32 %0, m0\n\ts_mov_b32 m0, %2\n\ts_nop 0\n\tglobal_load_lds_dwordx4 %1, off\n\ts_mov_b32 m0, %0":"=&s"(keep):"v"(gsrc),"s"(lds_dst):"memory");}
__device__ __forceinline__ float max3f(float a,float b,float c){float r;asm("v_max3_f32 %0, %1, %2, %3":"=v"(r):"v"(a),"v"(b),"v"(c));return r;}
__device__ __forceinline__ float max2f(float a,float b){float r;asm("v_max_f32_e32 %0, %1, %2":"=v"(r):"v"(a),"v"(b));return r;}
__device__ __forceinline__ float fadd_s(float a,float b){float r;asm("v_add_f32_e32 %0, %1, %2":"=v"(r):"v"(a),"v"(b));return r;}
__device__ __forceinline__ float fsub_s(float a,float b){float r;asm("v_sub_f32_e32 %0, %1, %2":"=v"(r):"v"(a),"v"(b));return r;}
typedef float f32x2_t __attribute__((ext_vector_type(2))); typedef __bf16 bf16x2_t __attribute__((ext_vector_type(2)));
__device__ __forceinline__ unsigned cvtpk_s(float lo,float hi){f32x2_t v={lo,hi};bf16x2_t b=__builtin_convertvector(v,bf16x2_t);return __builtin_bit_cast(unsigned,b);}
#define WAIT_BAR(N) asm volatile("s_waitcnt vmcnt(" #N ") lgkmcnt(0)\n\ts_barrier":::"memory")

__device__ __forceinline__ void qkt(f32x16&p0,f32x16&p1,const char*Kslot,const bf16x8*qr,const f32x16&negm,int r32,int hi){
  const char*kb=Kslot+hi*1024+r32*16;
  #pragma unroll
  for(int d0=0;d0<4;++d0){
    const bf16x8 b0=*reinterpret_cast<const bf16x8*>(kb+d0*2048);
    const bf16x8 b1=*reinterpret_cast<const bf16x8*>(kb+d0*2048+512);
    if(d0==0){p0=__builtin_amdgcn_mfma_f32_32x32x16_bf16(b0,qr[0],negm,0,0,0);p1=__builtin_amdgcn_mfma_f32_32x32x16_bf16(b1,qr[0],negm,0,0,0);}
    else{p0=__builtin_amdgcn_mfma_f32_32x32x16_bf16(b0,qr[d0],p0,0,0,0);p1=__builtin_amdgcn_mfma_f32_32x32x16_bf16(b1,qr[d0],p1,0,0,0);}}
}
typedef __attribute__((address_space(3))) const char* lds_cptr;
typedef short v4i16_t __attribute__((ext_vector_type(4)));
__device__ __forceinline__ void kload8(bf16x8*kf,lds_cptr kp){
  kf[0]=*(const __attribute__((address_space(3))) bf16x8*)(kp);      kf[1]=*(const __attribute__((address_space(3))) bf16x8*)(kp+512);
  kf[2]=*(const __attribute__((address_space(3))) bf16x8*)(kp+2048); kf[3]=*(const __attribute__((address_space(3))) bf16x8*)(kp+2560);
  kf[4]=*(const __attribute__((address_space(3))) bf16x8*)(kp+4096); kf[5]=*(const __attribute__((address_space(3))) bf16x8*)(kp+4608);
  kf[6]=*(const __attribute__((address_space(3))) bf16x8*)(kp+6144); kf[7]=*(const __attribute__((address_space(3))) bf16x8*)(kp+6656);
}
__device__ __forceinline__ void kload2(bf16x8*kf,lds_cptr kp,int j){ kf[2*j]=*(const __attribute__((address_space(3))) bf16x8*)(kp+j*2048); kf[2*j+1]=*(const __attribute__((address_space(3))) bf16x8*)(kp+j*2048+512); }
__device__ __forceinline__ s16x4 vtr(lds_cptr p){ return __builtin_bit_cast(s16x4,__builtin_amdgcn_ds_read_tr16_b64_v4i16((__attribute__((address_space(3))) v4i16_t*)p)); }
__device__ __forceinline__ float rowmax(const f32x16&p0,const f32x16&p1){
  float a=max3f(p0[0],p0[1],p1[0]),b=max3f(p0[2],p0[3],p1[1]);a=max3f(a,p1[2],p1[3]);
  #pragma unroll
  for(int r=4;r<16;r+=4){a=max3f(a,p0[r],p0[r+1]);b=max3f(b,p0[r+2],p0[r+3]);a=max3f(a,p1[r],p1[r+1]);b=max3f(b,p1[r+2],p1[r+3]);}
  const float m=max2f(a,b);
  auto rr=__builtin_amdgcn_permlane32_swap(__float_as_uint(m),__float_as_uint(m),false,false);
  return max2f(__uint_as_float(rr[0]),__uint_as_float(rr[1]));
}
__device__ __forceinline__ void pv(f32x16*o,int vb,bf16x8 pa0,bf16x8 pa1,bf16x8 pa2,bf16x8 pa3){
  #pragma unroll
  for(int d0=0;d0<2;++d0){s16x4 lo[4],hi[4];
    #pragma unroll
    for(int ks=0;ks<4;++ks){
      asm volatile("ds_read_b64_tr_b16 %0,%1 offset:%c2":"=&v"(lo[ks]):"v"(vb),"i"(d0*4096+ks*1024):"memory");
      asm volatile("ds_read_b64_tr_b16 %0,%1 offset:%c2":"=&v"(hi[ks]):"v"(vb),"i"(d0*4096+ks*1024+512):"memory");}
    asm volatile("s_waitcnt lgkmcnt(0)":::"memory");SBAR();
    #define PK(k) (bf16x8){lo[k][0],lo[k][1],lo[k][2],lo[k][3],hi[k][0],hi[k][1],hi[k][2],hi[k][3]}
    o[d0]=__builtin_amdgcn_mfma_f32_32x32x16_bf16(pa0,PK(0),o[d0],0,0,0);
    o[d0]=__builtin_amdgcn_mfma_f32_32x32x16_bf16(pa1,PK(1),o[d0],0,0,0);
    o[d0]=__builtin_amdgcn_mfma_f32_32x32x16_bf16(pa2,PK(2),o[d0],0,0,0);
    o[d0]=__builtin_amdgcn_mfma_f32_32x32x16_bf16(pa3,PK(3),o[d0],0,0,0);
    #undef PK
  }
}

__device__ __forceinline__ void pv4(f32x16*o,int vb,bf16x8 pa0,bf16x8 pa1,bf16x8 pa2,bf16x8 pa3){
  #pragma unroll
  for(int d0=0;d0<4;++d0){s16x4 lo[4],hi[4];
    #pragma unroll
    for(int ks=0;ks<4;++ks){
      asm volatile("ds_read_b64_tr_b16 %0,%1 offset:%c2":"=&v"(lo[ks]):"v"(vb),"i"(d0*4096+ks*1024):"memory");
      asm volatile("ds_read_b64_tr_b16 %0,%1 offset:%c2":"=&v"(hi[ks]):"v"(vb),"i"(d0*4096+ks*1024+512):"memory");}
    asm volatile("s_waitcnt lgkmcnt(0)":::"memory");SBAR();
    #define PK(k) (bf16x8){lo[k][0],lo[k][1],lo[k][2],lo[k][3],hi[k][0],hi[k][1],hi[k][2],hi[k][3]}
    o[d0]=__builtin_amdgcn_mfma_f32_32x32x16_bf16(pa0,PK(0),o[d0],0,0,0);
    o[d0]=__builtin_amdgcn_mfma_f32_32x32x16_bf16(pa1,PK(1),o[d0],0,0,0);
    o[d0]=__builtin_amdgcn_mfma_f32_32x32x16_bf16(pa2,PK(2),o[d0],0,0,0);
    o[d0]=__builtin_amdgcn_mfma_f32_32x32x16_bf16(pa3,PK(3),o[d0],0,0,0);
    #undef PK
  }
}

#ifndef ATTN_STORE16
#define ATTN_STORE16(p,v) (*(u32x4*)(p)=(v))
#endif
template<int THRL> __device__ __forceinline__ void attn_unit(const bf16*Q0,int qp,const bf16*__restrict__ K0,int kp,const bf16*__restrict__ V0,int vp,bf16*O0,int op,const int NT,char*shm,const int wave0){
  int tid_=wave0*64+lane_id_(); asm volatile("":"+v"(tid_)); const int tid=tid_,lane=tid&63,r32=lane&31,hi=lane>>5; const int wid=__builtin_amdgcn_readfirstlane(tid>>6);
  const bf16*Qw=Q0+(long)(wid*QBLK)*qp;
  const bf16*Kh=K0,*Vh=V0;
  const unsigned lds0=(unsigned)(uintptr_t)shm;
  float*wsf=(float*)(shm+LDS_WS)+wid*64;
  const bf16*ksrc=Kh+(long)lane*kp+wid*8;
  const bf16*vsrc=Vh+(long)(16*(wid&3)+(lane>>2))*vp+(wid>>2)*32+(lane&3)*8;
  const unsigned kdst=lds0+LDS_K+wid*1024, vdst=lds0+LDS_V+wid*1024;
  #define DMA_K(t,slot) glds16(ksrc+(long)(t)*KVBLK*kp,(unsigned)__builtin_amdgcn_readfirstlane(kdst+(slot)))
  #define DMA_V(t,slot) glds16(vsrc+(long)(t)*KVBLK*vp,(unsigned)__builtin_amdgcn_readfirstlane(vdst+(slot)))
  const int vb0=(int)(lds0+LDS_V)+((lane>>4)&1)*32+(lane&3)*8+(4*hi+((lane&15)>>2))*64;
  const char*Kbase=shm+LDS_K; bf16x8 kf[8];
  const lds_cptr shm3=(lds_cptr)shm; const lds_cptr kp0=shm3+LDS_K+hi*1024+r32*16; const lds_cptr vp0=shm3+LDS_V+((lane>>4)&1)*32+(lane&3)*8+(4*hi+((lane&15)>>2))*64;
  DMA_K(0,0);DMA_V(0,0);DMA_K(1,SLOTB);
  bf16x8 qr[4];
  #pragma unroll
  for(int d0=0;d0<4;++d0)qr[d0]=*reinterpret_cast<const bf16x8*>(&Qw[(long)r32*qp+d0*16+hi*8]);
  float mhat=0.f,l_reg=0.f;f32x16 o[2];o[0]=f32x16{};o[1]=f32x16{};f32x16 negm=f32x16{};asm volatile("":"+v"(negm));
  #define CMASK(P0,P1,t) do{}while(0)
  bool resc=false;
  #define START(P0,P1) do{ const float rm=rowmax(P0,P1); resc=false; \
    { const float dl=rm; mhat=fadd_s(mhat,dl); \
      _Pragma("unroll") for(int r=0;r<16;++r){P0[r]=fsub_s(P0[r],dl);P1[r]=fsub_s(P1[r],dl);} \
      _Pragma("unroll") for(int r=0;r<16;++r)negm[r]=-mhat; asm volatile("":"+v"(negm)); } \
    _Pragma("unroll") for(int r=0;r<16;++r)P0[r]=__builtin_amdgcn_exp2f(P0[r]); }while(0)
  #define RESC() do{ if(resc){ asm volatile("s_waitcnt lgkmcnt(0)":::"memory"); \
      _Pragma("unroll") for(int d_=0;d_<2;++d_) _Pragma("unroll") for(int r=0;r<16;++r)o[d_][r]*=wsf[crow(r,hi)]; } }while(0)
  f32x16 pA0,pA1,pB0,pB1;
  int sl_prev=0,sl_cur=0,sl_next=SLOTB;
  #define ROT() do{sl_prev=sl_cur;sl_cur=sl_next;sl_next=(sl_next==(NSLOT-1)*SLOTB)?0:sl_next+SLOTB;}while(0)
  DMA_K(2,2*SLOTB);
  WAIT_BAR(3);
  qkt(pA0,pA1,Kbase,qr,negm,r32,hi);asm volatile("s_nop 15\n\ts_nop 7":"+v"(pA0),"+v"(pA1));CMASK(pA0,pA1,0);
  START(pA0,pA1);
  _Pragma("unroll") for(int r=0;r<16;++r)pA1[r]=__builtin_amdgcn_exp2f(pA1[r]);
  WAIT_BAR(0);
  DMA_K(3,0);DMA_V(1,SLOTB);
  ROT();
  kload8(kf,kp0+sl_cur);
  WAIT_BAR(2);
  s16x4 vlo[8],vhi[8]; u32x4 pw0,pw1,pw2,pw3;
  #define PKW(P,B) cvtpk_s(P[B],P[B+1])
  #define PAF(k) __builtin_bit_cast(bf16x8,pw##k)
  #define VFR(i) (bf16x8){vlo[i][0],vlo[i][1],vlo[i][2],vlo[i][3],vhi[i][0],vhi[i][1],vhi[i][2],vhi[i][3]}
  #define PIN(x) asm volatile("":"+v"(x))
  #define MX3(a,b,c) __builtin_fmaxf(__builtin_fmaxf((a),(b)),(c))
  #define GAPA(MF,A0,A1,A2,A3,W0,W1,PW) do{ MF; sacc+=A0; sacc+=A1; sacc+=A2; sacc+=A3; PIN(sacc); W0; W1; PIN(PW); SBAR(); }while(0)
  #define EX(v) __builtin_amdgcn_exp2f(v)
  #define GAPB(MF,X,B) do{ MF; X[B]=EX(X[B]); X[B+1]=EX(X[B+1]); X[B+2]=EX(X[B+2]); X[B+3]=EX(X[B+3]); PIN(X); SBAR(); }while(0)
  #define VRD(i) do{ vlo[i]=vtr(vp_+(((i)>>2)*4096+((i)&3)*1024)); vhi[i]=vtr(vp_+(((i)>>2)*4096+((i)&3)*1024+512)); }while(0)
  #define KRD(G,j) do{ if(G){ kload2(kf,kp0+sl_next,j); SBAR(); } }while(0)
  #define STEP(C0,C1,P0,P1,t,GK,GV,GL) do{ SBAR(); \
    const lds_cptr vp_=vp0+sl_prev; \
    VRD(0); SBAR(); float sacc=(P0[0]+P0[1]); \
    GAPA(C0=__builtin_amdgcn_mfma_f32_32x32x16_bf16(kf[0],qr[0],negm,0,0,0), P0[2],P0[3],P0[4],P0[5],     pw0[0]=PKW(P0,0), pw0[1]=PKW(P0,2), pw0); \
    VRD(4); SBAR(); GAPA(C1=__builtin_amdgcn_mfma_f32_32x32x16_bf16(kf[1],qr[0],negm,0,0,0), P0[6],P0[7],P0[8],P0[9],     pw0[2]=PKW(P0,4), pw0[3]=PKW(P0,6), pw0); \
    VRD(1); SBAR(); GAPA(C0=__builtin_amdgcn_mfma_f32_32x32x16_bf16(kf[2],qr[1],C0,0,0,0),   P0[10],P0[11],P0[12],P0[13], pw1[0]=PKW(P0,8), pw1[1]=PKW(P0,10), pw1); \
    VRD(5); SBAR(); GAPA(C1=__builtin_amdgcn_mfma_f32_32x32x16_bf16(kf[3],qr[1],C1,0,0,0),   P0[14],P0[15],P1[0],P1[1],   pw1[2]=PKW(P0,12),pw1[3]=PKW(P0,14), pw1); \
    VRD(2); SBAR(); GAPA(C0=__builtin_amdgcn_mfma_f32_32x32x16_bf16(kf[4],qr[2],C0,0,0,0),   P1[2],P1[3],P1[4],P1[5],     pw2[0]=PKW(P1,0), pw2[1]=PKW(P1,2), pw2); \
    VRD(6); SBAR(); GAPA(C1=__builtin_amdgcn_mfma_f32_32x32x16_bf16(kf[5],qr[2],C1,0,0,0),   P1[6],P1[7],P1[8],P1[9],     pw2[2]=PKW(P1,4), pw2[3]=PKW(P1,6), pw2); \
    VRD(3); SBAR(); GAPA(C0=__builtin_amdgcn_mfma_f32_32x32x16_bf16(kf[6],qr[3],C0,0,0,0),   P1[10],P1[11],P1[12],P1[13], pw3[0]=PKW(P1,8), pw3[1]=PKW(P1,10), pw3); \
    VRD(7); SBAR(); GAPA(C1=__builtin_amdgcn_mfma_f32_32x32x16_bf16(kf[7],qr[3],C1,0,0,0),   P1[14],P1[15],0.f,0.f,       pw3[2]=PKW(P1,12),pw3[3]=PKW(P1,14), pw3); \
    l_reg+=sacc; \
    if(GK){DMA_K((t)+3,sl_cur);} if(GV){DMA_V((t)+1,sl_next);} \
    CMASK(C0,C1,t); \
    { float a=MX3(C0[0],C0[1],C1[0]),b=MX3(C0[2],C0[3],C1[1]); a=MX3(a,C1[2],C1[3]); \
      _Pragma("unroll") for(int r=4;r<16;r+=4){a=MX3(a,C0[r],C0[r+1]);b=MX3(b,C0[r+2],C0[r+3]);a=MX3(a,C1[r],C1[r+1]);b=MX3(b,C1[r+2],C1[r+3]);} \
      float rm=__builtin_fmaxf(a,b); { auto rr=__builtin_amdgcn_permlane32_swap(__float_as_uint(rm),__float_as_uint(rm),false,false); rm=__builtin_fmaxf(__uint_as_float(rr[0]),__uint_as_float(rr[1])); } \
      resc=false; \
      if(__builtin_expect(__any(rm>(float)THRL),0)){ const float dl=__builtin_fmaxf(rm,0.f); mhat+=dl; \
        _Pragma("unroll") for(int r=0;r<16;++r){C0[r]-=dl;C1[r]-=dl;} \
        _Pragma("unroll") for(int r=0;r<16;++r)negm[r]=-mhat; asm volatile("":"+v"(negm)); \
        const float f=__builtin_amdgcn_exp2f(-dl); l_reg*=f; if(hi==0)wsf[r32]=f; resc=true; } } \
    SBAR(); \
    GAPB(o[0]=__builtin_amdgcn_mfma_f32_32x32x16_bf16(PAF(0),VFR(0),o[0],0,0,0), C0,0); \
    GAPB(o[1]=__builtin_amdgcn_mfma_f32_32x32x16_bf16(PAF(0),VFR(4),o[1],0,0,0), C0,4); \
    KRD(GL,0); GAPB(o[0]=__builtin_amdgcn_mfma_f32_32x32x16_bf16(PAF(1),VFR(1),o[0],0,0,0), C0,8); \
    KRD(GL,1); GAPB(o[1]=__builtin_amdgcn_mfma_f32_32x32x16_bf16(PAF(1),VFR(5),o[1],0,0,0), C0,12); \
    KRD(GL,2); GAPB(o[0]=__builtin_amdgcn_mfma_f32_32x32x16_bf16(PAF(2),VFR(2),o[0],0,0,0), C1,0); \
    KRD(GL,3); GAPB(o[1]=__builtin_amdgcn_mfma_f32_32x32x16_bf16(PAF(2),VFR(6),o[1],0,0,0), C1,4); \
    GAPB(o[0]=__builtin_amdgcn_mfma_f32_32x32x16_bf16(PAF(3),VFR(3),o[0],0,0,0), C1,8); \
    GAPB(o[1]=__builtin_amdgcn_mfma_f32_32x32x16_bf16(PAF(3),VFR(7),o[1],0,0,0), C1,12); \
    }while(0)
  int t=1;
  #undef CMASK
  #define CMASK(P0,P1,t) do{}while(0)
  for(;t+5<NT;t+=2){
    STEP(pB0,pB1,pA0,pA1,t,true,true,true);     WAIT_BAR(2); RESC(); ROT();
    STEP(pA0,pA1,pB0,pB1,t+1,true,true,true);   WAIT_BAR(2); RESC(); ROT();
  }
  #undef CMASK
  #define CMASK(P0,P1,t) do{}while(0)
  #define ENDW(tt) do{ if((tt)+3<NT){WAIT_BAR(2);} else if((tt)+2<NT){WAIT_BAR(1);} else {WAIT_BAR(0);} }while(0)
  for(;t+1<NT;t+=2){
    STEP(pB0,pB1,pA0,pA1,t,(t+3<NT),(t+1<NT),(t+1<NT));       ENDW(t);   RESC(); ROT();
    STEP(pA0,pA1,pB0,pB1,t+1,(t+4<NT),(t+2<NT),(t+2<NT));     ENDW(t+1); RESC(); ROT();
  }
  STEP(pB0,pB1,pA0,pA1,NT-1,false,false,false); RESC();
  { float sacc=pB0[0]+pB0[1]; _Pragma("unroll") for(int r=2;r<16;++r)sacc+=pB0[r]; _Pragma("unroll") for(int r=0;r<16;++r)sacc+=pB1[r]; l_reg+=sacc;
    pw0=(u32x4){PKW(pB0,0),PKW(pB0,2),PKW(pB0,4),PKW(pB0,6)};pw1=(u32x4){PKW(pB0,8),PKW(pB0,10),PKW(pB0,12),PKW(pB0,14)};pw2=(u32x4){PKW(pB1,0),PKW(pB1,2),PKW(pB1,4),PKW(pB1,6)};pw3=(u32x4){PKW(pB1,8),PKW(pB1,10),PKW(pB1,12),PKW(pB1,14)};
    SBAR(); pv(o,vb0+sl_cur,PAF(0),PAF(1),PAF(2),PAF(3)); }
  #undef PKW
  #undef PAF
  #undef VFR
  #undef PIN
  #undef MX3
  #undef GAPA
  #undef GAPB
  #undef EX
  #undef VRD
  #undef KRD
  #undef STEP
  #undef ENDW
  {auto rr=__builtin_amdgcn_permlane32_swap(__float_as_uint(l_reg),__float_as_uint(l_reg),false,false);l_reg=__uint_as_float(rr[0])+__uint_as_float(rr[1]);}
  if(hi==0)wsf[32+r32]=l_reg;asm volatile("s_waitcnt lgkmcnt(0)":::"memory");
  float rli[16];
  #pragma unroll
  for(int r=0;r<16;++r)rli[r]=__builtin_amdgcn_rcpf(wsf[32+crow(r,hi)]);
  bf16*Ow=O0+(long)(wid*QBLK)*op;
  { bf16*stg=(bf16*)(shm+LDS_OST)+wid*2048;
    #pragma unroll
    for(int r=0;r<16;++r){const int orow=crow(r,hi);
      #pragma unroll
      for(int d0=0;d0<2;++d0)stg[orow*64+d0*32+r32]=__float2bfloat16(o[d0][r]*rli[r]);}
    asm volatile("s_waitcnt lgkmcnt(0)":::"memory");
    #pragma unroll
    for(int i=0;i<4;++i){const int row=i*8+(lane>>3),ch=lane&7; const u32x4 v=*(const u32x4*)(stg+row*64+ch*8); ATTN_STORE16(Ow+(long)row*op+ch*8,v);} }
  asm volatile("s_waitcnt lgkmcnt(0)\n\ts_barrier":::"memory");
  #undef DMA_K
  #undef DMA_V
  #undef CMASK
  #undef START
  #undef RESC
  #undef ROT
}
template<int THRL> __device__ __forceinline__ void attn_unit_dv(const bf16*Q0,int qp,const bf16*__restrict__ K0,int kp,const bf16*__restrict__ V0,int vp,bf16*O0,int op,const int NT,char*shm,const int wave0){
  int tid_=wave0*64+lane_id_(); asm volatile("":"+v"(tid_)); const int tid=tid_,lane=tid&63,r32=lane&31,hi=lane>>5; const int wid=__builtin_amdgcn_readfirstlane(tid>>6);
  const bf16*Qw=Q0+(long)(wid*QBLK)*qp;
  const bf16*Kh=K0,*Vh=V0;
  const unsigned lds0=(unsigned)(uintptr_t)shm;
  float*wsf=(float*)(shm+LDS_WS2)+wid*64;
  const bf16*ksrc=Kh+(long)lane*kp+wid*8;
  const bf16*vsrc=Vh+(long)(16*(wid&3)+(lane>>2))*vp+(wid>>2)*32+(lane&3)*8;
  const unsigned kdst=lds0+LDS_K+wid*1024, vdst=lds0+LDS_V2+wid*1024;
  #define DMA_K(t,slot) glds16(ksrc+(long)(t)*KVBLK*kp,(unsigned)__builtin_amdgcn_readfirstlane(kdst+(slot)))
  #define DMA_V(t,slot) do{ glds16(vsrc+(long)(t)*KVBLK*vp,(unsigned)__builtin_amdgcn_readfirstlane(vdst+2*(slot))); glds16(vsrc+(long)(t)*KVBLK*vp+64,(unsigned)__builtin_amdgcn_readfirstlane(vdst+2*(slot)+8192)); }while(0)
  const int vb0=(int)(lds0+LDS_V2)+((lane>>4)&1)*32+(lane&3)*8+(4*hi+((lane&15)>>2))*64;
  const char*Kbase=shm+LDS_K; bf16x8 kf[8];
  const lds_cptr shm3=(lds_cptr)shm; const lds_cptr kp0=shm3+LDS_K+hi*1024+r32*16; const lds_cptr vp0=shm3+LDS_V2+((lane>>4)&1)*32+(lane&3)*8+(4*hi+((lane&15)>>2))*64;
  DMA_K(0,0);DMA_V(0,0);DMA_K(1,SLOTB);
  bf16x8 qr[4];
  #pragma unroll
  for(int d0=0;d0<4;++d0)qr[d0]=*reinterpret_cast<const bf16x8*>(&Qw[(long)r32*qp+d0*16+hi*8]);
  float mhat=0.f,l_reg=0.f;f32x16 o[4];o[0]=f32x16{};o[1]=f32x16{};o[2]=f32x16{};o[3]=f32x16{};f32x16 negm=f32x16{};asm volatile("":"+v"(negm));
  #define CMASK(P0,P1,t) do{}while(0)
  bool resc=false;
  #define START(P0,P1) do{ const float rm=rowmax(P0,P1); resc=false; \
    { const float dl=rm; mhat=fadd_s(mhat,dl); \
      _Pragma("unroll") for(int r=0;r<16;++r){P0[r]=fsub_s(P0[r],dl);P1[r]=fsub_s(P1[r],dl);} \
      _Pragma("unroll") for(int r=0;r<16;++r)negm[r]=-mhat; asm volatile("":"+v"(negm)); } \
    _Pragma("unroll") for(int r=0;r<16;++r)P0[r]=__builtin_amdgcn_exp2f(P0[r]); }while(0)
  #define RESC() do{ if(resc){ asm volatile("s_waitcnt lgkmcnt(0)":::"memory"); \
      _Pragma("unroll") for(int d_=0;d_<4;++d_) _Pragma("unroll") for(int r=0;r<16;++r)o[d_][r]*=wsf[crow(r,hi)]; } }while(0)
  f32x16 pA0,pA1,pB0,pB1;
  int sl_prev=0,sl_cur=0,sl_next=SLOTB;
  #define ROT() do{sl_prev=sl_cur;sl_cur=sl_next;sl_next=(sl_next==(NSLOT-1)*SLOTB)?0:sl_next+SLOTB;}while(0)
  DMA_K(2,2*SLOTB);
  WAIT_BAR(4);
  qkt(pA0,pA1,Kbase,qr,negm,r32,hi);asm volatile("s_nop 15\n\ts_nop 7":"+v"(pA0),"+v"(pA1));CMASK(pA0,pA1,0);
  START(pA0,pA1);
  _Pragma("unroll") for(int r=0;r<16;++r)pA1[r]=__builtin_amdgcn_exp2f(pA1[r]);
  WAIT_BAR(0);
  DMA_K(3,0);DMA_V(1,SLOTB);
  ROT();
  kload8(kf,kp0+sl_cur);
  WAIT_BAR(3);
  s16x4 vlo[16],vhi[16]; u32x4 pw0,pw1,pw2,pw3;
  #define PKW(P,B) cvtpk_s(P[B],P[B+1])
  #define PAF(k) __builtin_bit_cast(bf16x8,pw##k)
  #define VFR(i) (bf16x8){vlo[i][0],vlo[i][1],vlo[i][2],vlo[i][3],vhi[i][0],vhi[i][1],vhi[i][2],vhi[i][3]}
  #define PIN(x) asm volatile("":"+v"(x))
  #define MX3(a,b,c) __builtin_fmaxf(__builtin_fmaxf((a),(b)),(c))
  #define GAPA(MF,A0,A1,A2,A3,W0,W1,PW) do{ MF; sacc+=A0; sacc+=A1; sacc+=A2; sacc+=A3; PIN(sacc); W0; W1; PIN(PW); SBAR(); }while(0)
  #define EX(v) __builtin_amdgcn_exp2f(v)
  #define GAPB(MF,X,B) do{ MF; X[B]=EX(X[B]); X[B+1]=EX(X[B+1]); PIN(X); SBAR(); }while(0)
  #define VRD(i) do{ vlo[i]=vtr(vp_+(((i)>>2)*4096+((i)&3)*1024)); vhi[i]=vtr(vp_+(((i)>>2)*4096+((i)&3)*1024+512)); }while(0)
  #define KRD(G,j) do{ if(G){ kload2(kf,kp0+sl_next,j); SBAR(); } }while(0)
  #define STEP(C0,C1,P0,P1,t,GK,GV,GL) do{ SBAR(); \
    const lds_cptr vp_=vp0+2*sl_prev; \
    float sacc=(P0[0]+P0[1]); \
    GAPA(C0=__builtin_amdgcn_mfma_f32_32x32x16_bf16(kf[0],qr[0],negm,0,0,0), P0[2],P0[3],P0[4],P0[5],     pw0[0]=PKW(P0,0), pw0[1]=PKW(P0,2), pw0); \
    GAPA(C1=__builtin_amdgcn_mfma_f32_32x32x16_bf16(kf[1],qr[0],negm,0,0,0), P0[6],P0[7],P0[8],P0[9],     pw0[2]=PKW(P0,4), pw0[3]=PKW(P0,6), pw0); \
    GAPA(C0=__builtin_amdgcn_mfma_f32_32x32x16_bf16(kf[2],qr[1],C0,0,0,0),   P0[10],P0[11],P0[12],P0[13], pw1[0]=PKW(P0,8), pw1[1]=PKW(P0,10), pw1); \
    GAPA(C1=__builtin_amdgcn_mfma_f32_32x32x16_bf16(kf[3],qr[1],C1,0,0,0),   P0[14],P0[15],P1[0],P1[1],   pw1[2]=PKW(P0,12),pw1[3]=PKW(P0,14), pw1); \
    VRD(0); SBAR(); GAPA(C0=__builtin_amdgcn_mfma_f32_32x32x16_bf16(kf[4],qr[2],C0,0,0,0),   P1[2],P1[3],P1[4],P1[5],     pw2[0]=PKW(P1,0), pw2[1]=PKW(P1,2), pw2); \
    VRD(4); SBAR(); GAPA(C1=__builtin_amdgcn_mfma_f32_32x32x16_bf16(kf[5],qr[2],C1,0,0,0),   P1[6],P1[7],P1[8],P1[9],     pw2[2]=PKW(P1,4), pw2[3]=PKW(P1,6), pw2); \
    VRD(1); SBAR(); GAPA(C0=__builtin_amdgcn_mfma_f32_32x32x16_bf16(kf[6],qr[3],C0,0,0,0),   P1[10],P1[11],P1[12],P1[13], pw3[0]=PKW(P1,8), pw3[1]=PKW(P1,10), pw3); \
    VRD(5); SBAR(); GAPA(C1=__builtin_amdgcn_mfma_f32_32x32x16_bf16(kf[7],qr[3],C1,0,0,0),   P1[14],P1[15],0.f,0.f,       pw3[2]=PKW(P1,12),pw3[3]=PKW(P1,14), pw3); \
    l_reg+=sacc; \
    if(GK){DMA_K((t)+3,sl_cur);} if(GV){DMA_V((t)+1,sl_next);} \
    CMASK(C0,C1,t); \
    { float a=MX3(C0[0],C0[1],C1[0]),b=MX3(C0[2],C0[3],C1[1]); a=MX3(a,C1[2],C1[3]); \
      _Pragma("unroll") for(int r=4;r<16;r+=4){a=MX3(a,C0[r],C0[r+1]);b=MX3(b,C0[r+2],C0[r+3]);a=MX3(a,C1[r],C1[r+1]);b=MX3(b,C1[r+2],C1[r+3]);} \
      float rm=__builtin_fmaxf(a,b); { auto rr=__builtin_amdgcn_permlane32_swap(__float_as_uint(rm),__float_as_uint(rm),false,false); rm=__builtin_fmaxf(__uint_as_float(rr[0]),__uint_as_float(rr[1])); } \
      resc=false; \
      if(__builtin_expect(__any(rm>(float)THRL),0)){ const float dl=__builtin_fmaxf(rm,0.f); mhat+=dl; \
        _Pragma("unroll") for(int r=0;r<16;++r){C0[r]-=dl;C1[r]-=dl;} \
        _Pragma("unroll") for(int r=0;r<16;++r)negm[r]=-mhat; asm volatile("":"+v"(negm)); \
        const float f=__builtin_amdgcn_exp2f(-dl); l_reg*=f; if(hi==0)wsf[r32]=f; resc=true; } } \
    SBAR(); \
    VRD(2); SBAR(); GAPB(o[0]=__builtin_amdgcn_mfma_f32_32x32x16_bf16(PAF(0),VFR(0),o[0],0,0,0), C0,0); \
    VRD(6); SBAR(); GAPB(o[1]=__builtin_amdgcn_mfma_f32_32x32x16_bf16(PAF(0),VFR(4),o[1],0,0,0), C0,2); \
    VRD(3); SBAR(); GAPB(o[0]=__builtin_amdgcn_mfma_f32_32x32x16_bf16(PAF(1),VFR(1),o[0],0,0,0), C0,4); \
    VRD(7); SBAR(); GAPB(o[1]=__builtin_amdgcn_mfma_f32_32x32x16_bf16(PAF(1),VFR(5),o[1],0,0,0), C0,6); \
    VRD(8); SBAR(); GAPB(o[0]=__builtin_amdgcn_mfma_f32_32x32x16_bf16(PAF(2),VFR(2),o[0],0,0,0), C0,8); \
    VRD(12); SBAR(); GAPB(o[1]=__builtin_amdgcn_mfma_f32_32x32x16_bf16(PAF(2),VFR(6),o[1],0,0,0), C0,10); \
    VRD(9); SBAR(); GAPB(o[0]=__builtin_amdgcn_mfma_f32_32x32x16_bf16(PAF(3),VFR(3),o[0],0,0,0), C0,12); \
    VRD(13); SBAR(); GAPB(o[1]=__builtin_amdgcn_mfma_f32_32x32x16_bf16(PAF(3),VFR(7),o[1],0,0,0), C0,14); \
    VRD(10); SBAR(); GAPB(o[2]=__builtin_amdgcn_mfma_f32_32x32x16_bf16(PAF(0),VFR(8),o[2],0,0,0), C1,0); \
    VRD(14); SBAR(); GAPB(o[3]=__builtin_amdgcn_mfma_f32_32x32x16_bf16(PAF(0),VFR(12),o[3],0,0,0), C1,2); \
    VRD(11); SBAR(); GAPB(o[2]=__builtin_amdgcn_mfma_f32_32x32x16_bf16(PAF(1),VFR(9),o[2],0,0,0), C1,4); \
    VRD(15); SBAR(); GAPB(o[3]=__builtin_amdgcn_mfma_f32_32x32x16_bf16(PAF(1),VFR(13),o[3],0,0,0), C1,6); \
    KRD(GL,0); GAPB(o[2]=__builtin_amdgcn_mfma_f32_32x32x16_bf16(PAF(2),VFR(10),o[2],0,0,0), C1,8); \
    KRD(GL,1); GAPB(o[3]=__builtin_amdgcn_mfma_f32_32x32x16_bf16(PAF(2),VFR(14),o[3],0,0,0), C1,10); \
    KRD(GL,2); GAPB(o[2]=__builtin_amdgcn_mfma_f32_32x32x16_bf16(PAF(3),VFR(11),o[2],0,0,0), C1,12); \
    KRD(GL,3); GAPB(o[3]=__builtin_amdgcn_mfma_f32_32x32x16_bf16(PAF(3),VFR(15),o[3],0,0,0), C1,14); \
    }while(0)
  int t=1;
  #undef CMASK
  #define CMASK(P0,P1,t) do{}while(0)
  for(;t+5<NT;t+=2){
    STEP(pB0,pB1,pA0,pA1,t,true,true,true);     WAIT_BAR(3); RESC(); ROT();
    STEP(pA0,pA1,pB0,pB1,t+1,true,true,true);   WAIT_BAR(3); RESC(); ROT();
  }
  #undef CMASK
  #define CMASK(P0,P1,t) do{}while(0)
  #define ENDW(tt) do{ if((tt)+3<NT){WAIT_BAR(3);} else if((tt)+2<NT){WAIT_BAR(2);} else {WAIT_BAR(0);} }while(0)
  for(;t+1<NT;t+=2){
    STEP(pB0,pB1,pA0,pA1,t,(t+3<NT),(t+1<NT),(t+1<NT));       ENDW(t);   RESC(); ROT();
    STEP(pA0,pA1,pB0,pB1,t+1,(t+4<NT),(t+2<NT),(t+2<NT));     ENDW(t+1); RESC(); ROT();
  }
  STEP(pB0,pB1,pA0,pA1,NT-1,false,false,false); RESC();
  { float sacc=pB0[0]+pB0[1]; _Pragma("unroll") for(int r=2;r<16;++r)sacc+=pB0[r]; _Pragma("unroll") for(int r=0;r<16;++r)sacc+=pB1[r]; l_reg+=sacc;
    pw0=(u32x4){PKW(pB0,0),PKW(pB0,2),PKW(pB0,4),PKW(pB0,6)};pw1=(u32x4){PKW(pB0,8),PKW(pB0,10),PKW(pB0,12),PKW(pB0,14)};pw2=(u32x4){PKW(pB1,0),PKW(pB1,2),PKW(pB1,4),PKW(pB1,6)};pw3=(u32x4){PKW(pB1,8),PKW(pB1,10),PKW(pB1,12),PKW(pB1,14)};
    SBAR(); pv4(o,vb0+2*sl_cur,PAF(0),PAF(1),PAF(2),PAF(3)); }
  #undef PKW
  #undef PAF
  #undef VFR
  #undef PIN
  #undef MX3
  #undef GAPA
  #undef GAPB
  #undef EX
  #undef VRD
  #undef KRD
  #undef STEP
  #undef ENDW
  {auto rr=__builtin_amdgcn_permlane32_swap(__float_as_uint(l_reg),__float_as_uint(l_reg),false,false);l_reg=__uint_as_float(rr[0])+__uint_as_float(rr[1]);}
  if(hi==0)wsf[32+r32]=l_reg;asm volatile("s_waitcnt lgkmcnt(0)":::"memory");
  float rli[16];
  #pragma unroll
  for(int r=0;r<16;++r)rli[r]=__builtin_amdgcn_rcpf(wsf[32+crow(r,hi)]);
  bf16*Ow=O0+(long)(wid*QBLK)*op;
  { bf16*stg=(bf16*)(shm+LDS_OST2)+wid*2048;
    #pragma unroll
    for(int hh=0;hh<2;++hh){
      #pragma unroll
      for(int r=0;r<16;++r){const int orow=crow(r,hi);
        #pragma unroll
        for(int d0=0;d0<2;++d0)stg[orow*64+d0*32+r32]=__float2bfloat16(o[2*hh+d0][r]*rli[r]);}
      asm volatile("s_waitcnt lgkmcnt(0)":::"memory");
      #pragma unroll
      for(int i=0;i<4;++i){const int row=i*8+(lane>>3),ch=lane&7; const u32x4 v=*(const u32x4*)(stg+row*64+ch*8); ATTN_STORE16(Ow+(long)row*op+hh*64+ch*8,v);}
      asm volatile("s_waitcnt lgkmcnt(0)":::"memory"); } }
  asm volatile("s_waitcnt lgkmcnt(0)\n\ts_barrier":::"memory");
  #undef DMA_K
  #undef DMA_V
  #undef CMASK
  #undef START
  #undef RESC
  #undef ROT
}
#undef SBAR
#undef WAIT_BAR
}

constexpr size_t MiB = 1u << 20;
constexpr size_t WS_CTL = 0, CTL_ZERO_BYTES = 1 * MiB;
constexpr size_t WS_MOD = 1 * MiB;
constexpr size_t WS_TAB = 1 * MiB + 256 * 1024;
constexpr size_t WS_LAM = 1 * MiB + 272 * 1024;
constexpr size_t WS_ME = 2 * MiB, WS_MP = 2 * MiB + 128 * 1024, WS_MW = 2 * MiB + 256 * 1024;
constexpr size_t WS_WIN = 4 * MiB;
constexpr size_t WS_WPRJ = 30 * MiB;
constexpr size_t WS_W13 = 42 * MiB;
constexpr size_t WS_W2F = 53 * MiB;
constexpr size_t WS_XC = 60 * MiB;
constexpr size_t WS_H = 64 * MiB;
constexpr size_t WS_P = 98 * MiB;
constexpr size_t WS_OA = 319 * MiB;
constexpr size_t WS_MX = 421 * MiB;
constexpr size_t WS_U = 98 * MiB;
constexpr size_t WS_MW2 = 4 * MiB;
constexpr size_t WS_HS = 98 * MiB;
constexpr size_t WS_U2 = 166 * MiB;
constexpr size_t WS_MW13 = 404 * MiB;
constexpr size_t WS_SLABJ = 192 * MiB;
constexpr size_t WS_SLABM = 64 * MiB;
constexpr size_t WS_SLABX = 456 * MiB, WS_SLABG = 488 * MiB;
constexpr size_t WS_END = 516 * MiB;
static_assert(WS_P + (size_t)MEXT * INW * 2 <= WS_OA && WS_OA + (size_t)MEXT * OAW * 2 <= WS_MX && WS_MX + (size_t)MEXT * DM * 2 <= WS_END, "attention-phase map");
static_assert(WS_HS + (size_t)MOE_ROWS * DM * 2 <= WS_U2 && WS_U2 + (size_t)MOE_ROWS * DFE * 2 <= WS_MW13 && WS_MW13 + (size_t)NEXP * 2 * DFE * DM * 2 <= WS_END && WS_MW2 + (size_t)NEXP * DFE * DM * 2 <= WS_XC, "MoE-phase map");
static_assert(WS_SLABX >= WS_MX + (size_t)MEXT * DM * 2 && WS_SLABX + (size_t)128 * 65536 * 4 <= WS_SLABG && WS_SLABG + (size_t)64 * 65536 * 4 <= WS_END, "mixer slab map");
static_assert(WS_SLABJ >= WS_U + (size_t)MEXT * DFF * 2 && WS_SLABJ + (size_t)176 * 65536 * 4 <= WS_OA && WS_SLABM + (size_t)128 * 65536 * 4 <= WS_HS, "slab map");
static_assert(WS_W2F + (size_t)DM * DFF * 2 <= WS_XC && WS_U + (size_t)MEXT * DFF * 2 <= WS_OA && WS_H + (size_t)MEXT * DM * 2 <= WS_P, "dense map");
constexpr int CW_BAR = 4096;
constexpr int CW_MOE = 8192;

constexpr int NWAVES = 8;
constexpr int RING_OFF = 0, RING_BYTES = 131072;
constexpr int LDSCTL_OFF = RING_BYTES, MISC_OFF = LDSCTL_OFF + 320;
constexpr int LDS_BYTES = 147456;
static_assert(MISC_OFF + 128 <= LDS_BYTES, "LDS map");

#define GAS __attribute__((address_space(1)))
#define LAS __attribute__((address_space(3)))
typedef unsigned short bf16;
typedef unsigned v4u __attribute__((ext_vector_type(4)));
typedef float f32x4 __attribute__((ext_vector_type(4)));
typedef short bf16x8 __attribute__((ext_vector_type(8)));
typedef GAS unsigned gu32;
typedef GAS unsigned long long gu64;
#define RLX_AGENT __ATOMIC_RELAXED, __HIP_MEMORY_SCOPE_AGENT
#define LDS_WAIT() asm volatile("s_waitcnt lgkmcnt(0)" ::: "memory")
#define VM_WAIT() asm volatile("s_waitcnt vmcnt(0)" ::: "memory")
__device__ __forceinline__ unsigned long long rt() { return __builtin_amdgcn_s_memrealtime(); }
__device__ __forceinline__ unsigned f2bf(float f) { unsigned u = __builtin_bit_cast(unsigned, f); return (u + 0x7fffu + ((u >> 16) & 1u)) >> 16; }
__device__ __forceinline__ unsigned pk2(float lo, float hi) { return f2bf(lo) | (f2bf(hi) << 16); }

#define XB_TMO      128
#define XB_XCNT(j)  (256  + 64 * (j))
#define XB_XSUB(j)  (1280 + 64 * (j))
#define XB_XGEN(j)  (2304 + 64 * (j))
#define XB_TOP      3328
#define XB_TOPGEN   3392
#define XCD_BAR_WORDS 3456
#define XB_SPIN_CAP (1u << 22)

__device__ __forceinline__ unsigned xb_ld(unsigned* p)              { return __hip_atomic_load(p, __ATOMIC_RELAXED, __HIP_MEMORY_SCOPE_AGENT); }
__device__ __forceinline__ unsigned xb_add(unsigned* p, unsigned v) { return __hip_atomic_fetch_add(p, v, __ATOMIC_RELAXED, __HIP_MEMORY_SCOPE_AGENT); }
__device__ __forceinline__ unsigned xb_xcc_id() { return (unsigned)__builtin_amdgcn_s_getreg((3 << 11) | 20) & 0xFu; }
#define XB_SPIN(cond, bar) do { unsigned _sp = 0; while (cond) { __builtin_amdgcn_s_sleep(1); \
    if ((++_sp & 255u) == 0u) { if (xb_ld(&(bar)[XB_TMO])) break; if (_sp > XB_SPIN_CAP) { atomicAdd(&(bar)[XB_TMO], 1u); break; } } } } while (0)

struct XcdBarrier {
    unsigned* bar; unsigned x; int w0;
    volatile LAS unsigned* st;
};

__device__ __forceinline__ XcdBarrier xcd_barrier_post(unsigned* bar, volatile LAS unsigned* st, int w0) {
    XcdBarrier b; b.bar = bar; b.x = xb_xcc_id(); b.st = st; b.w0 = w0;
    if (w0 == 0 && lane_id_() == 0) (void)xb_add(&bar[XB_XCNT(b.x)], 1u);
    return b;
}
__device__ __forceinline__ void xcd_barrier_complete(unsigned* bar, unsigned x, unsigned& nloc, unsigned& nx) {
    const unsigned G = gridDim.x * gridDim.y * gridDim.z;
    unsigned sum, cnt, mine, sp = 0u;
    for (;;) {
        sum = 0u; cnt = 0u; mine = 0u;
#pragma unroll
        for (unsigned j = 0; j < 16; ++j) { const unsigned c = xb_ld(&bar[XB_XCNT(j)]); sum += c; cnt += (c > 0u) ? 1u : 0u; mine = (j == x) ? c : mine; }
        if (sum == G) break;
        __builtin_amdgcn_s_sleep(1);
        if ((++sp & 255u) == 0u) { if (xb_ld(&bar[XB_TMO])) break; if (sp > XB_SPIN_CAP) { atomicAdd(&bar[XB_TMO], 1u); break; } }
    }
    nloc = mine > 0u ? mine : 1u; nx = cnt > 0u ? cnt : 1u;
}

__device__ __forceinline__ void xcd_barrier(const XcdBarrier& b) {
    asm volatile("s_waitcnt vmcnt(0)" ::: "memory");
    __syncthreads();
    if (b.w0 == 0 && lane_id_() == 0) {
        unsigned* bar = b.bar;
        __builtin_amdgcn_s_waitcnt(0);
        unsigned nloc = b.st[0], nx = b.st[1];
        if (nloc == 0u) { xcd_barrier_complete(bar, b.x, nloc, nx); b.st[0] = nloc; b.st[1] = nx; }
        const unsigned old = xb_add(&bar[XB_XSUB(b.x)], 1u);
        const unsigned gen = old / nloc;
        if (old + 1u == (gen + 1u) * nloc) {
            __builtin_amdgcn_fence(__ATOMIC_RELEASE, "agent");
            asm volatile("s_waitcnt vmcnt(0)" ::: "memory");
            const unsigned og = xb_add(&bar[XB_TOP], 1u);
            const unsigned tg = og / nx;
            if (og + 1u == (tg + 1u) * nx) xb_add(&bar[XB_TOPGEN], 1u);
            else XB_SPIN(xb_ld(&bar[XB_TOPGEN]) == tg, bar);
            __builtin_amdgcn_fence(__ATOMIC_ACQUIRE, "agent");
            xb_add(&bar[XB_XGEN(b.x)], 1u);
            asm volatile("s_waitcnt vmcnt(0)" ::: "memory");
        } else {
            XB_SPIN(xb_ld(&bar[XB_XGEN(b.x)]) == gen, bar);
            __builtin_amdgcn_fence(__ATOMIC_ACQUIRE, "agent");
            asm volatile("s_waitcnt vmcnt(0)" ::: "memory");
        }
    }
    __syncthreads();
}

__device__ __forceinline__ float shx(float v, int mask, int lane) { return __builtin_bit_cast(float, __builtin_amdgcn_ds_bpermute((lane ^ mask) << 2, __builtin_bit_cast(int, v))); }
__device__ __forceinline__ float wave_sum(float v, int lane) {
#pragma unroll
    for (int o = 1; o < 64; o <<= 1) v += shx(v, o, lane);
    return v;
}
__device__ __forceinline__ unsigned pkbf(float lo, float hi) { return pg8::cvt_pk_bf16(lo, hi); }
__device__ __forceinline__ int dst_row0(int mode, int n0) {
    if (mode == 0) return n0;
    if (mode == 1) { const int t = n0 >> 8, blk = (n0 & 255) >> 5, wc = blk >> 1, bj = blk & 1; return (t << 8) + 32 * (4 * bj + wc); }
    const int r = ((n0 >> 7) << 8) + (n0 & 127); return mode == 2 ? r : r + 128;
}
__device__ __forceinline__ void transpose_item(const float* W, int K, int N, bf16* WT, int mode, LAS float* scr, int item, int lane) {
    const int nblk = N / 32, kb = item / nblk, nb = item % nblk, k0 = 64 * kb, n0 = 32 * nb, d0 = dst_row0(mode, n0);
    float tv[32];
#pragma unroll
    for (int i = 0; i < 32; ++i) { const int kk = 2 * i + (lane >> 5); tv[i] = W[(size_t)(k0 + kk) * N + n0 + (lane & 31)]; }
#pragma unroll
    for (int i = 0; i < 32; ++i) { const int kk = 2 * i + (lane >> 5); scr[kk * 33 + (lane & 31)] = tv[i]; }
    LDS_WAIT(); asm volatile("" ::: "memory");
    const int c = lane & 7;
#pragma unroll
    for (int j = 0; j < 4; ++j) { const int n = (lane >> 3) + 8 * j; const LAS float* s = scr + (8 * c) * 33 + n;
        v4u o; o.x = pkbf(s[0 * 33], s[1 * 33]); o.y = pkbf(s[2 * 33], s[3 * 33]); o.z = pkbf(s[4 * 33], s[5 * 33]); o.w = pkbf(s[6 * 33], s[7 * 33]);
        *(GAS v4u*)(WT + (size_t)(d0 + n) * K + k0 + 8 * c) = o; }
    LDS_WAIT(); asm volatile("" ::: "memory");
}
__device__ __forceinline__ void row_load(const float* xrow, int lane, f32x4 (&h)[4]) {
    const GAS f32x4* xr = (const GAS f32x4*)xrow + lane;
#pragma unroll
    for (int j = 0; j < 4; ++j) h[j] = xr[64 * j];
}
__device__ __forceinline__ void norm_mod_apply(f32x4 (&h)[4], const float* g, const float* sh, const float* sc, bf16* orow, int lane) {
    float ss = 0.f;
#pragma unroll
    for (int j = 0; j < 4; ++j) ss += (h[j].x * h[j].x + h[j].y * h[j].y) + (h[j].z * h[j].z + h[j].w * h[j].w);
    const float rs = 1.f / sqrtf(wave_sum(ss, lane) * (1.f / DM) + EPS);
    GAS unsigned long long* o8 = (GAS unsigned long long*)orow + lane;
#pragma unroll
    for (int j = 0; j < 4; ++j) { const f32x4 g4 = ((const GAS f32x4*)g)[lane + 64 * j], s4 = ((const GAS f32x4*)sc)[lane + 64 * j], b4 = ((const GAS f32x4*)sh)[lane + 64 * j];
        h[j] = h[j] * rs * g4 * (s4 + 1.f) + b4;
        o8[64 * j] = (unsigned long long)pkbf(h[j].x, h[j].y) | ((unsigned long long)pkbf(h[j].z, h[j].w) << 32); }
}
struct Args { const float* in[24]; float* out; unsigned char* ws; };
enum { I_X = 0, I_C, I_CTX, I_CCTX, I_ADAW, I_ADAB, I_NAG, I_NFG, I_WIN, I_QNG, I_KNG, I_DLAM, I_SUBG, I_WPD, I_WPG, I_WO, I_FW1, I_FW3, I_FW2, I_ROUTER, I_MW1, I_MW3, I_MW2, I_FNG };

#ifndef REP_THIN
#define REP_THIN 1
#endif
#ifndef REP_CONV
#define REP_CONV 1
#endif
#ifndef REP_ATT
#define REP_ATT 1
#endif
#ifndef REP_GEMM
#define REP_GEMM 1
#endif
#define CAS __attribute__((address_space(4)))
#define PH_BEGIN \
    const CAS Args* ap = (const CAS Args*)__builtin_amdgcn_kernarg_segment_ptr(); asm volatile("" : "+s"(ap)); \
    unsigned char* const ws = (unsigned char*)(GAS unsigned char*)ap->ws; \
    int tid = wave0 * 64 + lane_id_(); asm volatile("" : "+v"(tid)); \
    const int lane = tid & 63, wave = __builtin_amdgcn_readfirstlane(tid >> 6); \
    const int G = gridDim.x, bx = blockIdx.x, vcu = (G % 8 == 0) ? (bx % 8) * (G / 8) + bx / 8 : bx, gw = vcu * NWAVES + wave, NGW = G * NWAVES; \
    (void)lane; (void)gw; (void)NGW; (void)bx; (void)ws;
#define INP(i) ((const float*)(const GAS float*)ap->in[i])
#define WSP(T, off) ((T*)(ws + (off)))
#define LDSP ((LAS unsigned char*)lds)

__global__ void __launch_bounds__(NWAVES * 64, 2) fwd_kernel(Args args) {
    extern __shared__ __attribute__((aligned(16))) unsigned char lds[];
    const int wave0 = __builtin_amdgcn_readfirstlane((int)threadIdx.x >> 6);
    for (int u = threadIdx.x; u < (LDS_BYTES - LDSCTL_OFF) / 4; u += NWAVES * 64) ((LAS unsigned*)(LDSP + LDSCTL_OFF))[u] = 0u;
    __syncthreads();
    const XcdBarrier bar = xcd_barrier_post((unsigned*)(args.ws + WS_CTL) + CW_BAR, (volatile LAS unsigned*)(LDSP + MISC_OFF) + 8, wave0);
#define GRID_BAR() do { XcdBarrier b_ = bar; asm volatile("" : "+s"(b_.bar), "+s"(b_.x)); b_.bar = (unsigned*)(GAS unsigned*)b_.bar; xcd_barrier(b_); } while (0)

#define D_MOD WSP(float, WS_MOD)
#define D_TAB WSP(float, WS_TAB)
#define D_LAM WSP(float, WS_LAM)
#define D_H WSP(bf16, WS_H)
#define D_P WSP(bf16, WS_P)
#define D_OA WSP(bf16, WS_OA)
#define D_MX WSP(bf16, WS_MX)
#define D_XC WSP(float, WS_XC)
#define D_X ((float*)(GAS float*)ap->out)
#define D_SCR ((LAS float*)(LDSP + RING_OFF + wave * 8448))
#define D_MODL (D_MOD + (size_t)l * 5 * 6144)
#define MOE2_SPLIT const int nU = ps[8] * 4, nfull = (nU / G) * G, nlo = nU - nfull, ns = (nlo == 0 || nlo > 64) ? 1 : nlo <= 18 ? 7 : nlo <= 32 ? 4 : 2;
#define D_CNT ((gu32*)(GAS unsigned*)(ws + WS_CTL) + CW_MOE)
#define D_ME WSP(int2, WS_ME)
#define D_MP WSP(int2, WS_MP)
#define D_MW WSP(float2, WS_MW)
#define PS_LOAD int ps[9]; ps[0] = 0; _Pragma("unroll") for (int e_ = 0; e_ < 8; ++e_) { const int n_ = (int)__builtin_amdgcn_readfirstlane(__hip_atomic_load(D_CNT + 64 * e_, RLX_AGENT)); ps[e_ + 1] = ps[e_] + ((n_ + 255) >> 8); }
for (int rep_ = 0; rep_ < REP_THIN; ++rep_) {
    {
        PH_BEGIN
        LAS float* const st = (LAS float*)(LDSP + RING_OFF + 69632);
        for (int i = tid; i < 5 * DM; i += NWAVES * 64) { const float x = i < 4 * DM ? INP(I_C)[i] : INP(I_CCTX)[i - 4 * DM]; st[i] = x / (1.f + __expf(-x)); }
        __syncthreads();
        constexpr int N_MOD = 2 * 384, N_ROPE = 16, N_LAM = 1, N_WIN = 16 * (INW / 32), N_PRJ = 16 * 32, N_W1 = 16 * (DFF / 32), N_W2 = (DFF / 64) * 32;
        constexpr int NITEMS = N_MOD + N_ROPE + N_LAM + 2 * N_WIN + 6 * N_PRJ + 2 * N_W1 + N_W2;
        for (int it = gw; it < NITEMS; it += NGW) {
            int r = it;
            if (r < N_MOD) {
                const int l = r / 384, cb = r - l * 384, cl = lane & 15, kg = lane >> 4, col = 16 * cb + cl;
                const float* w = INP(I_ADAW) + (size_t)l * DM * 6144 + col; float a0 = 0.f, a1 = 0.f, a2 = 0.f, a3 = 0.f, a4 = 0.f;
#pragma unroll 16
                for (int k = kg; k < DM; k += 4) { const float wv = w[(size_t)k * 6144]; a0 += st[k] * wv; a1 += st[DM + k] * wv; a2 += st[2 * DM + k] * wv; a3 += st[3 * DM + k] * wv; a4 += st[4 * DM + k] * wv; }
                a0 += shx(a0, 16, lane); a0 += shx(a0, 32, lane); a1 += shx(a1, 16, lane); a1 += shx(a1, 32, lane); a2 += shx(a2, 16, lane); a2 += shx(a2, 32, lane);
                a3 += shx(a3, 16, lane); a3 += shx(a3, 32, lane); a4 += shx(a4, 16, lane); a4 += shx(a4, 32, lane);
                if (kg == 0) { const float bb = INP(I_ADAB)[l * 6144 + col]; float* m = D_MOD + (size_t)l * 5 * 6144 + col;
                    m[0] = a0 + bb; m[6144] = a1 + bb; m[2 * 6144] = a2 + bb; m[3 * 6144] = a3 + bb; m[4 * 6144] = a4 + bb; }
                continue; }
            r -= N_MOD;
            if (r < N_ROPE) { const int idx = r * 64 + lane, pos = idx >> 4, f = idx & 15; const float invf = powf(10000.f, -(float)f / 16.f), ang = (float)pos * invf;
                D_TAB[2 * idx] = cosf(ang); D_TAB[2 * idx + 1] = sinf(ang); continue; }
            r -= N_ROPE;
            if (r < N_LAM) {
                for (int l = 0; l < 2; ++l) { const float* dl = INP(I_DLAM) + l * 256; const float s1 = wave_sum(dl[lane] * dl[64 + lane], lane), s2 = wave_sum(dl[128 + lane] * dl[192 + lane], lane);
                    if (lane == 0) D_LAM[l] = expf(s1) - expf(s2) + (0.8f - 0.6f * expf(-0.3f * (float)l)); }
                continue; }
            r -= N_LAM;
            if (r < 2 * N_WIN) { const int l = r / N_WIN; transpose_item(INP(I_WIN) + (size_t)l * DM * INW, DM, INW, (bf16*)(ws + WS_WIN) + (size_t)l * INW * DM, 1, D_SCR, r - l * N_WIN, lane); continue; }
            r -= 2 * N_WIN;
            if (r < 6 * N_PRJ) { const int j = r / N_PRJ, l = j / 3, w = j - 3 * l;
                const float* src = (w == 0 ? INP(I_WPD) : w == 1 ? INP(I_WPG) : INP(I_WO)) + (size_t)l * DM * DM;
                transpose_item(src, DM, DM, (bf16*)(ws + WS_WPRJ) + (size_t)j * DM * DM, 0, D_SCR, r - j * N_PRJ, lane); continue; }
            r -= 6 * N_PRJ;
            if (r < N_W1) { transpose_item(INP(I_FW1), DM, DFF, (bf16*)(ws + WS_W13), 2, D_SCR, r, lane); continue; }
            r -= N_W1;
            if (r < N_W1) { transpose_item(INP(I_FW3), DM, DFF, (bf16*)(ws + WS_W13), 3, D_SCR, r, lane); continue; }
            r -= N_W1;
            transpose_item(INP(I_FW2), DFF, DM, (bf16*)(ws + WS_W2F), 0, D_SCR, r, lane);
        }
    }
    GRID_BAR();
        }

    for (int l = 0; l < 2; ++l) {
for (int rep_ = 0; rep_ < REP_THIN; ++rep_) {
        {
            PH_BEGIN
            const float* xl = l == 0 ? INP(I_X) : D_X; const float* xc = l == 0 ? INP(I_CTX) : D_XC; f32x4 hv[4], hn[4];
#define XROW(e_) ((e_) % EXT < SEQ ? xl + (size_t)((e_) / EXT * SEQ + (e_) % EXT) * DM : xc + (size_t)((e_) / EXT * CTXL + (e_) % EXT - SEQ) * DM)
            row_load(XROW(gw), lane, hv);
            for (int e = gw; e < MEXT; e += NGW) { const int b = e / EXT, s = e - b * EXT; const bool lat = s < SEQ;
                const int en = e + NGW < MEXT ? e + NGW : e; row_load(XROW(en), lane, hn);
                const float* mv = D_MODL + (lat ? b : 4) * 6144;
                if (l == 1 && !lat) {
                    const float* sl = WSP(float, WS_SLABJ) + (size_t)(s - SEQ) * 256 + 4 * lane; const float* gtc = D_MOD + 4 * 6144 + 5 * DM;
#pragma unroll
                    for (int j = 0; j < 4; ++j) { f32x4 a = {0.f, 0.f, 0.f, 0.f};
                        for (int q = 0; q < DFF / 256; ++q) a = a + *(const GAS f32x4*)(sl + (size_t)((b * 4 + j) * (DFF / 256) + q) * 65536);
                        hv[j] = hv[j] + ((const GAS f32x4*)gtc)[lane + 64 * j] * a; } }
                norm_mod_apply(hv, INP(I_NAG) + l * DM, mv, mv + DM, D_H + (size_t)e * DM, lane);
#pragma unroll
                for (int j = 0; j < 4; ++j) hv[j] = hn[j]; }
#undef XROW
        }
        GRID_BAR();
        }
for (int rep_ = 0; rep_ < REP_GEMM; ++rep_) {
        {
            PH_BEGIN
            pg8::Gemm g{(const pg8::bf16_t*)D_H, (const pg8::bf16_t*)(ws + WS_WIN) + (size_t)l * INW * DM, DM, DM, DM, 0};
            pg8::RectOrder S; if (l == 0) S.init(NPAN, INW / 256, G, bx, 0, 0, 0); else S.init(64, INW / 256, G, bx, 1, 8, 10);
            pg8::EpiInProj E{(pg8::bf16_t*)D_P, INP(I_QNG) + l * 64, INP(I_KNG) + l * 64, D_TAB, attn_body::C2};
            pg8::gemm_phase<pg8::EpiInProj, pg8::RectOrder, true, true>(LDSP + RING_OFF, g, S, E, wave0);
        }
        GRID_BAR();
        }
for (int rep_ = 0; rep_ < REP_ATT; ++rep_) {
        {
            PH_BEGIN
            const int nun = l == 0 ? 2048 + 128 : 2048;
            for (int i = 0;; ++i) {
                const int Lu = i * G + vcu; if (Lu >= nun) break;
                int b, k, qb; bool diff;
                if (Lu < 2048) { const int pr = Lu >> 4, rnd = pr >> 4, idx = (rnd >> 1) * 16 + (pr & 15); qb = Lu & 15; diff = (rnd & 1) == 0; b = idx >> 4; k = idx & 15; }
                else { const int x = Lu - 2048; b = x >> 5; const int kk = x & 31; diff = kk < 16; k = kk & 15; qb = 16; }
                const size_t qrow = (size_t)b * EXT + qb * 256, krow = (size_t)b * EXT + (qb < 16 ? 0 : SEQ); const int NT = qb < 16 ? EXT / 64 : CTXL / 64;
                const attn_body::bf16* Pq = (const attn_body::bf16*)D_P + qrow * INW; const attn_body::bf16* Pk = (const attn_body::bf16*)D_P + krow * INW; attn_body::bf16* Oq = (attn_body::bf16*)D_OA + qrow * OAW;
                if (diff) { const int h = k >> 1, c = k & 1;
                    attn_body::attn_unit_dv<8>(Pq + PC_QD + h * 128 + c * 64, INW, Pk + PC_KD + h * 128 + c * 64, INW, Pk + PC_VD + h * 128, INW, Oq + c * 1024 + h * 128, OAW, NT, (char*)lds + RING_OFF, wave0); }
                else { const int gk = k >> 2;
                    attn_body::attn_unit<8>(Pq + PC_QG + k * 64, INW, Pk + PC_KG + gk * 64, INW, Pk + PC_VG + gk * 64, INW, Oq + 2048 + k * 64, OAW, NT, (char*)lds + RING_OFF, wave0); }
            }
        }
        GRID_BAR();
        }
        {
            PH_BEGIN
            const float lam = D_LAM[l], li = 1.f - (0.8f - 0.6f * expf(-0.3f * (float)l)); const float* sg = INP(I_SUBG) + l * 128 + 16 * (lane & 7);
            f32x4 g4[4];
#pragma unroll
            for (int j = 0; j < 4; ++j) g4[j] = ((const GAS f32x4*)sg)[j];
            for (int e = gw; e < MEXT; e += NGW) { bf16* row = D_OA + (size_t)e * OAW + 16 * lane;
                const v4u ra0 = *(const GAS v4u*)row, ra1 = *(const GAS v4u*)(row + 8), rc0 = *(const GAS v4u*)(row + 1024), rc1 = *(const GAS v4u*)(row + 1032);
                f32x4 a[4], c[4]; pg8::unpack8(ra0, a[0], a[1]); pg8::unpack8(ra1, a[2], a[3]); pg8::unpack8(rc0, c[0], c[1]); pg8::unpack8(rc1, c[2], c[3]);
                float ss = 0.f;
#pragma unroll
                for (int j = 0; j < 4; ++j) { a[j] = a[j] - c[j] * lam; ss += (a[j].x * a[j].x + a[j].y * a[j].y) + (a[j].z * a[j].z + a[j].w * a[j].w); }
                ss += shx(ss, 1, lane); ss += shx(ss, 2, lane); ss += shx(ss, 4, lane);
                const float rs = li / sqrtf(ss * (1.f / 128.f) + EPS);
#pragma unroll
                for (int j = 0; j < 4; ++j) a[j] = a[j] * rs * g4[j];
                *(GAS v4u*)row = pg8::pack8(a[0], a[1]); *(GAS v4u*)(row + 8) = pg8::pack8(a[2], a[3]); }
        }
        GRID_BAR();
        {
            PH_BEGIN
            pg8::Gemm g{(const pg8::bf16_t*)D_OA, (const pg8::bf16_t*)(ws + WS_WPRJ) + (size_t)(l * 3) * DM * DM, DM, OAW, DM, (size_t)DM * DM * 2};
            pg8::MixOrder S{G, bx, 2048};
            pg8::EpiGate E{(pg8::bf16_t*)D_MX, (const pg8::bf16_t*)D_P + PC_G1};
            pg8::gemm_phase<pg8::EpiGate, pg8::MixOrder, true, true>(LDSP + RING_OFF, g, S, E, wave0);
            if (l == 0) {
                pg8::Gemm g2{(const pg8::bf16_t*)D_OA, (const pg8::bf16_t*)(ws + WS_WPRJ), 256, OAW, DM, (size_t)DM * DM * 2};
                pg8::MixCtxOrder S2{G, bx, 2048};
                pg8::EpiSlabGate E2{WSP(float, WS_SLABX), (const pg8::bf16_t*)D_P + PC_G1};
                pg8::gemm_phase<pg8::EpiSlabGate, pg8::MixCtxOrder, true, true>(LDSP + RING_OFF, g2, S2, E2, wave0);
            }
        }
        GRID_BAR();
        if (l == 0) {
            { PH_BEGIN
              for (int it = gw; it < 16 * 256; it += NGW) { const int t = it >> 8, r = it & 255; const float* sl = WSP(float, WS_SLABX) + (size_t)t * 8 * 65536 + r * 256 + 4 * lane; f32x4 a = {0.f, 0.f, 0.f, 0.f};
#pragma unroll
                  for (int q = 0; q < 8; ++q) a = a + *(const GAS f32x4*)(sl + (size_t)q * 65536);
                  *(GAS unsigned long long*)(D_MX + ((size_t)((t >> 2) * 17 + 16) * 256 + r) * DM + (t & 3) * 256 + 4 * lane) = (unsigned long long)pkbf(a.x, a.y) | ((unsigned long long)pkbf(a.z, a.w) << 32); } }
            GRID_BAR();
        }
        {
            PH_BEGIN
            pg8::Gemm g{(const pg8::bf16_t*)D_MX, (const pg8::bf16_t*)(ws + WS_WPRJ) + (size_t)(l * 3 + 2) * DM * DM, DM, DM, DM, 0};
            pg8::RectOrder S; S.init(64, 4, G, bx, 1, 0, 0);
            pg8::EpiResid E{l == 0 ? INP(I_X) : D_X, l == 0 ? INP(I_CTX) : D_XC, D_X, D_XC, D_MODL + 2 * DM};
            pg8::gemm_phase<pg8::EpiResid, pg8::RectOrder, true, true>(LDSP + RING_OFF, g, S, E, wave0);
            if (l == 0) {
                pg8::Gemm g2{(const pg8::bf16_t*)D_MX, (const pg8::bf16_t*)(ws + WS_WPRJ) + (size_t)2 * DM * DM, 256, DM, DM, 0};
                pg8::CtxSliceOrder S2{4, 256, G, bx};
                pg8::EpiSlab E2{WSP(float, WS_SLABG)};
                pg8::gemm_phase<pg8::EpiSlab, pg8::CtxSliceOrder, true, true>(LDSP + RING_OFF, g2, S2, E2, wave0);
            }
        }
        GRID_BAR();
        if (l == 0) {
for (int rep_ = 0; rep_ < REP_THIN; ++rep_) {
            { PH_BEGIN
              f32x4 hv[4], hn[4]; const float* xl = D_X; const float* xc = INP(I_CTX);
#define XROW(e_) ((e_) % EXT < SEQ ? xl + (size_t)((e_) / EXT * SEQ + (e_) % EXT) * DM : xc + (size_t)((e_) / EXT * CTXL + (e_) % EXT - SEQ) * DM)
              row_load(XROW(gw), lane, hv);
              for (int e = gw; e < MEXT; e += NGW) { const int b = e / EXT, s = e - b * EXT; const bool lat = s < SEQ;
                  const int en = e + NGW < MEXT ? e + NGW : e; row_load(XROW(en), lane, hn);
                  const float* mv = D_MODL + (lat ? b : 4) * 6144;
                  if (!lat) { const float* sl = WSP(float, WS_SLABG) + (size_t)(s - SEQ) * 256 + 4 * lane; const float* gtc = D_MOD + 4 * 6144 + 2 * DM; GAS f32x4* xo = (GAS f32x4*)(D_XC + (size_t)(b * CTXL + s - SEQ) * DM) + lane;
#pragma unroll
                      for (int j = 0; j < 4; ++j) { f32x4 a = {0.f, 0.f, 0.f, 0.f};
#pragma unroll
                          for (int q = 0; q < 4; ++q) a = a + *(const GAS f32x4*)(sl + (size_t)((b * 4 + j) * 4 + q) * 65536);
                          hv[j] = hv[j] + ((const GAS f32x4*)gtc)[lane + 64 * j] * a; xo[64 * j] = hv[j]; } }
                  norm_mod_apply(hv, INP(I_NFG) + l * DM, mv + 3 * DM, mv + 4 * DM, D_H + (size_t)e * DM, lane);
#pragma unroll
                  for (int j = 0; j < 4; ++j) hv[j] = hn[j]; } }
#undef XROW
            GRID_BAR();
        }
for (int rep_ = 0; rep_ < REP_GEMM; ++rep_) {
            {
                PH_BEGIN
                pg8::Gemm g{(const pg8::bf16_t*)D_H, (const pg8::bf16_t*)(ws + WS_W13), DM, DM, DM, 0};
                pg8::RectOrder S; S.init(NPAN, 2 * DFF / 256, G, bx, 0, 0, 0);
                pg8::EpiSwiGLU E{(pg8::bf16_t*)(ws + WS_U), DFF};
                pg8::gemm_phase<pg8::EpiSwiGLU, pg8::RectOrder, true, true>(LDSP + RING_OFF, g, S, E, wave0);
            }
            GRID_BAR();
        }
            {
                PH_BEGIN
                pg8::Gemm g{(const pg8::bf16_t*)(ws + WS_U), (const pg8::bf16_t*)(ws + WS_W2F), DFF, DFF, DFF, 0};
                pg8::RectOrder S; S.init(64, 4, G, bx, 1, 0, 0);
                pg8::EpiResid E{D_X, D_XC, D_X, D_XC, D_MODL + 5 * DM};
                pg8::gemm_phase<pg8::EpiResid, pg8::RectOrder, true, true>(LDSP + RING_OFF, g, S, E, wave0);
                pg8::Gemm g2{(const pg8::bf16_t*)(ws + WS_U), (const pg8::bf16_t*)(ws + WS_W2F), 256, DFF, DFF, 0};
                pg8::CtxSliceOrder S2{DFF / 256, 256, G, bx};
                pg8::EpiSlab E2{WSP(float, WS_SLABJ)};
                pg8::gemm_phase<pg8::EpiSlab, pg8::CtxSliceOrder, true, true>(LDSP + RING_OFF, g2, S2, E2, wave0);
            }
            GRID_BAR();
        } else {
            { PH_BEGIN
              f32x4 hv[4], hn[4]; const float* router = INP(I_ROUTER);
              row_load(D_X + (size_t)gw * DM, lane, hn);
              for (int t = gw; t < MLAT; t += NGW) { const int b = t / SEQ; const float* mv = D_MODL + b * 6144;
#pragma unroll
                  for (int j = 0; j < 4; ++j) hv[j] = hn[j];
                  row_load(D_X + (size_t)(t + NGW < MLAT ? t + NGW : t) * DM, lane, hn);
                  norm_mod_apply(hv, INP(I_NFG) + l * DM, mv + 3 * DM, mv + 4 * DM, D_H + (size_t)t * DM, lane);
                  float lg[8];
#pragma unroll
                  for (int e = 0; e < 8; ++e) lg[e] = 0.f;
#pragma unroll
                  for (int j = 0; j < 4; ++j)
#pragma unroll
                      for (int i = 0; i < 4; ++i) { const GAS f32x4* rp = (const GAS f32x4*)(router + (size_t)(4 * lane + 256 * j + i) * 8); const f32x4 r0 = rp[0], r1 = rp[1]; const float hx = hv[j][i];
                          lg[0] += hx * r0.x; lg[1] += hx * r0.y; lg[2] += hx * r0.z; lg[3] += hx * r0.w; lg[4] += hx * r1.x; lg[5] += hx * r1.y; lg[6] += hx * r1.z; lg[7] += hx * r1.w; }
#pragma unroll
                  for (int e = 0; e < 8; ++e) lg[e] = wave_sum(lg[e], lane);
                  int i0 = 0; float v0 = lg[0];
#pragma unroll
                  for (int e = 1; e < 8; ++e) if (lg[e] > v0) { v0 = lg[e]; i0 = e; }
                  int i1 = -1; float v1 = -INFINITY;
#pragma unroll
                  for (int e = 0; e < 8; ++e) if (e != i0 && lg[e] > v1) { v1 = lg[e]; i1 = e; }
                  if (lane == 0) { const float w0 = 1.f / (1.f + expf(v1 - v0));
                      const int p0 = (int)__hip_atomic_fetch_add(D_CNT + 64 * i0, 1u, RLX_AGENT), p1 = (int)__hip_atomic_fetch_add(D_CNT + 64 * i1, 1u, RLX_AGENT);
                      D_ME[t] = make_int2(i0, i1); D_MP[t] = make_int2(p0, p1); D_MW[t] = make_float2(w0, 1.f - w0); } } }
            {
                PH_BEGIN
                constexpr int N_E1 = 16 * (DFE / 32), N_E2 = (DFE / 64) * 32;
                for (int rep2_ = 0; rep2_ < REP_CONV; ++rep2_)
                for (int it = gw; it < NEXP * (2 * N_E1 + N_E2); it += NGW) { const int e = it / (2 * N_E1 + N_E2); int r = it - e * (2 * N_E1 + N_E2);
                    if (r < N_E1) { transpose_item(INP(I_MW1) + (size_t)e * DM * DFE, DM, DFE, (bf16*)(ws + WS_MW13) + (size_t)e * 2 * DFE * DM, 2, D_SCR, r, lane); continue; }
                    r -= N_E1;
                    if (r < N_E1) { transpose_item(INP(I_MW3) + (size_t)e * DM * DFE, DM, DFE, (bf16*)(ws + WS_MW13) + (size_t)e * 2 * DFE * DM, 3, D_SCR, r, lane); continue; }
                    r -= N_E1;
                    transpose_item(INP(I_MW2) + (size_t)e * DFE * DM, DFE, DM, (bf16*)(ws + WS_MW2) + (size_t)e * DM * DFE, 0, D_SCR, r, lane); }
            }
            GRID_BAR();
for (int rep_ = 0; rep_ < REP_THIN; ++rep_) {
            {
                PH_BEGIN
                PS_LOAD
                bf16* const HS = (bf16*)(ws + WS_HS);
                for (int it = gw; it < 2 * MLAT; it += NGW) { const int t = it >> 1, k = it & 1; const int2 ee = D_ME[t], pp = D_MP[t]; const int e = k ? ee.y : ee.x, p = k ? pp.y : pp.x;
                    int pe = 0;
#pragma unroll
                    for (int q = 1; q < 8; ++q) pe = (e == q) ? ps[q] : pe;
                    const GAS v4u* src = (const GAS v4u*)(D_H + (size_t)t * DM); GAS v4u* dst = (GAS v4u*)(HS + ((size_t)pe * 256 + p) * DM);
                    dst[lane] = src[lane]; dst[lane + 64] = src[lane + 64]; }
            }
            GRID_BAR();
        }
for (int rep_ = 0; rep_ < REP_GEMM; ++rep_) {
            {
                PH_BEGIN
                PS_LOAD
                pg8::Gemm g{(const pg8::bf16_t*)(ws + WS_HS), (const pg8::bf16_t*)(ws + WS_MW13), DM, DM, DM, (size_t)2 * DFE * DM * 2};
                pg8::MoeOrder S{ps[8], 2 * DFE / 256, ps[8] * (2 * DFE / 256), G, bx, ps[1], ps[2], ps[3], ps[4], ps[5], ps[6], ps[7], 1, 0, 0};
                pg8::EpiSwiGLU E{(pg8::bf16_t*)(ws + WS_U2), DFE};
                pg8::gemm_phase<pg8::EpiSwiGLU, pg8::MoeOrder, true, true>(LDSP + RING_OFF, g, S, E, wave0);
            }
            GRID_BAR();
        }
for (int rep_ = 0; rep_ < REP_GEMM; ++rep_) {
            {
                PH_BEGIN
                PS_LOAD
                MOE2_SPLIT
                pg8::Gemm g{(const pg8::bf16_t*)(ws + WS_U2), (const pg8::bf16_t*)(ws + WS_MW2), DFE, DFE, DFE, (size_t)DM * DFE * 2};
                pg8::MoeOrder S{ps[8], 4, ns > 1 ? nfull : nU, G, bx, ps[1], ps[2], ps[3], ps[4], ps[5], ps[6], ps[7], 1, 0, 0};
                pg8::EpiPlain E{(pg8::bf16_t*)(ws + WS_HS), DM};
                pg8::gemm_phase<pg8::EpiPlain, pg8::MoeOrder, true, true>(LDSP + RING_OFF, g, S, E, wave0);
                if (ns > 1) {
                    pg8::Gemm g2{(const pg8::bf16_t*)(ws + WS_U2), (const pg8::bf16_t*)(ws + WS_MW2), DFE / ns, DFE, DFE, (size_t)DM * DFE * 2};
                    pg8::MoeOrder S2{ps[8], 4, nlo * ns, G, bx, ps[1], ps[2], ps[3], ps[4], ps[5], ps[6], ps[7], ns, nfull, DFE / ns};
                    pg8::EpiSlab E2{WSP(float, WS_SLABM)};
                    pg8::gemm_phase<pg8::EpiSlab, pg8::MoeOrder, true, true>(LDSP + RING_OFF, g2, S2, E2, wave0);
                }
            }
            GRID_BAR();
            {
                PH_BEGIN
                PS_LOAD
                MOE2_SPLIT
                if (ns > 1) { bf16* const Y = (bf16*)(ws + WS_HS);
                    for (int it = gw; it < nlo * 256; it += NGW) { const int t = it >> 8, r = it & 255; int pm, pn; pg8::rect_map(nfull + t, ps[8], 4, pm, pn);
                        const float* sl = WSP(float, WS_SLABM) + (size_t)t * ns * 65536 + r * 256 + 4 * lane; f32x4 a = {0.f, 0.f, 0.f, 0.f};
                        for (int q = 0; q < ns; ++q) a = a + *(const GAS f32x4*)(sl + (size_t)q * 65536);
                        *(GAS unsigned long long*)(Y + ((size_t)pm * 256 + r) * DM + pn * 256 + 4 * lane) = (unsigned long long)pkbf(a.x, a.y) | ((unsigned long long)pkbf(a.z, a.w) << 32); } }
            }
            GRID_BAR();
        }
            {
                PH_BEGIN
                PS_LOAD
                const bf16* const Y = (const bf16*)(ws + WS_HS); const float* fg = INP(I_FNG);
                for (int t = gw; t < MLAT; t += NGW) { const int b = t / SEQ; const int2 ee = D_ME[t], pp = D_MP[t]; const float2 ww = D_MW[t];
                    int pe0 = 0, pe1 = 0;
#pragma unroll
                    for (int q = 1; q < 8; ++q) { pe0 = (ee.x == q) ? ps[q] : pe0; pe1 = (ee.y == q) ? ps[q] : pe1; }
                    const GAS unsigned long long* y0 = (const GAS unsigned long long*)(Y + ((size_t)pe0 * 256 + pp.x) * DM) + lane; const GAS unsigned long long* y1 = (const GAS unsigned long long*)(Y + ((size_t)pe1 * 256 + pp.y) * DM) + lane;
                    GAS f32x4* xr = (GAS f32x4*)(D_X + (size_t)t * DM) + lane; const GAS f32x4* gt = (const GAS f32x4*)(D_MODL + b * 6144 + 5 * DM) + lane;
                    f32x4 v[4]; float ss = 0.f;
#pragma unroll
                    for (int j = 0; j < 4; ++j) { const unsigned long long a = y0[64 * j], c = y1[64 * j]; const unsigned a0 = (unsigned)a, a1 = (unsigned)(a >> 32), c0 = (unsigned)c, c1 = (unsigned)(c >> 32);
                        const f32x4 ya = {__builtin_bit_cast(float, a0 << 16), __builtin_bit_cast(float, a0 & 0xffff0000u), __builtin_bit_cast(float, a1 << 16), __builtin_bit_cast(float, a1 & 0xffff0000u)};
                        const f32x4 yc = {__builtin_bit_cast(float, c0 << 16), __builtin_bit_cast(float, c0 & 0xffff0000u), __builtin_bit_cast(float, c1 << 16), __builtin_bit_cast(float, c1 & 0xffff0000u)};
                        v[j] = xr[64 * j] + gt[64 * j] * (ya * ww.x + yc * ww.y);
                        ss += (v[j].x * v[j].x + v[j].y * v[j].y) + (v[j].z * v[j].z + v[j].w * v[j].w); }
                    const float rs = 1.f / sqrtf(wave_sum(ss, lane) * (1.f / DM) + EPS);
#pragma unroll
                    for (int j = 0; j < 4; ++j) xr[64 * j] = v[j] * rs * ((const GAS f32x4*)fg)[lane + 64 * j]; }
            }
        }
    }
#undef GRID_BAR
}

extern "C" void kernel_launch(void* const* d_in, const int* in_sizes, int n_in, void* d_out, int out_size, void* d_ws, size_t ws_size, hipStream_t stream) {
    static int grid = 0;
    if (grid == 0) {
        if (n_in != 24 || out_size != MLAT * DM || ws_size < WS_END) { fprintf(stderr, "kernel_launch: built for 24 inputs, %d outputs, >= %zu bytes of workspace; got n_in %d, out %d, ws %zu; nothing launched\n", MLAT * DM, (size_t)WS_END, n_in, out_size, ws_size); grid = -1; return; }
        int dev = 0, cus = 0, per_cu = 0;
        if (hipGetDevice(&dev) != hipSuccess || hipDeviceGetAttribute(&cus, hipDeviceAttributeMultiprocessorCount, dev) != hipSuccess) { fprintf(stderr, "kernel_launch: device query failed\n"); grid = -1; return; }
        if (hipFuncSetAttribute((const void*)fwd_kernel, hipFuncAttributeMaxDynamicSharedMemorySize, LDS_BYTES) != hipSuccess) { fprintf(stderr, "kernel_launch: hipFuncSetAttribute failed\n"); grid = -1; return; }
        if (hipOccupancyMaxActiveBlocksPerMultiprocessor(&per_cu, (const void*)fwd_kernel, NWAVES * 64, LDS_BYTES) != hipSuccess || per_cu < 1) { fprintf(stderr, "kernel_launch: occupancy query reports %d workgroups per CU\n", per_cu); }
        (void)hipGetLastError();
        grid = cus;
    }
    if (grid < 0) return;
    if (hipMemsetAsync((char*)d_ws + WS_CTL, 0, CTL_ZERO_BYTES, stream) != hipSuccess) { fprintf(stderr, "kernel_launch: hipMemsetAsync failed\n"); return; }
    Args a{};
    for (int i = 0; i < 24; ++i) a.in[i] = (const float*)d_in[i];
    a.out = (float*)d_out; a.ws = (unsigned char*)d_ws;
    hipLaunchKernelGGL(fwd_kernel, dim3(grid), dim3(NWAVES * 64), LDS_BYTES, stream, a);
    const hipError_t le = hipPeekAtLastError();
    if (le != hipSuccess) fprintf(stderr, "kernel_launch: launch failed: %s\n", hipGetErrorName(le));
}
```
